# Optimizing an MI355X kernel written in HIP

```python
import jax
import jax.numpy as jnp
from jax import lax
import numpy as np

D_MODEL = 4096
BATCH = 4
SEQ = 2048
DEPTH = 2

HEAD_DIM = 128
D_MIX = D_MODEL
D_RG = D_MIX // 4
D_NSA = D_MIX // 2
D_HG = D_MIX - D_RG - D_NSA

RG_BLOCKS = D_RG // HEAD_DIM
RG_CONV = 4
RG_C = 8.0

NSA_HEADS = D_NSA // HEAD_DIM
NSA_KV = 2
NSA_GROUP = NSA_HEADS // NSA_KV
CMP_LEN = 32
CMP_STRIDE = 16
CMP_HIDDEN = 256
SEL_LEN = 64
SEL_TOPN = 16
WINDOW = 512
Q_BLOCK = 64

HG_HEADS = D_HG // HEAD_DIM
HG_CHUNK = 64

ALPHA = (2.0 * DEPTH) ** 0.25
BETA = (8.0 * DEPTH) ** -0.25
ADA_SCALE = 0.1
LN_EPS = 1e-5
RMS_EPS = 1e-6
NEG_INF = -1e30
FORCE_SCORE = 1e9

KV_COLS = 2 * NSA_KV * HEAD_DIM
IN_SIZES = (D_RG, D_RG,
            D_NSA, KV_COLS, KV_COLS, KV_COLS, 3 * NSA_HEADS, D_NSA,
            D_HG, D_HG, D_HG, D_HG)
N_IN = sum(IN_SIZES)

kernel_name = "hymba_rglru_nsa_hgrn2_deepnorm"


def _layer_norm(x, g, b):
    xf = x.astype(jnp.float32)
    mu = jnp.mean(xf, axis=-1, keepdims=True)
    var = jnp.mean(jnp.square(xf - mu), axis=-1, keepdims=True)
    return ((xf - mu) * lax.rsqrt(var + LN_EPS)).astype(x.dtype) * g + b


def _masked_softmax(logits, valid):
    p = jax.nn.softmax(jnp.where(valid, logits, NEG_INF), axis=-1)
    return p * valid


def _alibi_slopes():
    h = np.arange(1, NSA_HEADS + 1, dtype=np.float32)
    s = np.power(np.float32(2.0), -8.0 * h / NSA_HEADS).astype(np.float32)
    return jnp.asarray(s.reshape(NSA_KV, NSA_GROUP))


def _causal_dwconv(x, w, b):
    T = x.shape[1]
    xp = jnp.pad(x, ((0, 0), (RG_CONV - 1, 0), (0, 0)))
    y = b
    for j in range(RG_CONV):
        y = y + xp[:, j:j + T] * w[j]
    return y


def _rg_lru(x, w_a, b_a, w_x, b_x, lam):
    B, T, _ = x.shape
    xb = x.reshape(B, T, RG_BLOCKS, HEAD_DIM)
    r = jax.nn.sigmoid(jnp.einsum('btnd,nde->btne', xb, w_a).reshape(B, T, D_RG) + b_a)
    i = jax.nn.sigmoid(jnp.einsum('btnd,nde->btne', xb, w_x).reshape(B, T, D_RG) + b_x)
    log_a = (-RG_C * jax.nn.softplus(-lam) * r).astype(jnp.float32)
    a = jnp.exp(log_a)
    mult = jnp.sqrt(-jnp.expm1(2.0 * log_a))
    mult = mult.at[:, 0].set(1.0)
    bx = mult * (i * x).astype(jnp.float32)

    def combine(left, right):
        a_l, b_l = left
        a_r, b_r = right
        return a_l * a_r, a_r * b_l + b_r

    _, h = lax.associative_scan(combine, (a, bx), axis=1)
    return h.astype(x.dtype)


def _nsa(q, kv_c, kv_s, kv_w, gate_logits, pe_k, pe_v, w1_k, w2_k, w1_v, w2_v):
    B, T, _ = q.shape
    dt = q.dtype
    f32 = jnp.float32
    G, R, D = NSA_KV, NSA_GROUP, HEAD_DIM
    scale = D ** -0.5
    slopes = _alibi_slopes()
    qh = q.reshape(B, T, G, R, D)

    def kv_split(kv):
        k, v = jnp.split(kv, 2, axis=-1)
        return k.reshape(B, T, G, D), v.reshape(B, T, G, D)

    kc, vc = kv_split(kv_c)
    ks, vs = kv_split(kv_s)
    kw, vw = kv_split(kv_w)
    t_pos = jnp.arange(T)

    n_cmp = (T - CMP_LEN) // CMP_STRIDE + 1
    cmp_idx = np.arange(n_cmp)[:, None] * CMP_STRIDE + np.arange(CMP_LEN)[None, :]

    def compress(k, pe, w1, w2):
        blk = k[:, cmp_idx] + pe[:, None, :]
        blk = blk.transpose(0, 1, 3, 2, 4).reshape(B, n_cmp, G, CMP_LEN * D)
        return jax.nn.silu(blk @ w1) @ w2

    k_cmp = compress(kc, pe_k, w1_k, w2_k)
    v_cmp = compress(vc, pe_v, w1_v, w2_v)
    cmp_end = jnp.asarray(cmp_idx[:, -1])
    d_cmp = (t_pos[:, None] - cmp_end[None, :]).astype(f32)
    lg_cmp = (jnp.einsum('btgrd,bjgd->bgrtj', qh, k_cmp).astype(f32) * scale
              - slopes[None, :, :, None, None] * d_cmp)
    p_cmp = _masked_softmax(lg_cmp, d_cmp >= 0)
    o_cmp = jnp.einsum('bgrtj,bjgd->btgrd', p_cmp.astype(dt), v_cmp)

    n_sel = T // SEL_LEN
    top_n = min(SEL_TOPN, n_sel)
    s_c = np.arange(n_cmp) * CMP_STRIDE
    s_s = np.arange(n_sel) * SEL_LEN
    overlap = np.clip(np.minimum(s_c[:, None] + CMP_LEN, s_s[None, :] + SEL_LEN)
                      - np.maximum(s_c[:, None], s_s[None, :]), 0, None).astype(np.float32) / CMP_LEN
    imp = jnp.einsum('bgrtj,jn->bgtn', p_cmp, jnp.asarray(overlap))
    n_ids = jnp.arange(n_sel)
    cur = t_pos // SEL_LEN
    future = jnp.asarray(s_s)[None, :] > t_pos[:, None]
    forced = (n_ids[None, :] == 0) | (n_ids[None, :] == cur[:, None]) | (n_ids[None, :] == cur[:, None] - 1)
    imp = jnp.where(future, NEG_INF, jnp.where(forced, FORCE_SCORE, imp))
    _, sel_idx = lax.top_k(imp, top_n)

    n_qb = T // Q_BLOCK
    q_blocks = qh.reshape(B, n_qb, Q_BLOCK, G, R, D).transpose(1, 0, 2, 3, 4, 5)
    idx_blocks = sel_idx.reshape(B, G, n_qb, Q_BLOCK, top_n).transpose(2, 0, 1, 3, 4)
    ks_blk = ks.reshape(B, n_sel, SEL_LEN, G, D).transpose(0, 3, 1, 2, 4)
    vs_blk = vs.reshape(B, n_sel, SEL_LEN, G, D).transpose(0, 3, 1, 2, 4)
    kw_pad = jnp.pad(kw, ((0, 0), (WINDOW, 0), (0, 0), (0, 0)))
    vw_pad = jnp.pad(vw, ((0, 0), (WINDOW, 0), (0, 0), (0, 0)))
    b_ix = jnp.arange(B)[:, None, None, None]
    g_ix = jnp.arange(G)[None, :, None, None]
    n_keys = top_n * SEL_LEN

    def block_fn(args):
        qb, idx, qb_i = args
        q0 = qb_i * Q_BLOCK
        tq = q0 + jnp.arange(Q_BLOCK)
        kg = ks_blk[b_ix, g_ix, idx]
        vg = vs_blk[b_ix, g_ix, idx]
        pos = idx[..., None] * SEL_LEN + jnp.arange(SEL_LEN)
        d_sel = (tq[None, None, :, None, None] - pos).reshape(B, G, 1, Q_BLOCK, n_keys).astype(f32)
        lg = jnp.einsum('bqgrd,bgqnld->bgrqnl', qb, kg).reshape(B, G, R, Q_BLOCK, n_keys).astype(f32) * scale
        p_sel = _masked_softmax(lg - slopes[None, :, :, None, None] * d_sel, d_sel >= 0)
        o_sel = jnp.einsum('bgrqk,bgqkd->bqgrd', p_sel.astype(dt), vg.reshape(B, G, Q_BLOCK, n_keys, D))
        kwin = lax.dynamic_slice_in_dim(kw_pad, q0, WINDOW + Q_BLOCK, axis=1)
        vwin = lax.dynamic_slice_in_dim(vw_pad, q0, WINDOW + Q_BLOCK, axis=1)
        kpos = q0 - WINDOW + jnp.arange(WINDOW + Q_BLOCK)
        d_win = tq[:, None] - kpos[None, :]
        valid = (d_win >= 0) & (d_win < WINDOW) & (kpos[None, :] >= 0)
        lw = (jnp.einsum('bqgrd,bkgd->bgrqk', qb, kwin).astype(f32) * scale
              - slopes[None, :, :, None, None] * d_win.astype(f32))
        p_win = _masked_softmax(lw, valid)
        o_win = jnp.einsum('bgrqk,bkgd->bqgrd', p_win.astype(dt), vwin)
        return o_sel, o_win

    o_sel, o_win = lax.map(block_fn, (q_blocks, idx_blocks, jnp.arange(n_qb)))
    o_sel = o_sel.transpose(1, 0, 2, 3, 4, 5).reshape(B, T, G, R, D)
    o_win = o_win.transpose(1, 0, 2, 3, 4, 5).reshape(B, T, G, R, D)

    g = jax.nn.sigmoid(gate_logits.reshape(B, T, G, R, 3))
    o = g[..., 0:1] * o_cmp + g[..., 1:2] * o_sel + g[..., 2:3] * o_win
    return o.reshape(B, T, D_NSA)


def _hgrn2(q, f_logit, v, out_gate, lb, norm_g):
    B, T, _ = q.shape
    dt = q.dtype
    f32 = jnp.float32
    n_ch = T // HG_CHUNK
    z = f_logit.astype(f32)
    lb = lb.astype(f32)
    log_f = jnp.logaddexp(jnp.log(lb), jnp.log1p(-lb) + jax.nn.log_sigmoid(z))
    k = (1.0 - lb) * jax.nn.sigmoid(-z)
    qs = jax.nn.silu(q.astype(f32))

    def chunks(a):
        return a.reshape(B, n_ch, HG_CHUNK, HG_HEADS, HEAD_DIM).transpose(1, 0, 2, 3, 4)

    qc, kc, vc, lfc = chunks(qs), chunks(k), chunks(v.astype(f32)), chunks(log_f)
    causal = jnp.tril(jnp.ones((HG_CHUNK, HG_CHUNK), dtype=bool))

    def step(S, inp):
        q_, k_, v_, lf = inp
        b = jnp.cumsum(lf, axis=1)
        b_last = b[:, -1]
        o_inter = jnp.einsum('bthk,bhkv->bthv', q_ * jnp.exp(b), S)
        diff = b[:, :, None] - b[:, None, :]
        decay = jnp.exp(jnp.where(causal[None, :, :, None, None], diff, -jnp.inf))
        A = jnp.einsum('bthk,btshk->bhts', q_, decay * k_[:, None])
        o_intra = jnp.einsum('bhts,bshv->bthv', A, v_)
        S = S * jnp.exp(b_last)[..., None] + jnp.einsum('bshk,bshv->bhkv', k_ * jnp.exp(b_last[:, None] - b), v_)
        return S, o_inter + o_intra

    S0 = jnp.zeros((B, HG_HEADS, HEAD_DIM, HEAD_DIM), f32)
    _, o = lax.scan(step, S0, (qc, kc, vc, lfc))
    o = o.transpose(1, 0, 2, 3, 4).reshape(B, T, HG_HEADS, HEAD_DIM)
    o = o * lax.rsqrt(jnp.mean(o * o, axis=-1, keepdims=True) + RMS_EPS) * norm_g.astype(f32)
    return (o.reshape(B, T, D_HG) * jax.nn.silu(out_gate.astype(f32))).astype(dt)


def setup_inputs(seed: int = 0) -> dict:
    key = jax.random.key(seed)
    ks = jax.random.split(key, 24)
    f32 = jnp.float32

    def nrm(k, shape, s):
        return jax.random.normal(k, shape, f32) * s

    a0 = jax.random.uniform(ks[11], (DEPTH, D_RG), f32, 0.9, 0.999) ** (1.0 / RG_C)
    return {
        "x": nrm(ks[0], (BATCH, SEQ, D_MODEL), 1.0),
        "c": nrm(ks[1], (BATCH, D_MODEL), 1.0),
        "w_ada": nrm(ks[2], (DEPTH, D_MODEL, 3 * D_MODEL), ADA_SCALE * D_MODEL ** -0.5),
        "b_ada": nrm(ks[3], (DEPTH, 3 * D_MODEL), 0.02),
        "w_in": nrm(ks[4], (DEPTH, D_MODEL, N_IN), D_MODEL ** -0.5),
        "rg_conv_w": nrm(ks[5], (DEPTH, RG_CONV, D_RG), RG_CONV ** -0.5),
        "rg_conv_b": nrm(ks[6], (DEPTH, D_RG), 0.02),
        "rg_w_a": nrm(ks[7], (DEPTH, RG_BLOCKS, HEAD_DIM, HEAD_DIM), HEAD_DIM ** -0.5),
        "rg_b_a": nrm(ks[8], (DEPTH, D_RG), 0.02),
        "rg_w_x": nrm(ks[9], (DEPTH, RG_BLOCKS, HEAD_DIM, HEAD_DIM), HEAD_DIM ** -0.5),
        "rg_b_x": nrm(ks[10], (DEPTH, D_RG), 0.02),
        "rg_lambda": jnp.log(a0) - jnp.log1p(-a0),
        "nsa_pe_k": nrm(ks[12], (DEPTH, CMP_LEN, HEAD_DIM), 0.1),
        "nsa_pe_v": nrm(ks[13], (DEPTH, CMP_LEN, HEAD_DIM), 0.1),
        "nsa_cmp_w1_k": nrm(ks[14], (DEPTH, CMP_LEN * HEAD_DIM, CMP_HIDDEN), (CMP_LEN * HEAD_DIM) ** -0.5),
        "nsa_cmp_w2_k": nrm(ks[15], (DEPTH, CMP_HIDDEN, HEAD_DIM), CMP_HIDDEN ** -0.5),
        "nsa_cmp_w1_v": nrm(ks[16], (DEPTH, CMP_LEN * HEAD_DIM, CMP_HIDDEN), (CMP_LEN * HEAD_DIM) ** -0.5),
        "nsa_cmp_w2_v": nrm(ks[17], (DEPTH, CMP_HIDDEN, HEAD_DIM), CMP_HIDDEN ** -0.5),
        "hg_lower_bounds": nrm(ks[18], (DEPTH, D_HG), 1.0),
        "hg_norm_g": 1.0 + nrm(ks[19], (DEPTH, HEAD_DIM), 0.02),
        "w_out": nrm(ks[20], (DEPTH, D_MIX, D_MODEL), BETA * D_MIX ** -0.5),
        "ln_g": 1.0 + nrm(ks[21], (DEPTH, D_MODEL), 0.02),
        "ln_b": nrm(ks[22], (DEPTH, D_MODEL), 0.02),
    }


def reference(x, c, w_ada, b_ada, w_in, rg_conv_w, rg_conv_b, rg_w_a, rg_b_a, rg_w_x, rg_b_x,
              rg_lambda, nsa_pe_k, nsa_pe_v, nsa_cmp_w1_k, nsa_cmp_w2_k, nsa_cmp_w1_v, nsa_cmp_w2_v,
              hg_lower_bounds, hg_norm_g, w_out, ln_g, ln_b):
    lbs = jnp.cumsum(jax.nn.softmax(hg_lower_bounds.astype(jnp.float32), axis=0), axis=0)
    lbs = lbs - lbs[0]
    splits = [int(s) for s in np.cumsum(IN_SIZES)[:-1]]
    for l in range(DEPTH):
        mod = c @ w_ada[l] + b_ada[l]
        shift, scale, gate = jnp.split(mod, 3, axis=-1)
        u = x * (1.0 + scale[:, None]) + shift[:, None]
        proj = u @ w_in[l]
        (rg_x, rg_g, nsa_q, kv_c, kv_s, kv_w, nsa_gl, nsa_g,
         hg_q, hg_f, hg_i, hg_g) = jnp.split(proj, splits, axis=-1)
        y_rg = _rg_lru(_causal_dwconv(rg_x, rg_conv_w[l], rg_conv_b[l]),
                       rg_w_a[l], rg_b_a[l], rg_w_x[l], rg_b_x[l], rg_lambda[l]) * jax.nn.silu(rg_g)
        y_nsa = _nsa(nsa_q, kv_c, kv_s, kv_w, nsa_gl, nsa_pe_k[l], nsa_pe_v[l],
                     nsa_cmp_w1_k[l], nsa_cmp_w2_k[l], nsa_cmp_w1_v[l], nsa_cmp_w2_v[l]) * jax.nn.silu(nsa_g)
        y_hg = _hgrn2(hg_q, hg_f, hg_i, hg_g, lbs[l], hg_norm_g[l])
        y = jnp.concatenate([y_rg, y_nsa, y_hg], axis=-1) @ w_out[l]
        x = _layer_norm(ALPHA * x + (1.0 + gate[:, None]) * y, ln_g[l], ln_b[l])
    return x
```

```cpp
#include <hip/hip_runtime.h>
#include <cstdio>
#include <cstdint>
#define MK_SPLIT 0
namespace pg8 {
#define PG8_LAS __attribute__((address_space(3)))
typedef unsigned short bf16_t;
typedef short bf16x8 __attribute__((ext_vector_type(8)));
typedef float f32x4 __attribute__((ext_vector_type(4)));
typedef unsigned u32x4 __attribute__((ext_vector_type(4)));
constexpr int BM = 256, BK = 64, HALF = 128, HTB = HALF * BK * 2  , STAGE_BYTES = 8 * HTB, NXCD = 8, WGM = 8;

__host__ __device__ __forceinline__ int lds_byte(int r, int c) { const int st = (r >> 4) * 2 + (c >> 5), rr = r & 15, cc = c & 31, ob = rr * 64 + cc * 2; return st * 1024 + (ob ^ (((ob >> 9) & 1) << 5)); }
__host__ __device__ __forceinline__ void stage_rc(int b, int& R, int& C) { const int st = b / 1024, sb = b % 1024, swz = sb ^ (((sb >> 9) & 1) << 5); R = (st >> 1) * 16 + swz / 64; C = (st & 1) * 32 + (swz % 64) / 2; }
__host__ __device__ __forceinline__ int perm32(int rho) { const int n = rho >> 4, i = rho & 15; return 8 * (i >> 2) + 4 * n + (i & 3); }

struct Unit { int pm, pn; };
struct Gemm { const bf16_t* A; const bf16_t* Bt; int M, N, K; };

struct StaticOrder {
    int nM, nN, nwg, G, c;
    __host__ __device__ void init(int M, int N, int G_, int c_) { nM = M / BM; nN = N / BM; nwg = nM * nN; G = G_; c = c_; }
    __host__ __device__ bool next(int i, Unit& u) const {
        const long L = (long)i * G + c; if (L >= nwg) return false;
        int wgid = (int)L; { const int q = nwg / NXCD, r = nwg % NXCD, xcd = wgid % NXCD, off = wgid / NXCD; wgid = (xcd < r ? xcd * (q + 1) : r * (q + 1) + (xcd - r) * q) + off; }
        const int nig = WGM * nN, gid = wgid / nig, fm = gid * WGM, gsz = (nM - fm) < WGM ? (nM - fm) : WGM;
        u.pm = fm + ((wgid % nig) % gsz); u.pn = (wgid % nig) / gsz; return true;
    }
    __device__ __forceinline__ void a_ready(const Unit&) const {}
    __device__ __forceinline__ void done(const Unit&) const {}
};

__device__ __forceinline__ unsigned cvt_pk_bf16(float lo, float hi) { unsigned r; asm volatile("v_cvt_pk_bf16_f32 %0, %1, %2" : "=v"(r) : "v"(lo), "v"(hi)); return r; }
typedef float f32x2 __attribute__((ext_vector_type(2)));

struct EpiBf16 {
    static constexpr bool PERM = true, AFTER_DRAIN = false;
    bf16_t* O; int ldc;
    __device__ __forceinline__ void operator()(const f32x4 (&acc)[2][2][4][2], const Unit& u, int wr, int wc, int fr, int fq) const {
        const int row0 = u.pm * BM + wr * 64 + fr; const int col0 = u.pn * BM + wc * 32 + 8 * fq;
#pragma unroll
        for (int ai = 0; ai < 2; ++ai)
#pragma unroll
            for (int m = 0; m < 4; ++m) { bf16_t* rowp = O + (size_t)(row0 + ai * HALF + m * 16) * ldc + col0;
#pragma unroll
                for (int bj = 0; bj < 2; ++bj) { const f32x4 v0 = acc[ai][bj][m][0], v1 = acc[ai][bj][m][1];
                    u32x4 w; w.x = cvt_pk_bf16(v0[0], v0[1]); w.y = cvt_pk_bf16(v0[2], v0[3]); w.z = cvt_pk_bf16(v1[0], v1[1]); w.w = cvt_pk_bf16(v1[2], v1[3]);
                    *(u32x4*)(rowp + bj * HALF) = w; } }
    }
};
struct EpiResid {
    static constexpr bool PERM = false, AFTER_DRAIN = false;
    const float* xres; float* V; const float* gate; int gate_stride; int rows_per_batch; int ldc; float alpha;
    __device__ __forceinline__ void operator()(const f32x4 (&acc)[2][2][4][2], const Unit& u, int wr, int wc, int fr, int fq) const {
        const int bidx = (u.pm * BM) / rows_per_batch; const int col0 = u.pn * BM + wc * 32 + 4 * fq;
        f32x4 gv[2][2];
#pragma unroll
        for (int bj = 0; bj < 2; ++bj)
#pragma unroll
            for (int n = 0; n < 2; ++n) gv[bj][n] = *(const f32x4*)(gate + (size_t)bidx * gate_stride + col0 + bj * HALF + n * 16) + 1.0f;
#pragma unroll
        for (int ai = 0; ai < 2; ++ai)
#pragma unroll
            for (int m = 0; m < 4; ++m) { const size_t off = (size_t)(u.pm * BM + ai * HALF + wr * 64 + m * 16 + fr) * ldc + col0;
#pragma unroll
                for (int bj = 0; bj < 2; ++bj)
#pragma unroll
                    for (int n = 0; n < 2; ++n) { const f32x4 xr = *(const f32x4*)(xres + off + bj * HALF + n * 16);
                        *(f32x4*)(V + off + bj * HALF + n * 16) = xr * alpha + gv[bj][n] * acc[ai][bj][m][n]; } }
    }
};
template <class Epi, class Sched, bool ALIGN_EPI = false, bool SP2 = false>
__device__ __forceinline__ void gemm_phase(PG8_LAS unsigned char* lds, const Gemm g, const Sched& S, const Epi& E) {
    int tid_ = threadIdx.x; asm volatile("" : "+v"(tid_));
    const int tid = tid_, wid = __builtin_amdgcn_readfirstlane(tid >> 6), lane = tid & 63, wr = wid >> 2, wc = wid & 3, fr = lane & 15, fq = lane >> 4;
    const int K = g.K, nt = K / BK;
    unsigned voffA[2], voffB[2];
#pragma unroll
    for (int i = 0; i < 2; ++i) { int R, C; stage_rc(tid * 16 + i * 8192, R, C); const int Rb = Epi::PERM ? ((R & ~31) + perm32(R & 31)) : R;
        voffA[i] = (unsigned)(R * K + C) * 2u; voffB[i] = (unsigned)(Rb * K + C) * 2u; }
    const size_t kstep = (size_t)(BK * 2);
    const size_t hstep = (size_t)HALF * K * 2;
    const size_t tstep = 2 * hstep;
    const unsigned ldsw = (unsigned)wid * 1024u;
    const int aoff = lds_byte(wr * 64 + fr, fq * 8), boff = lds_byte(wc * 32 + fr, fq * 8);
#define PG8_SA(b, h) (((b) * 2 + (h)) * HTB)
#define PG8_SB(b, h) ((4 + (b) * 2 + (h)) * HTB)
#define PG8_STAGE(bufoff, gbase, voff) do { _Pragma("unroll") for (int _i = 0; _i < 2; ++_i) \
        __builtin_amdgcn_global_load_lds((const unsigned*)((const char*)(gbase) + (voff)[_i]), (PG8_LAS unsigned*)(lds + (bufoff) + ldsw + _i * 8192), 16, 0, 0); } while (0)
#define PG8_LDA(dst, b, h) do { _Pragma("unroll") for (int m = 0; m < 4; ++m) _Pragma("unroll") for (int k = 0; k < 2; ++k) dst[m][k] = *(const PG8_LAS bf16x8*)(lds + PG8_SA(b, h) + aoff + m * 2048 + k * 1024); } while (0)
#define PG8_LDB(dst, b, h) do { _Pragma("unroll") for (int n = 0; n < 2; ++n) _Pragma("unroll") for (int k = 0; k < 2; ++k) dst[n][k] = *(const PG8_LAS bf16x8*)(lds + PG8_SB(b, h) + boff + n * 2048 + k * 1024); } while (0)
#define PG8_MMA(ai, bj, At, Bt) do { __builtin_amdgcn_s_setprio(1); _Pragma("unroll") for (int m = 0; m < 4; ++m) _Pragma("unroll") for (int n = 0; n < 2; ++n) _Pragma("unroll") for (int k = 0; k < 2; ++k) \
        acc[ai][bj][m][n] = __builtin_amdgcn_mfma_f32_16x16x32_bf16(Bt[n][k], At[m][k], acc[ai][bj][m][n], 0, 0, 0); __builtin_amdgcn_s_setprio(0); } while (0)
#define PG8_WAIT_V(n) asm volatile("s_waitcnt vmcnt(" #n ")" ::: "memory")
#define PG8_WAIT_L(n) asm volatile("s_waitcnt lgkmcnt(" #n ")" ::: "memory")
#define PG8_BAR __builtin_amdgcn_s_barrier()
#define PG8_SCHED __builtin_amdgcn_sched_barrier(0)
    Unit cur, nxt; int ui = 0;
    if (!S.next(0, cur)) return;
    f32x4 acc[2][2][4][2];
#pragma unroll
    for (int a = 0; a < 2; ++a)
#pragma unroll
        for (int b = 0; b < 2; ++b)
#pragma unroll
            for (int m = 0; m < 4; ++m)
#pragma unroll
                for (int n = 0; n < 2; ++n) acc[a][b][m][n] = (f32x4){0.f, 0.f, 0.f, 0.f};
    bf16x8 At[4][2], B0[2][2], B1[2][2];
    const char* cA = (const char*)g.A + (size_t)cur.pm * tstep; const char* cB = (const char*)g.Bt + (size_t)cur.pn * tstep;
    S.a_ready(cur);
    if constexpr (SP2) {
        PG8_STAGE(PG8_SB(0, 0), cB, voffB); PG8_STAGE(PG8_SB(0, 1), cB + hstep, voffB); PG8_STAGE(PG8_SA(0, 0), cA, voffA); PG8_STAGE(PG8_SA(0, 1), cA + hstep, voffA);
        if (wr == 1) PG8_BAR;
        PG8_WAIT_V(2); PG8_BAR;
        PG8_STAGE(PG8_SB(1, 0), cB + kstep, voffB); PG8_STAGE(PG8_SA(1, 0), cA + kstep, voffA); PG8_STAGE(PG8_SB(1, 1), cB + hstep + kstep, voffB);
        PG8_WAIT_V(6); PG8_BAR;
    } else {
        PG8_STAGE(PG8_SB(0, 0), cB, voffB); PG8_STAGE(PG8_SA(0, 0), cA, voffA); PG8_STAGE(PG8_SB(0, 1), cB + hstep, voffB); PG8_STAGE(PG8_SA(0, 1), cA + hstep, voffA);
        if (wr == 1) PG8_BAR;
        PG8_WAIT_V(4); PG8_BAR;
        PG8_STAGE(PG8_SB(1, 0), cB + kstep, voffB); PG8_STAGE(PG8_SA(1, 0), cA + kstep, voffA); PG8_STAGE(PG8_SB(1, 1), cB + hstep + kstep, voffB);
        PG8_WAIT_V(6); PG8_BAR;
    }
    for (;;) {
        const bool has_next = S.next(ui + 1, nxt);
        const char* nA = has_next ? (const char*)g.A + (size_t)nxt.pm * tstep : cA; const char* nB = has_next ? (const char*)g.Bt + (size_t)nxt.pn * tstep : cB;
        for (int t = 0; t < nt; t += 2) {
            const bool last = (t == nt - 2);
            const char* a1 = cA + (size_t)(t + 1) * kstep;
            const char* a2 = last ? nA : cA + (size_t)(t + 2) * kstep; const char* b2 = last ? nB : cB + (size_t)(t + 2) * kstep;
            const char* a3 = a2 + kstep; const char* b3 = b2 + kstep;
            if (last && has_next) S.a_ready(nxt);
            if constexpr (SP2) {
            PG8_LDB(B0, 0, 0); PG8_LDB(B1, 0, 1); PG8_SCHED; PG8_LDA(At, 0, 0); PG8_STAGE(PG8_SA(1, 1), a1 + hstep, voffA);
            PG8_WAIT_V(8); PG8_WAIT_L(0); PG8_BAR; PG8_MMA(0, 0, At, B0); PG8_MMA(0, 1, At, B1); PG8_BAR; PG8_SCHED;
            PG8_LDA(At, 0, 1); PG8_STAGE(PG8_SB(0, 0), b2, voffB); PG8_STAGE(PG8_SB(0, 1), b2 + hstep, voffB); PG8_STAGE(PG8_SA(0, 0), a2, voffA);
            PG8_WAIT_V(8); PG8_WAIT_L(0); PG8_BAR; PG8_MMA(1, 0, At, B0); PG8_MMA(1, 1, At, B1); PG8_BAR; PG8_SCHED;
            PG8_LDB(B0, 1, 0); PG8_LDB(B1, 1, 1); PG8_SCHED; PG8_LDA(At, 1, 0); PG8_STAGE(PG8_SA(0, 1), a2 + hstep, voffA);
            PG8_WAIT_V(8); PG8_WAIT_L(0); PG8_BAR; PG8_MMA(0, 0, At, B0); PG8_MMA(0, 1, At, B1); PG8_BAR; PG8_SCHED;
            PG8_LDA(At, 1, 1); PG8_STAGE(PG8_SB(1, 0), b3, voffB); PG8_STAGE(PG8_SB(1, 1), b3 + hstep, voffB); PG8_STAGE(PG8_SA(1, 0), a3, voffA);
            PG8_WAIT_V(8); PG8_WAIT_L(0); PG8_BAR; PG8_MMA(1, 0, At, B0); PG8_MMA(1, 1, At, B1); PG8_BAR; PG8_SCHED;
            } else {
            PG8_LDB(B0, 0, 0); PG8_SCHED; PG8_LDA(At, 0, 0); PG8_STAGE(PG8_SA(1, 1), a1 + hstep, voffA);
            PG8_WAIT_L(8); PG8_BAR; PG8_WAIT_L(0); PG8_MMA(0, 0, At, B0); PG8_BAR; PG8_SCHED;
            PG8_LDB(B1, 0, 1); PG8_STAGE(PG8_SB(0, 0), b2, voffB);
            PG8_BAR; PG8_WAIT_L(0); PG8_MMA(0, 1, At, B1); PG8_BAR;
            PG8_LDA(At, 0, 1); PG8_STAGE(PG8_SA(0, 0), a2, voffA);
            PG8_BAR; PG8_WAIT_L(0); PG8_MMA(1, 0, At, B0); PG8_BAR; PG8_SCHED;
            PG8_STAGE(PG8_SB(0, 1), b2 + hstep, voffB);
            PG8_WAIT_V(6); PG8_BAR; PG8_MMA(1, 1, At, B1); PG8_BAR;
            PG8_LDB(B0, 1, 0); PG8_SCHED; PG8_LDA(At, 1, 0); PG8_STAGE(PG8_SA(0, 1), a2 + hstep, voffA);
            PG8_WAIT_L(8); PG8_BAR; PG8_WAIT_L(0); PG8_MMA(0, 0, At, B0); PG8_BAR; PG8_SCHED;
            PG8_LDB(B1, 1, 1); PG8_STAGE(PG8_SB(1, 0), b3, voffB);
            PG8_BAR; PG8_WAIT_L(0); PG8_MMA(0, 1, At, B1); PG8_BAR;
            PG8_LDA(At, 1, 1); PG8_STAGE(PG8_SA(1, 0), a3, voffA);
            PG8_BAR; PG8_WAIT_L(0); PG8_MMA(1, 0, At, B0); PG8_BAR; PG8_SCHED;
            PG8_STAGE(PG8_SB(1, 1), b3 + hstep, voffB);
            PG8_WAIT_V(6); PG8_BAR; PG8_MMA(1, 1, At, B1); PG8_BAR;
            }
        }
        if constexpr (ALIGN_EPI) { if (wr == 0) PG8_BAR; }
        if constexpr (!Epi::AFTER_DRAIN) { E(acc, cur, wr, wc, fr, fq); S.done(cur); }
        if (!has_next) break;
#pragma unroll
        for (int a = 0; a < 2; ++a)
#pragma unroll
            for (int b = 0; b < 2; ++b)
#pragma unroll
                for (int m = 0; m < 4; ++m)
#pragma unroll
                    for (int n = 0; n < 2; ++n) acc[a][b][m][n] = (f32x4){0.f, 0.f, 0.f, 0.f};
        cur = nxt; cA = nA; cB = nB; ++ui;
        if constexpr (ALIGN_EPI) { if (wr == 1) PG8_BAR; }
    }
    PG8_WAIT_V(0);
    if constexpr (!ALIGN_EPI) { if (wr == 0) PG8_BAR; }
    PG8_BAR;
    if constexpr (Epi::AFTER_DRAIN) { E.fused(acc, cur, wr, wc, fr, fq, lds, wid, lane); S.done(cur); }
#undef PG8_SA
#undef PG8_SB
#undef PG8_STAGE
#undef PG8_LDA
#undef PG8_LDB
#undef PG8_MMA
#undef PG8_WAIT_V
#undef PG8_WAIT_L
#undef PG8_BAR
#undef PG8_SCHED
}
}

constexpr int DM = 4096, BATCH = 4, SEQ = 2048, DEPTH = 2, MROWS = BATCH * SEQ;
constexpr int HD = 128, D_RG = 1024, D_NSA = 2048, D_HG = 1024;
constexpr int NIN = 11824, NPAD = 12032;
constexpr int NHEADS = 16, NKV = 2, NGRP = 8;
constexpr int NCMP = 127, NSEL = 32, TOPN = 16, WINDOW = 512;
constexpr int PC_RGX = 0, PC_RGG = 1024, PC_Q = 2048, PC_KVC = 4096, PC_KVS = 4608, PC_KVW = 5120, PC_NSAG = 5632,
              PC_HGQ = 7680, PC_HGF = 8704, PC_HGI = 9728, PC_HGG = 10752, PC_GL = 11776;
constexpr float LN_EPS = 1e-5f, RMS_EPS = 1e-6f, ALPHA = 1.41421356237309515f;
constexpr float SM_SCALE = 0.088388347648318440f;
constexpr float LOG2E = 1.4426950408889634f;

constexpr size_t MiB = 1u << 20;
constexpr size_t WS_CTL = 0, CTL_ZERO_BYTES = 1 * MiB;
constexpr size_t WS_WIN  = 2 * MiB;
constexpr size_t WS_WOUT = 190 * MiB;
constexpr size_t WS_W1T  = 254 * MiB;
constexpr size_t WS_W2T  = 262 * MiB;
constexpr size_t WS_RGW  = 263 * MiB;
constexpr size_t WS_MOD  = 264 * MiB;
constexpr size_t WS_U    = 266 * MiB;
constexpr size_t WS_P    = 330 * MiB;
constexpr size_t WS_XRES = 518 * MiB;
constexpr size_t WS_V    = 646 * MiB;
constexpr size_t WS_YCAT = 774 * MiB;
constexpr size_t WS_OACC = 838 * MiB;
constexpr size_t WS_HS   = 902 * MiB;
constexpr size_t WS_HDEC = 966 * MiB;
constexpr size_t WS_RGSA = 967 * MiB;
constexpr size_t WS_RGSH = 967 * MiB + 512 * 1024;
constexpr size_t WS_RGC  = 968 * MiB;
constexpr size_t WS_KCMP = 969 * MiB;
constexpr size_t WS_VCMP = 969 * MiB + 256 * 1024;
constexpr size_t WS_SEL  = 970 * MiB;
constexpr size_t WS_END  = 972 * MiB;

constexpr int CW_TMO = 0;
constexpr int CW_BAR = 4096;
constexpr int CW_Q = 8192;

constexpr int RING_BYTES = 131072;
constexpr int LDSCTL_OFF = 143360, MISC_OFF = LDSCTL_OFF + 320;
constexpr int LDS_BYTES = 147456;
constexpr int NWAVES = 8;

#define GAS __attribute__((address_space(1)))
#define LAS __attribute__((address_space(3)))
typedef unsigned short bf16;
typedef unsigned v4u __attribute__((ext_vector_type(4)));
typedef unsigned v2u __attribute__((ext_vector_type(2)));
typedef float f32x4 __attribute__((ext_vector_type(4)));
typedef float f32x16 __attribute__((ext_vector_type(16)));
typedef short bf16x8 __attribute__((ext_vector_type(8)));
typedef short s16x4 __attribute__((ext_vector_type(4)));
typedef GAS unsigned gu32;
#define RLX_AGENT __ATOMIC_RELAXED, __HIP_MEMORY_SCOPE_AGENT
#define LDS_WAIT() asm volatile("s_waitcnt lgkmcnt(0)" ::: "memory")
#define VM_WAIT() asm volatile("s_waitcnt vmcnt(0)" ::: "memory")
#define SBAR() __builtin_amdgcn_sched_barrier(0)
__device__ __forceinline__ unsigned f2bf(float f) { unsigned u = __builtin_bit_cast(unsigned, f); return (u + 0x7fffu + ((u >> 16) & 1u)) >> 16; }
__device__ __forceinline__ unsigned pk2(float lo, float hi) { return f2bf(lo) | (f2bf(hi) << 16); }
__device__ __forceinline__ float bf2f(unsigned h) { return __builtin_bit_cast(float, h << 16); }
__device__ __forceinline__ float bflo(unsigned w) { return __builtin_bit_cast(float, w << 16); }
__device__ __forceinline__ float bfhi(unsigned w) { return __builtin_bit_cast(float, w & 0xffff0000u); }
__device__ __forceinline__ float sigm(float x) { return 1.0f / (1.0f + __expf(-x)); }
__device__ __forceinline__ float silu(float x) { return x / (1.0f + __expf(-x)); }
__device__ __forceinline__ int crow(int r, int hi) { return (r & 3) + 8 * (r >> 2) + 4 * hi; }
__device__ __forceinline__ unsigned cvtpk(float lo, float hi) { unsigned r; asm volatile("v_cvt_pk_bf16_f32 %0, %1, %2" : "=v"(r) : "v"(lo), "v"(hi)); return r; }
__device__ __forceinline__ float wave_sum(float v) {
#pragma unroll
    for (int o = 1; o < 64; o <<= 1) v += __shfl_xor(v, o);
    return v;
}
#define XB_TMO      128
#define XB_XCNT(j)  (256  + 64 * (j))
#define XB_XSUB(j)  (1280 + 64 * (j))
#define XB_XGEN(j)  (2304 + 64 * (j))
#define XB_TOP      3328
#define XB_TOPGEN   3392
#define XCD_BAR_WORDS 3456
#define XB_SPIN_CAP (1u << 18)

__device__ __forceinline__ unsigned xb_ld(unsigned* p)              { return __hip_atomic_load(p, __ATOMIC_RELAXED, __HIP_MEMORY_SCOPE_AGENT); }
__device__ __forceinline__ unsigned xb_add(unsigned* p, unsigned v) { return __hip_atomic_fetch_add(p, v, __ATOMIC_RELAXED, __HIP_MEMORY_SCOPE_AGENT); }
__device__ __forceinline__ unsigned xb_xcc_id() { return (unsigned)__builtin_amdgcn_s_getreg((3 << 11) | 20) & 0xFu; }
#define XB_SPIN(cond, bar) do { unsigned _sp = 0; while (cond) { __builtin_amdgcn_s_sleep(1); \
    if ((++_sp & 255u) == 0u) { if (xb_ld(&(bar)[XB_TMO])) break; if (_sp > XB_SPIN_CAP) { atomicAdd(&(bar)[XB_TMO], 1u); break; } } } } while (0)

struct XcdBarrier {
    unsigned* bar; unsigned x;
    volatile LAS unsigned* st;
};

__device__ __forceinline__ XcdBarrier xcd_barrier_post(unsigned* bar, volatile LAS unsigned* st) {
    XcdBarrier b; b.bar = bar; b.x = xb_xcc_id(); b.st = st;
    if (threadIdx.x == 0) (void)xb_add(&bar[XB_XCNT(b.x)], 1u);
    return b;
}
__device__ __forceinline__ void xcd_barrier_complete(unsigned* bar, unsigned x, unsigned& nloc, unsigned& nx) {
    const unsigned G = gridDim.x * gridDim.y * gridDim.z;
    unsigned sum, cnt, mine, sp = 0u;
    for (;;) {
        sum = 0u; cnt = 0u; mine = 0u;
#pragma unroll
        for (unsigned j = 0; j < 16; ++j) { const unsigned c = xb_ld(&bar[XB_XCNT(j)]); sum += c; cnt += (c > 0u) ? 1u : 0u; mine = (j == x) ? c : mine; }
        if (sum == G) break;
        __builtin_amdgcn_s_sleep(1);
        if ((++sp & 255u) == 0u) { if (xb_ld(&bar[XB_TMO])) break; if (sp > XB_SPIN_CAP) { atomicAdd(&bar[XB_TMO], 1u); break; } }
    }
    nloc = mine > 0u ? mine : 1u; nx = cnt > 0u ? cnt : 1u;
}

__device__ __forceinline__ void xcd_barrier(const XcdBarrier& b) {
    asm volatile("s_waitcnt vmcnt(0)" ::: "memory");
    __syncthreads();
    if (threadIdx.x == 0) {
        unsigned* bar = b.bar;
        __builtin_amdgcn_s_waitcnt(0);
        unsigned nloc = b.st[0], nx = b.st[1];
        if (nloc == 0u) { xcd_barrier_complete(bar, b.x, nloc, nx); b.st[0] = nloc; b.st[1] = nx; }
        const unsigned old = xb_add(&bar[XB_XSUB(b.x)], 1u);
        const unsigned gen = old / nloc;
        if (old + 1u == (gen + 1u) * nloc) {
            __builtin_amdgcn_fence(__ATOMIC_RELEASE, "agent");
            asm volatile("s_waitcnt vmcnt(0)" ::: "memory");
            const unsigned og = xb_add(&bar[XB_TOP], 1u);
            const unsigned tg = og / nx;
            if (og + 1u == (tg + 1u) * nx) xb_add(&bar[XB_TOPGEN], 1u);
            else XB_SPIN(xb_ld(&bar[XB_TOPGEN]) == tg, bar);
            __builtin_amdgcn_fence(__ATOMIC_ACQUIRE, "agent");
            xb_add(&bar[XB_XGEN(b.x)], 1u);
            asm volatile("s_waitcnt vmcnt(0)" ::: "memory");
        } else {
            XB_SPIN(xb_ld(&bar[XB_XGEN(b.x)]) == gen, bar);
            __builtin_amdgcn_fence(__ATOMIC_ACQUIRE, "agent");
            asm volatile("s_waitcnt vmcnt(0)" ::: "memory");
        }
    }
    __syncthreads();
}

struct Frame {
    LAS unsigned char* lds;
    volatile LAS unsigned* MISC;
    gu32* ctl;
    int tid, lane, wave, vcu, G;
    unsigned char* ws; float* out;
    const float* const* in;
};
__device__ __forceinline__ bf16* ws_bf(const Frame& F, size_t off) { return (bf16*)(F.ws + off); }
__device__ __forceinline__ float* ws_f(const Frame& F, size_t off) { return (float*)(F.ws + off); }

__device__ __forceinline__ int launder_u(int v) { asm volatile("" : "+v"(v)); return __builtin_amdgcn_readfirstlane(v); }
template <class T> __device__ __forceinline__ T* launder_p(T* p) { const unsigned long long a = (unsigned long long)p;
    const unsigned lo = (unsigned)launder_u((int)(unsigned)a), hi = (unsigned)launder_u((int)(unsigned)(a >> 32)); return (T*)(((unsigned long long)hi << 32) | lo); }
__device__ __forceinline__ void launder(Frame& F) {
    F.ws = launder_p(F.ws); F.out = launder_p(F.out); F.ctl = (gu32*)launder_p((unsigned*)F.ctl);
    F.G = launder_u(F.G); F.vcu = launder_u(F.vcu);
    { const unsigned lb = (unsigned)launder_u((int)(unsigned)(uintptr_t)F.lds); F.lds = (LAS unsigned char*)(uintptr_t)lb; F.MISC = (volatile LAS unsigned*)(F.lds + MISC_OFF); }
    { int t = threadIdx.x; asm volatile("" : "+v"(t)); F.tid = t; F.lane = t & 63; F.wave = __builtin_amdgcn_readfirstlane(t >> 6); }
}

__device__ __forceinline__ int q_next(Frame& F, int qid) {
    __syncthreads();
    if (F.tid == 0) F.MISC[0] = __hip_atomic_fetch_add(F.ctl + CW_Q + 64 * qid, 1u, RLX_AGENT);
    __syncthreads();
    return (int)F.MISC[0];
}

__device__ __forceinline__ int win_src_col(int np) { return np < 5632 ? np : (np < 11776 ? np + 48 : (np < 11824 ? np - 11776 + 5632 : -1)); }
template <int MODE>
__device__ __forceinline__ void transpose_item(const float* W, int K, int N, bf16* WT, LAS float* scr, int kb, int nb, int lane) {
    const int k0 = 64 * kb, n0 = 32 * nb;
    int nsrc = n0 + (lane & 31); if (MODE == 1) nsrc = win_src_col(nsrc);
#pragma unroll 8
    for (int i = 0; i < 32; ++i) { const int kk = 2 * i + (lane >> 5); float v = 0.f; if (nsrc >= 0) v = W[(size_t)(k0 + kk) * N + nsrc]; scr[kk * 33 + (lane & 31)] = v; }
    LDS_WAIT(); asm volatile("" ::: "memory");
    const int c = lane & 7;
#pragma unroll
    for (int j = 0; j < 4; ++j) { const int n = (lane >> 3) + 8 * j; const LAS float* s = scr + (8 * c) * 33 + n;
        v4u o; o.x = pk2(s[0 * 33], s[1 * 33]); o.y = pk2(s[2 * 33], s[3 * 33]); o.z = pk2(s[4 * 33], s[5 * 33]); o.w = pk2(s[6 * 33], s[7 * 33]);
        *(GAS v4u*)(WT + (size_t)(n0 + n) * K + k0 + 8 * c) = o; }
    LDS_WAIT(); asm volatile("" ::: "memory");
}

__device__ __forceinline__ void ada_item(Frame& F, int item) {
    const int l = item / 384, n0 = (item % 384) * 32;
    const float* W = F.in[2] + (size_t)l * DM * 12288;
    const LAS float* cl = (const LAS float*)F.lds;
    LAS float* red = (LAS float*)(F.lds + 65536);
    const int kq = F.lane >> 3, nq = F.lane & 7;
    f32x4 acc[4];
#pragma unroll
    for (int b = 0; b < 4; ++b) acc[b] = (f32x4){0.f, 0.f, 0.f, 0.f};
#pragma unroll 8
    for (int i = 0; i < 64; ++i) {
        const int k = 64 * i + 8 * F.wave + kq;
        const f32x4 w = *(const GAS f32x4*)(W + (size_t)k * 12288 + n0 + 4 * nq);
#pragma unroll
        for (int b = 0; b < 4; ++b) acc[b] += w * cl[b * DM + k];
    }
#pragma unroll
    for (int b = 0; b < 4; ++b)
#pragma unroll
        for (int e = 0; e < 4; ++e) { float v = acc[b][e]; v += __shfl_xor(v, 8); v += __shfl_xor(v, 16); v += __shfl_xor(v, 32);
            if (kq == 0) red[(F.wave * 4 + b) * 32 + 4 * nq + e] = v; }
    __syncthreads();
    if (F.tid < 128) { const int b = F.tid >> 5, n = F.tid & 31; float s = 0.f;
#pragma unroll
        for (int w = 0; w < 8; ++w) s += red[(w * 4 + b) * 32 + n];
        ws_f(F, WS_MOD)[(size_t)(l * 4 + b) * 12288 + n0 + n] = s + F.in[3][l * 12288 + n0 + n]; }
    __syncthreads();
}

__device__ __forceinline__ void p0_prologue(Frame& F) {
    { LAS float* cl = (LAS float*)F.lds;
      for (int i = F.tid; i < 4 * DM / 4; i += NWAVES * 64) ((LAS f32x4*)cl)[i] = ((const GAS f32x4*)F.in[1])[i];
      __syncthreads();
      for (int it = F.vcu; it < 768; it += F.G) ada_item(F, it);
      __syncthreads(); }
    LAS float* scr = (LAS float*)(F.lds + F.wave * 16384);
    const int gw = F.vcu * NWAVES + F.wave, NGW = F.G * NWAVES;
    constexpr int I_WIN = 64 * (NPAD / 32), I_WOUT = 64 * (DM / 32), I_W1 = 64 * 8, I_W2 = 4 * 4, I_RG = 2 * 4;
    constexpr int NIT = 2 * I_WIN + 2 * I_WOUT + 4 * I_W1 + 4 * I_W2 + 32 * I_RG;
    for (int it = gw; it < NIT; it += NGW) {
        int r = it;
        if (r < 2 * I_WIN) { const int l = r / I_WIN; r -= l * I_WIN; const int nblk = NPAD / 32;
            transpose_item<1>(F.in[4] + (size_t)l * DM * NIN, DM, NIN, ws_bf(F, WS_WIN) + (size_t)l * NPAD * DM, scr, r / nblk, r % nblk, F.lane); continue; }
        r -= 2 * I_WIN;
        if (r < 2 * I_WOUT) { const int l = r / I_WOUT; r -= l * I_WOUT; const int nblk = DM / 32;
            transpose_item<0>(F.in[20] + (size_t)l * DM * DM, DM, DM, ws_bf(F, WS_WOUT) + (size_t)l * DM * DM, scr, r / nblk, r % nblk, F.lane); continue; }
        r -= 2 * I_WOUT;
        if (r < 4 * I_W1) { const int lk = r / I_W1; r -= lk * I_W1; const int l = lk >> 1, kv = lk & 1;
            transpose_item<0>((kv ? F.in[16] : F.in[14]) + (size_t)l * 4096 * 256, 4096, 256, ws_bf(F, WS_W1T) + (size_t)lk * 256 * 4096, scr, r / 8, r % 8, F.lane); continue; }
        r -= 4 * I_W1;
        if (r < 4 * I_W2) { const int lk = r / I_W2; r -= lk * I_W2; const int l = lk >> 1, kv = lk & 1;
            transpose_item<0>((kv ? F.in[17] : F.in[15]) + (size_t)l * 256 * 128, 256, 128, ws_bf(F, WS_W2T) + (size_t)lk * 128 * 256, scr, r / 4, r % 4, F.lane); continue; }
        r -= 4 * I_W2;
        { const int mi = r / I_RG; r -= mi * I_RG; const int l = mi >> 4, gate = (mi >> 3) & 1, n = mi & 7;
            transpose_item<0>((gate ? F.in[9] : F.in[7]) + (size_t)(l * 8 + n) * 128 * 128, 128, 128, ws_bf(F, WS_RGW) + (size_t)mi * 128 * 128, scr, r / 4, r % 4, F.lane); }
    }
    { const int g = F.vcu * NWAVES * 64 + F.tid;
      if (g < 2 * 8 * 128 / 2) { const int kv = g >> 9, rest = g & 511, bg = rest >> 6, e = rest & 63;
          ((unsigned*)(F.ws + (kv ? WS_VCMP : WS_KCMP)))[(size_t)(bg * 128 + 127) * 64 + e] = 0u; } }
}

__device__ __forceinline__ void p1_u0(Frame& F) {
    const int gw = F.vcu * NWAVES + F.wave, NGW = F.G * NWAVES;
    const float* mod = ws_f(F, WS_MOD);
    bf16* U = ws_bf(F, WS_U);
    for (int m = gw; m < MROWS; m += NGW) {
        const int b = m / SEQ;
        const GAS f32x4* xr = (const GAS f32x4*)(F.in[0] + (size_t)m * DM);
        const GAS f32x4* sh = (const GAS f32x4*)(mod + (size_t)b * 12288);
        const GAS f32x4* sc = (const GAS f32x4*)(mod + (size_t)b * 12288 + DM);
        GAS v2u* o = (GAS v2u*)(U + (size_t)m * DM);
#pragma unroll 4
        for (int j = 0; j < 16; ++j) { const int idx = 64 * j + F.lane; const f32x4 v = xr[idx] * (sc[idx] + 1.0f) + sh[idx];
            v2u w; w.x = pk2(v[0], v[1]); w.y = pk2(v[2], v[3]); o[idx] = w; }
    }
}

__device__ __forceinline__ void ln_phase(Frame& F, int l, float* xout, bool unext) {
    const int gw = F.vcu * NWAVES + F.wave, NGW = F.G * NWAVES;
    const float* Vb = ws_f(F, WS_V);
    const float* mod = ws_f(F, WS_MOD) + (size_t)(l + 1) * 4 * 12288;
    bf16* U = ws_bf(F, WS_U);
    const GAS f32x4* g4 = (const GAS f32x4*)(F.in[21] + (size_t)l * DM);
    const GAS f32x4* b4 = (const GAS f32x4*)(F.in[22] + (size_t)l * DM);
    for (int m = gw; m < MROWS; m += NGW) {
        const int b = m / SEQ;
        const GAS f32x4* vr = (const GAS f32x4*)(Vb + (size_t)m * DM);
        f32x4 v[16]; float s = 0.f;
#pragma unroll
        for (int j = 0; j < 16; ++j) { v[j] = vr[64 * j + F.lane]; s += (v[j][0] + v[j][1]) + (v[j][2] + v[j][3]); }
        const float mean = wave_sum(s) * (1.0f / DM); float s2 = 0.f;
#pragma unroll
        for (int j = 0; j < 16; ++j) { v[j] = v[j] - mean; s2 += (v[j][0] * v[j][0] + v[j][1] * v[j][1]) + (v[j][2] * v[j][2] + v[j][3] * v[j][3]); }
        const float rstd = 1.0f / sqrtf(wave_sum(s2) * (1.0f / DM) + LN_EPS);
        GAS f32x4* xo = (GAS f32x4*)(xout + (size_t)m * DM);
        if (unext) {
            const GAS f32x4* sh = (const GAS f32x4*)(mod + (size_t)b * 12288);
            const GAS f32x4* sc = (const GAS f32x4*)(mod + (size_t)b * 12288 + DM);
            GAS v2u* o = (GAS v2u*)(U + (size_t)m * DM);
#pragma unroll
            for (int j = 0; j < 16; ++j) { const int idx = 64 * j + F.lane; const f32x4 y = v[j] * rstd * g4[idx] + b4[idx]; xo[idx] = y;
                const f32x4 u = y * (sc[idx] + 1.0f) + sh[idx]; v2u w; w.x = pk2(u[0], u[1]); w.y = pk2(u[2], u[3]); o[idx] = w; }
        } else {
#pragma unroll
            for (int j = 0; j < 16; ++j) { const int idx = 64 * j + F.lane; xo[idx] = v[j] * rstd * g4[idx] + b4[idx]; }
        }
    }
}

__device__ __forceinline__ f32x16 mfma32(bf16x8 a, bf16x8 b, f32x16 c) { return __builtin_amdgcn_mfma_f32_32x32x16_bf16(a, b, c, 0, 0, 0); }
__device__ __forceinline__ f32x4 mfma16(bf16x8 a, bf16x8 b, f32x4 c) { return __builtin_amdgcn_mfma_f32_16x16x32_bf16(a, b, c, 0, 0, 0); }
__device__ __forceinline__ bf16x8 as_bf16x8(v4u w) { return __builtin_bit_cast(bf16x8, w); }

template <int PASS>
__device__ __forceinline__ void rg_item(Frame& F, int l, int item) {
    const int n = item & 7, c = (item >> 3) & 31, b = item >> 8;
    LAS float* xcf = (LAS float*)(F.lds);
    LAS bf16*  xcb = (LAS bf16*)(F.lds + 32768);
    LAS float* aL  = (LAS float*)(F.lds + 50176);
    LAS float* bxL = (LAS float*)(F.lds + 82944);
    LAS float* qs  = (LAS float*)(F.lds + 115712);
    const bf16* P = ws_bf(F, WS_P);
    const int d = F.tid & 127, tq = F.tid >> 7, ch = n * 128 + d;
    const size_t rowbase = (size_t)b * SEQ + 64 * c;
    {
        const float w0 = F.in[5][(l * 4 + 0) * 1024 + ch], w1 = F.in[5][(l * 4 + 1) * 1024 + ch], w2 = F.in[5][(l * 4 + 2) * 1024 + ch],
                    w3 = F.in[5][(l * 4 + 3) * 1024 + ch], cb = F.in[6][l * 1024 + ch];
        float xv[19];
#pragma unroll
        for (int i = 0; i < 19; ++i) { const int tl = 64 * c + 16 * tq - 3 + i; xv[i] = (tl >= 0) ? bf2f(P[((size_t)b * SEQ + tl) * NPAD + PC_RGX + ch]) : 0.f; }
#pragma unroll
        for (int i = 0; i < 16; ++i) { const float y = cb + w0 * xv[i] + w1 * xv[i + 1] + w2 * xv[i + 2] + w3 * xv[i + 3]; const int t = 16 * tq + i;
            xcf[t * 128 + d] = y; xcb[t * 136 + d] = (bf16)f2bf(y); }
    }
    __syncthreads();
    {
        const int rt = F.wave & 1, ct = F.wave >> 1, r32 = F.lane & 31, hi = F.lane >> 5;
        const bf16* WA = ws_bf(F, WS_RGW) + (size_t)((l * 2 + 0) * 8 + n) * 16384;
        const bf16* WX = ws_bf(F, WS_RGW) + (size_t)((l * 2 + 1) * 8 + n) * 16384;
        f32x16 ga = {}, gx = {};
#pragma unroll
        for (int s = 0; s < 8; ++s) {
            const bf16x8 a = *(const LAS bf16x8*)(xcb + (32 * rt + r32) * 136 + 16 * s + 8 * hi);
            const bf16x8 wa = *(const GAS bf16x8*)(WA + (32 * ct + r32) * 128 + 16 * s + 8 * hi);
            const bf16x8 wx = *(const GAS bf16x8*)(WX + (32 * ct + r32) * 128 + 16 * s + 8 * hi);
            ga = mfma32(a, wa, ga); gx = mfma32(a, wx, gx);
        }
        const int e = 32 * ct + r32, che = n * 128 + e;
        const float ba_ = F.in[8][l * 1024 + che], bx_ = F.in[10][l * 1024 + che], lam = F.in[11][l * 1024 + che];
        const float sp8 = 8.0f * log1pf(__expf(-lam));
#pragma unroll
        for (int r = 0; r < 16; ++r) { const int t = 32 * rt + crow(r, hi);
            const float rg = sigm(ga[r] + ba_), ig = sigm(gx[r] + bx_);
            const float la = -sp8 * rg; const float a = __expf(la); float mult = sqrtf(-expm1f(2.0f * la)); if (c == 0 && t == 0) mult = 1.0f;
            aL[t * 128 + e] = a; bxL[t * 128 + e] = mult * ig * xcf[t * 128 + e]; }
    }
    __syncthreads();
    {
        float av[16], bv[16];
#pragma unroll
        for (int i = 0; i < 16; ++i) { av[i] = aL[(16 * tq + i) * 128 + d]; bv[i] = bxL[(16 * tq + i) * 128 + d]; }
        float Ap = 1.0f, H = 0.f;
#pragma unroll
        for (int i = 0; i < 16; ++i) { H = av[i] * H + bv[i]; Ap *= av[i]; }
        qs[(tq * 128 + d) * 2 + 0] = Ap; qs[(tq * 128 + d) * 2 + 1] = H;
        __syncthreads();
        float hin = 0.f, atot = 1.0f;
        if (PASS == 3) hin = ws_f(F, WS_RGC)[(size_t)(b * 32 + c) * 1024 + ch];
        for (int q = 0; q < tq; ++q) { const float aq = qs[(q * 128 + d) * 2], hq = qs[(q * 128 + d) * 2 + 1]; hin = aq * hin + hq; atot *= aq; }
        if (PASS == 1) {
            if (tq == 3) { ws_f(F, WS_RGSA)[(size_t)(b * 32 + c) * 1024 + ch] = atot * Ap; ws_f(F, WS_RGSH)[(size_t)(b * 32 + c) * 1024 + ch] = Ap * hin + H; }
        } else {
            bf16* Y = ws_bf(F, WS_YCAT);
            float h = hin;
#pragma unroll
            for (int i = 0; i < 16; ++i) { h = av[i] * h + bv[i]; const size_t row = rowbase + 16 * tq + i;
                const float gt = bf2f(P[row * NPAD + PC_RGG + ch]);
                Y[row * DM + ch] = (bf16)f2bf(h * silu(gt)); }
        }
    }
    __syncthreads();
}
__device__ __forceinline__ void rg_pass2(Frame& F) {
    const int g = F.vcu * NWAVES * 64 + F.tid;
    if (g < BATCH * D_RG) { const int b = g >> 10, ch = g & 1023; float h = 0.f;
        const float* A = ws_f(F, WS_RGSA); const float* Hh = ws_f(F, WS_RGSH); float* C = ws_f(F, WS_RGC);
#pragma unroll 8
        for (int c = 0; c < 32; ++c) { const size_t idx = (size_t)(b * 32 + c) * 1024 + ch; C[idx] = h; h = A[idx] * h + Hh[idx]; } }
}

__device__ __forceinline__ float hg_lower_bound(const Frame& F, int l, int ch) {
    if (l == 0) return 0.f;
    return 1.0f / (1.0f + __expf(F.in[18][ch] - F.in[18][1024 + ch]));
}
__device__ __forceinline__ void hg_fk(float z, float lb, int l, float& lf, float& kk) {
    if (l == 0) { lf = fminf(z, 0.f) - log1pf(__expf(-fabsf(z))); kk = sigm(-z); }
    else { const float sg = sigm(z); lf = __logf(lb + (1.0f - lb) * sg); kk = (1.0f - lb) * sigm(-z); }
}
__device__ __forceinline__ void hg1_item(Frame& F, int l, int item) {
    const int c = item & 31, bh = item >> 5, b = bh >> 3, h = bh & 7;
    LAS float* part = (LAS float*)(F.lds);
    LAS bf16* kdT = (LAS bf16*)(F.lds + 2048);
    LAS bf16* vT  = (LAS bf16*)(F.lds + 2048 + 18432);
    const bf16* P = ws_bf(F, WS_P);
    const int k = F.tid & 127, tq = F.tid >> 7, ch = h * 128 + k;
    const size_t row0 = (size_t)b * SEQ + 64 * c + 16 * tq;
    const float lb = hg_lower_bound(F, l, ch);
    float lf[16], kk[16]; float ps = 0.f;
#pragma unroll
    for (int i = 0; i < 16; ++i) { const float z = bf2f(P[(row0 + i) * NPAD + PC_HGF + ch]); hg_fk(z, lb, l, lf[i], kk[i]); ps += lf[i]; }
    part[tq * 128 + k] = ps;
    unsigned vv[8];
#pragma unroll
    for (int i = 0; i < 8; ++i) { const unsigned lo = P[(row0 + 2 * i) * NPAD + PC_HGI + ch], hi2 = P[(row0 + 2 * i + 1) * NPAD + PC_HGI + ch]; vv[i] = lo | (hi2 << 16); }
    *(LAS v4u*)(vT + k * 72 + 16 * tq) = (v4u){vv[0], vv[1], vv[2], vv[3]};
    *(LAS v4u*)(vT + k * 72 + 16 * tq + 8) = (v4u){vv[4], vv[5], vv[6], vv[7]};
    __syncthreads();
    {
        float off = 0.f, tot = 0.f;
#pragma unroll
        for (int q = 0; q < 4; ++q) { const float pq = part[q * 128 + k]; tot += pq; if (q < tq) off += pq; }
        float run = off; unsigned w[8];
#pragma unroll
        for (int i = 0; i < 8; ++i) { run += lf[2 * i]; const float k0 = kk[2 * i] * __expf(tot - run); run += lf[2 * i + 1]; const float k1 = kk[2 * i + 1] * __expf(tot - run); w[i] = pk2(k0, k1); }
        *(LAS v4u*)(kdT + k * 72 + 16 * tq) = (v4u){w[0], w[1], w[2], w[3]};
        *(LAS v4u*)(kdT + k * 72 + 16 * tq + 8) = (v4u){w[4], w[5], w[6], w[7]};
        if (tq == 0) ws_f(F, WS_HDEC)[(size_t)item * 128 + k] = __expf(tot);
    }
    __syncthreads();
    {
        const int vt = F.wave >> 1, kt0 = 2 * (F.wave & 1), r32 = F.lane & 31, hi = F.lane >> 5;
        f32x16 a0 = {}, a1 = {};
#pragma unroll
        for (int s = 0; s < 4; ++s) {
            const bf16x8 a = *(const LAS bf16x8*)(vT + (32 * vt + r32) * 72 + 16 * s + 8 * hi);
            const bf16x8 b0 = *(const LAS bf16x8*)(kdT + (32 * kt0 + r32) * 72 + 16 * s + 8 * hi);
            const bf16x8 b1 = *(const LAS bf16x8*)(kdT + (32 * (kt0 + 1) + r32) * 72 + 16 * s + 8 * hi);
            a0 = mfma32(a, b0, a0); a1 = mfma32(a, b1, a1);
        }
        float* HS = ws_f(F, WS_HS) + (size_t)item * 16384;
#pragma unroll
        for (int r = 0; r < 16; ++r) { const int v = 32 * vt + crow(r, hi); HS[v * 128 + 32 * kt0 + r32] = a0[r]; HS[v * 128 + 32 * kt0 + 32 + r32] = a1[r]; }
    }
    __syncthreads();
}
__device__ __forceinline__ void hg_pass2(Frame& F) {
    float* HS = ws_f(F, WS_HS); const float* DEC = ws_f(F, WS_HDEC);
    for (int g = F.vcu * NWAVES * 64 + F.tid; g < 32 * 4096; g += F.G * NWAVES * 64) {
        const int bh = g >> 12, e4 = g & 4095, k4 = (e4 & 31) * 4;
        f32x4 S = {0.f, 0.f, 0.f, 0.f};
#pragma unroll 8
        for (int c = 0; c < 32; ++c) { GAS f32x4* p = (GAS f32x4*)(HS + ((size_t)(bh * 32 + c) * 16384) + e4 * 4);
            const f32x4 tmp = *p; const f32x4 d4 = *(const GAS f32x4*)(DEC + (size_t)(bh * 32 + c) * 128 + k4); *p = S; S = S * d4 + tmp; }
    }
}
__device__ __forceinline__ void hg3_item(Frame& F, int l, int item) {
    const int c = item & 31, bh = item >> 5, b = bh >> 3, h = bh & 7;
    LAS float* part = (LAS float*)(F.lds);
    LAS bf16* qi   = (LAS bf16*)(F.lds + 2048);
    LAS bf16* qd1  = (LAS bf16*)(F.lds + 19456);
    LAS bf16* kd00 = (LAS bf16*)(F.lds + 28160);
    LAS bf16* kd10 = (LAS bf16*)(F.lds + 36864);
    LAS bf16* kd11 = (LAS bf16*)(F.lds + 45568);
    LAS bf16* sT   = (LAS bf16*)(F.lds + 54272);
    LAS bf16* vT   = (LAS bf16*)(F.lds + 89088);
    LAS bf16* Abf  = (LAS bf16*)(F.lds + 107520);
    LAS float* ssq = (LAS float*)(F.lds + 116736);
    const bf16* P = ws_bf(F, WS_P);
    const int k = F.tid & 127, tq = F.tid >> 7, ch = h * 128 + k;
    const size_t row0 = (size_t)b * SEQ + 64 * c + 16 * tq;
    const float lb = hg_lower_bound(F, l, ch);
    float lf[16], kk[16], qv[16]; float ps = 0.f;
#pragma unroll
    for (int i = 0; i < 16; ++i) { const float z = bf2f(P[(row0 + i) * NPAD + PC_HGF + ch]); hg_fk(z, lb, l, lf[i], kk[i]); ps += lf[i];
        qv[i] = silu(bf2f(P[(row0 + i) * NPAD + PC_HGQ + ch])); }
    part[tq * 128 + k] = ps;
    {
        unsigned vv[8];
#pragma unroll
        for (int i = 0; i < 8; ++i) { const unsigned lo = P[(row0 + 2 * i) * NPAD + PC_HGI + ch], hi2 = P[(row0 + 2 * i + 1) * NPAD + PC_HGI + ch]; vv[i] = lo | (hi2 << 16); }
        *(LAS v4u*)(vT + k * 72 + 16 * tq) = (v4u){vv[0], vv[1], vv[2], vv[3]};
        *(LAS v4u*)(vT + k * 72 + 16 * tq + 8) = (v4u){vv[4], vv[5], vv[6], vv[7]};
    }
    {
        const int v = F.tid >> 2, k0 = (F.tid & 3) * 32;
        const GAS f32x4* src = (const GAS f32x4*)(ws_f(F, WS_HS) + (size_t)item * 16384 + v * 128 + k0);
#pragma unroll
        for (int j = 0; j < 4; ++j) { const f32x4 x0 = src[2 * j], x1 = src[2 * j + 1];
            *(LAS v4u*)(sT + v * 136 + k0 + 8 * j) = (v4u){pk2(x0[0], x0[1]), pk2(x0[2], x0[3]), pk2(x1[0], x1[1]), pk2(x1[2], x1[3])}; }
    }
    __syncthreads();
    {
        float off = 0.f;
#pragma unroll
        for (int q = 0; q < 4; ++q) { const float pq = part[q * 128 + k]; if (q < tq) off += pq; }
        const float bref1 = part[k] + part[128 + k];
        float run = off;
#pragma unroll
        for (int i = 0; i < 16; ++i) { run += lf[i]; const int t = 16 * tq + i;
            qi[t * 136 + k] = (bf16)f2bf(qv[i] * __expf(run));
            if (tq < 2) { kd00[t * 136 + k] = (bf16)f2bf(kk[i] * __expf(-run)); kd10[t * 136 + k] = (bf16)f2bf(kk[i] * __expf(bref1 - run)); }
            else { qd1[(t - 32) * 136 + k] = (bf16)f2bf(qv[i] * __expf(run - bref1)); kd11[(t - 32) * 136 + k] = (bf16)f2bf(kk[i] * __expf(bref1 - run)); } }
    }
    __syncthreads();
    const int r32 = F.lane & 31, hi = F.lane >> 5;
    if (F.wave < 4) {
        const int I = (F.wave == 0 || F.wave == 3) ? 0 : 1, J = (F.wave == 2 || F.wave == 3) ? 1 : 0;
        f32x16 a = {};
        if (F.wave != 3) {
            const LAS bf16* Aop = (F.wave == 0) ? qi : qd1;
            const LAS bf16* Bop = (F.wave == 0) ? kd00 : (F.wave == 1 ? kd10 : kd11);
#pragma unroll
            for (int s = 0; s < 8; ++s) a = mfma32(*(const LAS bf16x8*)(Aop + r32 * 136 + 16 * s + 8 * hi), *(const LAS bf16x8*)(Bop + r32 * 136 + 16 * s + 8 * hi), a);
        }
#pragma unroll
        for (int r = 0; r < 16; ++r) { const int tt = crow(r, hi); float x = a[r]; if (I == J && r32 > tt) x = 0.f;
            Abf[(32 * I + tt) * 72 + 32 * J + r32] = (bf16)f2bf(x); }
    }
    __syncthreads();
    {
        const int I = F.wave & 1, vt = F.wave >> 1;
        f32x16 o = {};
#pragma unroll
        for (int s = 0; s < 8; ++s) o = mfma32(*(const LAS bf16x8*)(qi + (32 * I + r32) * 136 + 16 * s + 8 * hi), *(const LAS bf16x8*)(sT + (32 * vt + r32) * 136 + 16 * s + 8 * hi), o);
#pragma unroll
        for (int s = 0; s < 4; ++s) if (s < 2 * (I + 1)) o = mfma32(*(const LAS bf16x8*)(Abf + (32 * I + r32) * 72 + 16 * s + 8 * hi), *(const LAS bf16x8*)(vT + (32 * vt + r32) * 72 + 16 * s + 8 * hi), o);
#pragma unroll
        for (int r = 0; r < 16; ++r) { float ss = o[r] * o[r];
            ss += __shfl_xor(ss, 1); ss += __shfl_xor(ss, 2); ss += __shfl_xor(ss, 4); ss += __shfl_xor(ss, 8); ss += __shfl_xor(ss, 16);
            if (r32 == 0) ssq[(32 * I + crow(r, hi)) * 4 + vt] = ss; }
        __syncthreads();
        const int v = 32 * vt + r32; const float ng = F.in[19][l * 128 + v];
        bf16* Y = ws_bf(F, WS_YCAT);
#pragma unroll
        for (int r = 0; r < 16; ++r) { const int t = 32 * I + crow(r, hi);
            const float tot = (ssq[t * 4] + ssq[t * 4 + 1]) + (ssq[t * 4 + 2] + ssq[t * 4 + 3]);
            const float rs = 1.0f / sqrtf(tot * (1.0f / 128.0f) + RMS_EPS);
            const size_t row = (size_t)b * SEQ + 64 * c + t;
            const float gt = silu(bf2f(P[row * NPAD + PC_HGG + h * 128 + v]));
            Y[row * DM + 3072 + h * 128 + v] = (bf16)f2bf(o[r] * rs * ng * gt); }
    }
    __syncthreads();
}

__device__ __forceinline__ void cmp_item(Frame& F, int l, int item) {
    const int kv = item >> 6, rt = item & 63;
    const int arow = F.lane & 15, kq = F.lane >> 4;
    LAS float* slots = (LAS float*)F.lds;
    LAS bf16* hbf = (LAS bf16*)(F.lds + 65536);
    const bf16* P = ws_bf(F, WS_P);
    int rho = rt * 16 + arow; if (rho > 1015) rho = 1015;
    const int b = rho / 254, rem = rho - b * 254, j = rem >> 1, g = rem & 1;
    const bf16* xrow = P + ((size_t)b * SEQ + 16 * j) * NPAD + PC_KVC + kv * 256 + g * 128;
    const bf16* W1T = ws_bf(F, WS_W1T) + (size_t)(l * 2 + kv) * 256 * 4096;
    const float* pe = (kv ? F.in[13] : F.in[12]) + l * 32 * 128;
    f32x4 acc[16];
#pragma unroll
    for (int n = 0; n < 16; ++n) acc[n] = (f32x4){0.f, 0.f, 0.f, 0.f};
    for (int li = 0; li < 4; ++li) { const int lidx = 4 * F.wave + li;
#pragma unroll
        for (int ds = 0; ds < 4; ++ds) { const int d = 32 * ds + 8 * kq;
            const v4u xa = *(const GAS v4u*)(xrow + (size_t)lidx * NPAD + d);
            const f32x4 p0 = *(const GAS f32x4*)(pe + lidx * 128 + d), p1 = *(const GAS f32x4*)(pe + lidx * 128 + d + 4);
            v4u aw; aw.x = pk2(bflo(xa.x) + p0[0], bfhi(xa.x) + p0[1]); aw.y = pk2(bflo(xa.y) + p0[2], bfhi(xa.y) + p0[3]);
            aw.z = pk2(bflo(xa.z) + p1[0], bfhi(xa.z) + p1[1]); aw.w = pk2(bflo(xa.w) + p1[2], bfhi(xa.w) + p1[3]);
            const bf16x8 a = as_bf16x8(aw); const int kbase = lidx * 128 + d;
#pragma unroll
            for (int n = 0; n < 16; ++n) { const bf16x8 bb = *(const GAS bf16x8*)(W1T + (size_t)(16 * n + arow) * 4096 + kbase); acc[n] = mfma16(a, bb, acc[n]); }
        } }
    if (F.wave >= 4) {
#pragma unroll
        for (int n = 0; n < 16; ++n)
#pragma unroll
            for (int rg = 0; rg < 4; ++rg) slots[((F.wave - 4) * 16 + 4 * kq + rg) * 256 + 16 * n + arow] = acc[n][rg]; }
    __syncthreads();
    if (F.wave < 4) {
#pragma unroll
        for (int n = 0; n < 16; ++n)
#pragma unroll
            for (int rg = 0; rg < 4; ++rg) slots[(F.wave * 16 + 4 * kq + rg) * 256 + 16 * n + arow] += acc[n][rg]; }
    __syncthreads();
#pragma unroll
    for (int e = 0; e < 8; ++e) { const int idx = F.tid * 8 + e; const float s = (slots[idx] + slots[4096 + idx]) + (slots[8192 + idx] + slots[12288 + idx]);
        hbf[(idx >> 8) * 264 + (idx & 255)] = (bf16)f2bf(silu(s)); }
    __syncthreads();
    {
        const bf16* W2T = ws_bf(F, WS_W2T) + (size_t)(l * 2 + kv) * 128 * 256;
        f32x4 a2 = {0.f, 0.f, 0.f, 0.f};
#pragma unroll
        for (int ks = 0; ks < 8; ++ks) { const bf16x8 a = *(const LAS bf16x8*)(hbf + arow * 264 + 32 * ks + 8 * kq);
            const bf16x8 bb = *(const GAS bf16x8*)(W2T + (size_t)(16 * F.wave + arow) * 256 + 32 * ks + 8 * kq); a2 = mfma16(a, bb, a2); }
        bf16* CMP = ws_bf(F, kv ? WS_VCMP : WS_KCMP);
#pragma unroll
        for (int rg = 0; rg < 4; ++rg) { const int rho2 = rt * 16 + 4 * kq + rg;
            if (rho2 < 1016) { const int b2 = rho2 / 254, rem2 = rho2 - b2 * 254, j2 = rem2 >> 1, g2 = rem2 & 1;
                CMP[((size_t)(b2 * 2 + g2) * 128 + j2) * 128 + 16 * F.wave + arow] = (bf16)f2bf(a2[rg]); } }
    }
    __syncthreads();
}

#define KSWZ(row, colB) ((row) * 256 + ((colB) ^ (((row) & 7) << 4)))
__device__ __forceinline__ int v_st(int k, int c) { const int kk = (k & ~0xC) | ((k & 4) << 1) | ((k & 8) >> 1); return ((kk >> 3) * 4 + (c >> 5)) * 512 + ((kk & 7) * 32 + (c & 31)) * 2; }
__device__ __forceinline__ int v_rd_base(int lane) { return ((lane & 3) << 3) | (((lane >> 2) & 3) << 6) | (((lane >> 4) & 1) << 5) | (((lane >> 5) & 1) << 8); }
constexpr int v_rd_off(int d0, int ks, int half) { return d0 * 512 + ks * 4096 + half * 2048; }
template <int OFF> __device__ __forceinline__ s16x4 tr_read(int vb) {
    s16x4 r; asm volatile("ds_read_b64_tr_b16 %0, %1 offset:%2" : "=&v"(r) : "v"(vb), "i"(OFF) : "memory"); return r;
}
template <int D0> __device__ __forceinline__ void pv_one(f32x16& od, int vb, bf16x8 pa0, bf16x8 pa1, bf16x8 pa2, bf16x8 pa3) {
    const s16x4 l0 = tr_read<v_rd_off(D0, 0, 0)>(vb), h0 = tr_read<v_rd_off(D0, 0, 1)>(vb), l1 = tr_read<v_rd_off(D0, 1, 0)>(vb), h1 = tr_read<v_rd_off(D0, 1, 1)>(vb);
    const s16x4 l2 = tr_read<v_rd_off(D0, 2, 0)>(vb), h2 = tr_read<v_rd_off(D0, 2, 1)>(vb), l3 = tr_read<v_rd_off(D0, 3, 0)>(vb), h3 = tr_read<v_rd_off(D0, 3, 1)>(vb);
    asm volatile("s_waitcnt lgkmcnt(0)" ::: "memory"); SBAR();
#define PK(L, H) (bf16x8){L[0], L[1], L[2], L[3], H[0], H[1], H[2], H[3]}
    od = mfma32(pa0, PK(l0, h0), od);
    od = mfma32(pa1, PK(l1, h1), od);
    od = mfma32(pa2, PK(l2, h2), od);
    od = mfma32(pa3, PK(l3, h3), od);
#undef PK
}
__device__ __forceinline__ void pv_d0(f32x16* o, int vb, bf16x8 pa0, bf16x8 pa1, bf16x8 pa2, bf16x8 pa3) {
    pv_one<0>(o[0], vb, pa0, pa1, pa2, pa3); pv_one<1>(o[1], vb, pa0, pa1, pa2, pa3); pv_one<2>(o[2], vb, pa0, pa1, pa2, pa3); pv_one<3>(o[3], vb, pa0, pa1, pa2, pa3);
}
__device__ __forceinline__ void qkt(f32x16& p0, f32x16& p1, const LAS char* Ks, const bf16x8* qr, int r32, int hi) {
    p0 = f32x16{}; p1 = f32x16{};
#pragma unroll
    for (int d0 = 0; d0 < 8; ++d0) { const int cb = (d0 * 16 + hi * 8) * 2;
        const bf16x8 b0 = *(const LAS bf16x8*)(Ks + KSWZ(r32, cb));
        const bf16x8 b1 = *(const LAS bf16x8*)(Ks + KSWZ(32 + r32, cb));
        p0 = mfma32(b0, qr[d0], p0);
        p1 = mfma32(b1, qr[d0], p1); }
}
__device__ __forceinline__ void p_to_frag(const f32x16& p0, const f32x16& p1, bf16x8& pa0, bf16x8& pa1, bf16x8& pa2, bf16x8& pa3) {
#define PK4(P, BASE, OUT) do { unsigned a0 = cvtpk(P[BASE + 0], P[BASE + 1]), a1 = cvtpk(P[BASE + 2], P[BASE + 3]);   \
    unsigned b0 = cvtpk(P[BASE + 4], P[BASE + 5]), b1 = cvtpk(P[BASE + 6], P[BASE + 7]);                              \
    auto r0 = __builtin_amdgcn_permlane32_swap(a0, b0, false, false); auto r1 = __builtin_amdgcn_permlane32_swap(a1, b1, false, false); \
    v4u w = {r0[0], r1[0], r0[1], r1[1]}; OUT = as_bf16x8(w); } while (0)
    PK4(p0, 0, pa0); PK4(p0, 8, pa1); PK4(p1, 0, pa2); PK4(p1, 8, pa3);
#undef PK4
}
__device__ __forceinline__ float half_swap_max(float v) { auto rr = __builtin_amdgcn_permlane32_swap(__float_as_uint(v), __float_as_uint(v), false, false); return fmaxf(__uint_as_float(rr[0]), __uint_as_float(rr[1])); }
__device__ __forceinline__ float half_swap_sum(float v) { auto rr = __builtin_amdgcn_permlane32_swap(__float_as_uint(v), __float_as_uint(v), false, false); return __uint_as_float(rr[0]) + __uint_as_float(rr[1]); }

struct KVRegs { v4u k0, k1, v0, v1; };
__device__ __forceinline__ void kv_load(KVRegs& R, const bf16* Kg, const bf16* Vg, size_t ld, int sr, int sc) {
    R.k0 = *(const GAS v4u*)(Kg + (size_t)sr * ld + sc); R.k1 = *(const GAS v4u*)(Kg + (size_t)(32 + sr) * ld + sc);
    R.v0 = *(const GAS v4u*)(Vg + (size_t)sr * ld + sc); R.v1 = *(const GAS v4u*)(Vg + (size_t)(32 + sr) * ld + sc);
}
__device__ __forceinline__ void kv_write(const KVRegs& R, LAS char* Kl, LAS char* Vl, int sr, int sc) {
    *(LAS v4u*)(Kl + KSWZ(sr, sc * 2)) = R.k0; *(LAS v4u*)(Kl + KSWZ(32 + sr, sc * 2)) = R.k1;
    *(LAS v4u*)(Vl + v_st(sr, sc)) = R.v0; *(LAS v4u*)(Vl + v_st(32 + sr, sc)) = R.v1;
}
constexpr int koff(int r) { return (r & 3) + 8 * (r >> 2); }
template <int MODE>
__device__ __forceinline__ void sm_tile(f32x16& p0, f32x16& p1, int dist0, bool rowsel, float C1, float C2, float& m, float& l, float& alpha) {
    float pmax = -1e30f;
#pragma unroll
    for (int r = 0; r < 16; ++r) { const int d = dist0 - koff(r); const bool ok = (MODE == 0) ? (rowsel && d >= 0) : (d >= 0 && d < WINDOW);
        const float lg = ok ? fmaf(p0[r], C1, -C2 * (float)d) : -1e30f; p0[r] = lg; pmax = fmaxf(pmax, lg); }
#pragma unroll
    for (int r = 0; r < 16; ++r) { const int d = dist0 - 32 - koff(r); const bool ok = (MODE == 0) ? (rowsel && d >= 0) : (d >= 0 && d < WINDOW);
        const float lg = ok ? fmaf(p1[r], C1, -C2 * (float)d) : -1e30f; p1[r] = lg; pmax = fmaxf(pmax, lg); }
    pmax = half_swap_max(pmax);
    const float mn = fmaxf(m, pmax);
    alpha = __builtin_amdgcn_exp2f(m - mn);
    const float mref = (mn < -1e29f) ? 0.f : mn;
    float ps = 0.f;
#pragma unroll
    for (int r = 0; r < 16; ++r) { p0[r] = __builtin_amdgcn_exp2f(p0[r] - mref); ps += p0[r]; }
#pragma unroll
    for (int r = 0; r < 16; ++r) { p1[r] = __builtin_amdgcn_exp2f(p1[r] - mref); ps += p1[r]; }
    ps = half_swap_sum(ps);
    l = l * alpha + ps; m = mn;
}
__device__ __forceinline__ void o_rescale(f32x16* o, float a, LAS float* al_l, int r32, int hi) {
    if (__any(a < 1.0f)) { if (hi == 0) al_l[r32] = a; LDS_WAIT();
#pragma unroll
        for (int r = 0; r < 16; ++r) { const float s = al_l[crow(r, hi)];
#pragma unroll
            for (int d = 0; d < 4; ++d) o[d][r] *= s; }
        LDS_WAIT(); }
}
__device__ __forceinline__ void row_bcast16(float v, float* out16, LAS float* li_l, int r32, int hi) {
    if (hi == 0) li_l[r32] = v; LDS_WAIT();
#pragma unroll
    for (int r = 0; r < 16; ++r) out16[r] = li_l[crow(r, hi)];
    LDS_WAIT();
}

__device__ __forceinline__ void nsa_cmp_item(Frame& F, int l, int item) {
    const int qb = item & 31, g = (item >> 5) & 1, b = item >> 6, q0 = 64 * qb;
    const int ntile = (4 * qb + 3) > 64 ? 2 : 1;
    LAS char* Kl = (LAS char*)F.lds; LAS char* Vl = Kl + 32768;
    LAS float* wsf = (LAS float*)(F.lds + 65536) + F.wave * 64;
    LAS float* impP = (LAS float*)(F.lds + 67584);
    const bf16* P = ws_bf(F, WS_P);
    const int r32 = F.lane & 31, hi = F.lane >> 5;
    {   const int sr = F.tid >> 4, sc = (F.tid & 15) * 8;
        const bf16* KC = ws_bf(F, WS_KCMP) + (size_t)(b * 2 + g) * 128 * 128; const bf16* VC = ws_bf(F, WS_VCMP) + (size_t)(b * 2 + g) * 128 * 128;
        for (int tl = 0; tl < ntile; ++tl) { KVRegs R; kv_load(R, KC + tl * 64 * 128, VC + tl * 64 * 128, 128, sr, sc); kv_write(R, Kl + tl * 16384, Vl + tl * 16384, sr, sc); } }
    __syncthreads();
    const int hg = g * 8 + F.wave;
    const float slope = exp2f(-0.5f * (float)(hg + 1));
    const int vb0 = (int)(uintptr_t)Vl + v_rd_base(F.lane);
    float* OACC = ws_f(F, WS_OACC);
    for (int qh = 0; qh < 2; ++qh) {
        const int t = q0 + 32 * qh + r32; const size_t row = (size_t)b * SEQ + t;
        bf16x8 qr[8];
#pragma unroll
        for (int d0 = 0; d0 < 8; ++d0) qr[d0] = *(const GAS bf16x8*)(P + row * NPAD + PC_Q + hg * 128 + 16 * d0 + 8 * hi);
        f32x16 p0, p1, p2, p3;
        qkt(p0, p1, Kl, qr, r32, hi);
        if (ntile == 2) qkt(p2, p3, Kl + 16384, qr, r32, hi); else { p2 = f32x16{}; p3 = f32x16{}; }
        const int base0 = t - 31 - 64 * hi; float mx = -1e30f;
#define LG(Pv, SH) _Pragma("unroll") for (int r = 0; r < 16; ++r) { const int d = base0 - (SH) - 16 * koff(r); const float lg = (d >= 0) ? (Pv[r] * SM_SCALE - slope * (float)d) : -1e30f; Pv[r] = lg; mx = fmaxf(mx, lg); }
        LG(p0, 0) LG(p1, 512) LG(p2, 1024) LG(p3, 1536)
#undef LG
        mx = half_swap_max(mx);
        const float mref = (mx < -1e29f) ? 0.f : mx; float sum = 0.f;
#define EX(Pv) _Pragma("unroll") for (int r = 0; r < 16; ++r) { Pv[r] = __expf(Pv[r] - mref); sum += Pv[r]; }
        EX(p0) EX(p1) EX(p2) EX(p3)
#undef EX
        sum = half_swap_sum(sum);
        const float inv = sum > 0.f ? 1.0f / sum : 0.f;
#define SC(Pv, S) _Pragma("unroll") for (int r = 0; r < 16; ++r) Pv[r] *= (S);
        SC(p0, inv) SC(p1, inv) SC(p2, inv) SC(p3, inv)
        {   float cg[16], sp[16];
#define GRP(Pv, GB) _Pragma("unroll") for (int i = 0; i < 4; ++i) { sp[(GB) + i] = 0.5f * Pv[4 * i + 3]; cg[(GB) + i] = (Pv[4 * i] + Pv[4 * i + 1]) + (Pv[4 * i + 2] + sp[(GB) + i]); }
            GRP(p0, 0) GRP(p1, 4) GRP(p2, 8) GRP(p3, 12)
#undef GRP
            float oth[16];
#pragma unroll
            for (int G = 0; G < 16; ++G) oth[G] = __shfl_xor(sp[G], 32);
#pragma unroll
            for (int G = 0; G < 16; ++G) { float v = cg[G]; if (hi) v += oth[G]; else if (G > 0) v += oth[G - 1];
                impP[(F.wave * 64 + 32 * qh + r32) * 32 + 2 * G + hi] = v; }
        }
        const float g0 = sigm(bf2f(P[row * NPAD + PC_GL + hg * 3 + 0]));
        SC(p0, g0) SC(p1, g0) SC(p2, g0) SC(p3, g0)
#undef SC
        f32x16 o[4] = {};
        { bf16x8 pa0, pa1, pa2, pa3; p_to_frag(p0, p1, pa0, pa1, pa2, pa3); pv_d0(o, vb0, pa0, pa1, pa2, pa3); }
        if (ntile == 2) { bf16x8 pa0, pa1, pa2, pa3; p_to_frag(p2, p3, pa0, pa1, pa2, pa3); pv_d0(o, vb0 + 16384, pa0, pa1, pa2, pa3); }
#pragma unroll
        for (int r = 0; r < 16; ++r) { const size_t orow = (size_t)b * SEQ + q0 + 32 * qh + crow(r, hi);
#pragma unroll
            for (int d0 = 0; d0 < 4; ++d0) OACC[orow * D_NSA + hg * 128 + 32 * d0 + r32] = o[d0][r]; }
    }
    __syncthreads();
    LAS float* impS = (LAS float*)F.lds;
    const int q = F.tid >> 3, sub = F.tid & 7;
#pragma unroll
    for (int e = 0; e < 4; ++e) { const int n = 4 * sub + e; float s = 0.f;
#pragma unroll
        for (int w = 0; w < 8; ++w) s += impP[(w * 64 + q) * 32 + n];
        if (n > qb) s = -1e30f; else if (n == 0 || n == qb || n == qb - 1) s = 1e9f;
        impS[q * 33 + n] = s; }
    __syncthreads();
    {   float mine[4]; int rank[4];
#pragma unroll
        for (int e = 0; e < 4; ++e) { mine[e] = impS[q * 33 + 4 * sub + e]; rank[e] = 0; }
        for (int mI = 0; mI < 32; ++mI) { const float sm = impS[q * 33 + mI];
#pragma unroll
            for (int e = 0; e < 4; ++e) rank[e] += (sm > mine[e] || (sm == mine[e] && mI < 4 * sub + e)) ? 1 : 0; }
        unsigned bits = 0u;
#pragma unroll
        for (int e = 0; e < 4; ++e) if (rank[e] < TOPN && (4 * sub + e) <= qb) bits |= 1u << (4 * sub + e);
        bits |= __shfl_xor(bits, 1); bits |= __shfl_xor(bits, 2); bits |= __shfl_xor(bits, 4);
        if (sub == 0) ((unsigned*)(F.ws + WS_SEL))[(size_t)(b * 2 + g) * SEQ + q0 + q] = bits;
    }
    __syncthreads();
}

template <int MODE>
__device__ __forceinline__ void attn_branch(Frame& F, f32x16* o, float& lsum, const bf16x8* qr, const bf16* Kg, const bf16* Vg, unsigned tiles, unsigned mymask,
                                            int t, float C1, float C2, LAS char* Kl, LAS char* Vl, LAS float* wsf, int vb0) {
    const int r32 = F.lane & 31, hi = F.lane >> 5, sr = F.tid >> 4, sc = (F.tid & 15) * 8;
    float m = -1e30f; lsum = 0.f;
    unsigned rem = tiles;
    KVRegs R;
    { const int n = __builtin_ctz(rem); kv_load(R, Kg + (size_t)(64 * n) * NPAD, Vg + (size_t)(64 * n) * NPAD, NPAD, sr, sc); }
    while (rem) {
        const int n = __builtin_ctz(rem); rem &= rem - 1u;
        __syncthreads();
        kv_write(R, Kl, Vl, sr, sc);
        __syncthreads();
        if (rem) { const int n2 = __builtin_ctz(rem); kv_load(R, Kg + (size_t)(64 * n2) * NPAD, Vg + (size_t)(64 * n2) * NPAD, NPAD, sr, sc); }
        f32x16 p0, p1; qkt(p0, p1, Kl, qr, r32, hi);
        float alpha;
        int dist0 = t - 64 * n - 4 * hi; asm volatile("" : "+v"(dist0));
        sm_tile<MODE>(p0, p1, dist0, ((mymask >> n) & 1u) != 0u, C1, C2, m, lsum, alpha);
        o_rescale(o, alpha, wsf, r32, hi);
        bf16x8 pa0, pa1, pa2, pa3; p_to_frag(p0, p1, pa0, pa1, pa2, pa3);
        pv_d0(o, vb0, pa0, pa1, pa2, pa3);
    }
}
__device__ __forceinline__ void nsa_attn_item(Frame& F, int l, int item) {
    const int qb = 31 - (item >> 4), rest = item & 15, b = rest >> 2, g = (rest >> 1) & 1, hh = rest & 1, q0 = 64 * qb;
    const int r32 = F.lane & 31, hi = F.lane >> 5;
    const int hg = 8 * g + 4 * hh + (F.wave >> 1), qh = F.wave & 1, t = q0 + 32 * qh + r32;
    const size_t row = (size_t)b * SEQ + t;
    const float slope = exp2f(-0.5f * (float)(hg + 1)), C1 = SM_SCALE * LOG2E, C2 = slope * LOG2E;
    LAS char* Kl = (LAS char*)F.lds; LAS char* Vl = Kl + 16384; LAS float* wsf = (LAS float*)(F.lds + 32768) + F.wave * 64;
    const int vb0 = (int)(uintptr_t)Vl + v_rd_base(F.lane);
    const bf16* P = ws_bf(F, WS_P);
    bf16x8 qr[8];
#pragma unroll
    for (int d0 = 0; d0 < 8; ++d0) qr[d0] = *(const GAS bf16x8*)(P + row * NPAD + PC_Q + hg * 128 + 16 * d0 + 8 * hi);
    const unsigned* SEL = (const unsigned*)(F.ws + WS_SEL) + (size_t)(b * 2 + g) * SEQ;
    const unsigned mymask = SEL[t];
    unsigned uni = SEL[q0 + F.lane];
#pragma unroll
    for (int o_ = 1; o_ < 64; o_ <<= 1) uni |= __shfl_xor(uni, o_);
    uni = __builtin_amdgcn_readfirstlane(uni);
    const unsigned upto = (qb == 31) ? 0xffffffffu : ((2u << qb) - 1u);
    const float* OACC = ws_f(F, WS_OACC);
    LAS unsigned* stash = (LAS unsigned*)(F.lds + 36864) + F.tid;
    float lsum, rs[16];
    {
        f32x16 o[4] = {};
        attn_branch<0>(F, o, lsum, qr, P + (size_t)b * SEQ * NPAD + PC_KVS + g * 128, P + (size_t)b * SEQ * NPAD + PC_KVS + 256 + g * 128, uni & upto, mymask, t, C1, C2, Kl, Vl, wsf, vb0);
        const float g1 = sigm(bf2f(P[row * NPAD + PC_GL + hg * 3 + 1]));
        row_bcast16(g1 / lsum, rs, wsf + 32, r32, hi);
#pragma unroll
        for (int d0 = 0; d0 < 4; ++d0)
#pragma unroll
            for (int r = 0; r < 16; r += 2) stash[(d0 * 8 + (r >> 1)) * 512] = cvtpk(o[d0][r] * rs[r], o[d0][r + 1] * rs[r + 1]);
    }
    {
        f32x16 o[4] = {};
        const int nlo = qb > 8 ? qb - 8 : 0;
        const unsigned wt = upto & ~((1u << nlo) - 1u);
        attn_branch<1>(F, o, lsum, qr, P + (size_t)b * SEQ * NPAD + PC_KVW + g * 128, P + (size_t)b * SEQ * NPAD + PC_KVW + 256 + g * 128, wt, 0xffffffffu, t, C1, C2, Kl, Vl, wsf, vb0);
        const float g2 = sigm(bf2f(P[row * NPAD + PC_GL + hg * 3 + 2]));
        row_bcast16(g2 / lsum, rs, wsf + 32, r32, hi);
        const size_t rb = (size_t)b * SEQ + q0 + 32 * qh + 4 * hi;
        const float* oa = OACC + rb * D_NSA + hg * 128 + r32;
        const bf16* gp = P + rb * NPAD + PC_NSAG + hg * 128 + r32;
        bf16* yp = ws_bf(F, WS_YCAT) + rb * DM + 1024 + hg * 128 + r32;
#pragma unroll
        for (int r = 0; r < 16; ++r) {
#pragma unroll
            for (int d0 = 0; d0 < 4; ++d0) { const unsigned sw = stash[(d0 * 8 + (r >> 1)) * 512];
                const float sel = (r & 1) ? bfhi(sw) : bflo(sw);
                const float v = oa[(size_t)koff(r) * D_NSA + 32 * d0] + sel + o[d0][r] * rs[r];
                const float gt = silu(bf2f(gp[(size_t)koff(r) * NPAD + 32 * d0]));
                yp[(size_t)koff(r) * DM + 32 * d0] = (bf16)f2bf(v * gt); }
            asm volatile("" ::: "memory");
        }
    }
    __syncthreads();
}

#ifndef MK_SPLIT
#define MK_SPLIT 0
#endif
constexpr int N_PHASES = 2 + 6 * DEPTH;
struct Args { const float* in[23]; float* out; unsigned char* ws; int ph_lo, ph_hi; };
__global__ void __launch_bounds__(NWAVES * 64, 2) hymba_fwd(Args args) {
    extern __shared__ __attribute__((aligned(16))) unsigned char lds[];
    Frame F;
    F.lds = (LAS unsigned char*)lds;
    F.MISC = (volatile LAS unsigned*)(F.lds + MISC_OFF);
    F.tid = threadIdx.x; F.lane = F.tid & 63; F.wave = __builtin_amdgcn_readfirstlane(F.tid >> 6);
    F.G = gridDim.x; { const int bx = blockIdx.x; F.vcu = (F.G % 8 == 0) ? (bx % 8) * (F.G / 8) + bx / 8 : bx; }
    F.ws = args.ws; F.out = args.out; F.ctl = (gu32*)(args.ws + WS_CTL);
    F.in = args.in;
    for (int u = F.tid; u < (LDS_BYTES - LDSCTL_OFF) / 4; u += NWAVES * 64) ((LAS unsigned*)(F.lds + LDSCTL_OFF))[u] = 0u;
    __syncthreads();
#if MK_SPLIT
#define GRID_BAR() do { } while (0)
#else
    XcdBarrier bar = xcd_barrier_post((unsigned*)(F.ctl + CW_BAR), F.MISC + 8);
#define GRID_BAR() xcd_barrier(bar)
#endif
#if MK_SPLIT
    const int lo = args.ph_lo, hi_ = args.ph_hi;
#define IN(k) (lo <= (k) && (k) < hi_)
#define BOTH(k) (IN(k) && IN((k) + 1))
#else
#define IN(k) true
#define BOTH(k) ((k) + 1 < N_PHASES)
#endif

    if (IN(0)) { launder(F); p0_prologue(F); if (BOTH(0)) GRID_BAR(); }
    if (IN(1)) { launder(F); p1_u0(F); if (BOTH(1)) GRID_BAR(); }
    for (int l = 0; l < DEPTH; ++l) {
        const int pb = 2 + 6 * l;
        if (IN(pb + 0)) { launder(F);
            pg8::Gemm g{ws_bf(F, WS_U), ws_bf(F, WS_WIN) + (size_t)l * NPAD * DM, MROWS, NPAD, DM}; pg8::StaticOrder S; S.init(MROWS, NPAD, F.G, (int)blockIdx.x);
            pg8::EpiBf16 E{ws_bf(F, WS_P), NPAD};
            pg8::gemm_phase<pg8::EpiBf16, pg8::StaticOrder, true, true>(F.lds, g, S, E);
            if (BOTH(pb + 0)) GRID_BAR();
        }
        if (IN(pb + 1)) { launder(F);
            for (int it = F.vcu; it < 128; it += F.G) cmp_item(F, l, it);
            launder(F);
            for (int it = F.vcu; it < 1024; it += F.G) hg1_item(F, l, it);
            launder(F);
            for (int it = F.vcu; it < 1024; it += F.G) rg_item<1>(F, l, it);
            if (BOTH(pb + 1)) GRID_BAR();
        }
        if (IN(pb + 2)) { launder(F);
            for (int it = F.vcu; it < 256; it += F.G) nsa_cmp_item(F, l, it);
            launder(F);
            hg_pass2(F);
            launder(F);
            rg_pass2(F);
            if (BOTH(pb + 2)) GRID_BAR();
        }
        if (IN(pb + 3)) { launder(F);
            for (;;) { const int it = q_next(F, l * 4 + 0); if (it >= 512) break; nsa_attn_item(F, l, it); }
            launder(F);
            for (;;) { const int it = q_next(F, l * 4 + 1); if (it >= 1024) break; hg3_item(F, l, it); }
            launder(F);
            for (;;) { const int it = q_next(F, l * 4 + 2); if (it >= 1024) break; rg_item<3>(F, l, it); }
            if (BOTH(pb + 3)) GRID_BAR();
        }
        if (IN(pb + 4)) { launder(F);
            pg8::Gemm g{ws_bf(F, WS_YCAT), ws_bf(F, WS_WOUT) + (size_t)l * DM * DM, MROWS, DM, DM}; pg8::StaticOrder S; S.init(MROWS, DM, F.G, (int)blockIdx.x);
            pg8::EpiResid E{l == 0 ? F.in[0] : ws_f(F, WS_XRES), ws_f(F, WS_V), ws_f(F, WS_MOD) + (size_t)l * 4 * 12288 + 2 * DM, 12288, SEQ, DM, ALPHA};
            pg8::gemm_phase<pg8::EpiResid, pg8::StaticOrder, true, true>(F.lds, g, S, E);
            if (BOTH(pb + 4)) GRID_BAR();
        }
        if (IN(pb + 5)) { launder(F);
            ln_phase(F, l, (l == DEPTH - 1) ? F.out : ws_f(F, WS_XRES), l != DEPTH - 1);
            if (BOTH(pb + 5)) GRID_BAR();
        }
    }
#undef IN
#undef BOTH
}

extern "C" void kernel_launch(void* const* d_in, const int* in_sizes, int n_in, void* d_out, int out_size, void* d_ws, size_t ws_size, hipStream_t stream) {
    static int grid = 0;
    if (grid == 0) {
        if (n_in != 23 || in_sizes[0] != MROWS * DM || out_size != MROWS * DM || ws_size < WS_END) {
            fprintf(stderr, "kernel_launch: shape/workspace mismatch: n_in %d in0 %d out %d ws %zu (need %zu)\n", n_in, n_in > 0 ? in_sizes[0] : -1, out_size, ws_size, (size_t)WS_END); grid = -1; return; }
        int dev = 0, cus = 0, per_cu = 0;
        if (hipGetDevice(&dev) != hipSuccess || hipDeviceGetAttribute(&cus, hipDeviceAttributeMultiprocessorCount, dev) != hipSuccess) { fprintf(stderr, "kernel_launch: device query failed\n"); grid = -1; return; }
        if (hipFuncSetAttribute((const void*)hymba_fwd, hipFuncAttributeMaxDynamicSharedMemorySize, LDS_BYTES) != hipSuccess) { fprintf(stderr, "kernel_launch: hipFuncSetAttribute failed\n"); grid = -1; return; }
        if (hipOccupancyMaxActiveBlocksPerMultiprocessor(&per_cu, (const void*)hymba_fwd, NWAVES * 64, LDS_BYTES) != hipSuccess || per_cu < 1)
            fprintf(stderr, "kernel_launch: note: occupancy query reports %d workgroups per CU\n", per_cu);
        (void)hipGetLastError();
        grid = cus;
    }
    if (grid < 0) return;
    if (hipMemsetAsync((char*)d_ws + WS_CTL, 0, CTL_ZERO_BYTES, stream) != hipSuccess) { fprintf(stderr, "kernel_launch: memset failed\n"); return; }
    Args a{};
    for (int i = 0; i < 23; ++i) a.in[i] = (const float*)d_in[i];
    a.out = (float*)d_out; a.ws = (unsigned char*)d_ws;
#if MK_SPLIT
    for (int ph = 0; ph < N_PHASES; ++ph) { a.ph_lo = ph; a.ph_hi = ph + 1;
        hipLaunchKernelGGL(hymba_fwd, dim3(grid), dim3(NWAVES * 64), LDS_BYTES, stream, a); }
#else
    a.ph_lo = 0; a.ph_hi = N_PHASES;
    hipLaunchKernelGGL(hymba_fwd, dim3(grid), dim3(NWAVES * 64), LDS_BYTES, stream, a);
#endif
    const hipError_t le = hipPeekAtLastError();
    if (le != hipSuccess) fprintf(stderr, "kernel_launch: launch failed: %s\n", hipGetErrorName(le));
}
```

```cpp
#include <hip/hip_runtime.h>
#include <cstdio>
#include <cstdint>
#define MK_SPLIT 0
#define PROBE_DUP -1
namespace pg8 {
#define PG8_LAS __attribute__((address_space(3)))
typedef unsigned short bf16_t;
typedef short bf16x8 __attribute__((ext_vector_type(8)));
typedef float f32x4 __attribute__((ext_vector_type(4)));
typedef unsigned u32x4 __attribute__((ext_vector_type(4)));
constexpr int BM = 256, BK = 64, HALF = 128, HTB = HALF * BK * 2  , STAGE_BYTES = 8 * HTB, NXCD = 8, WGM = 8;

__host__ __device__ __forceinline__ int lds_byte(int r, int c) { const int st = (r >> 4) * 2 + (c >> 5), rr = r & 15, cc = c & 31, ob = rr * 64 + cc * 2; return st * 1024 + (ob ^ (((ob >> 9) & 1) << 5)); }
__host__ __device__ __forceinline__ void stage_rc(int b, int& R, int& C) { const int st = b / 1024, sb = b % 1024, swz = sb ^ (((sb >> 9) & 1) << 5); R = (st >> 1) * 16 + swz / 64; C = (st & 1) * 32 + (swz % 64) / 2; }
__host__ __device__ __forceinline__ int perm32(int rho) { const int n = rho >> 4, i = rho & 15; return 8 * (i >> 2) + 4 * n + (i & 3); }

struct Unit { int pm, pn; };
struct Gemm { const bf16_t* A; const bf16_t* Bt; int M, N, K; };

struct StaticOrder {
    int nM, nN, nwg, G, c;
    __host__ __device__ void init(int M, int N, int G_, int c_) { nM = M / BM; nN = N / BM; nwg = nM * nN; G = G_; c = c_; }
    __host__ __device__ bool next(int i, Unit& u) const {
        const long L = (long)i * G + c; if (L >= nwg) return false;
        int wgid = (int)L; { const int q = nwg / NXCD, r = nwg % NXCD, xcd = wgid % NXCD, off = wgid / NXCD; wgid = (xcd < r ? xcd * (q + 1) : r * (q + 1) + (xcd - r) * q) + off; }
        const int nig = WGM * nN, gid = wgid / nig, fm = gid * WGM, gsz = (nM - fm) < WGM ? (nM - fm) : WGM;
        u.pm = fm + ((wgid % nig) % gsz); u.pn = (wgid % nig) / gsz; return true;
    }
    __device__ __forceinline__ void a_ready(const Unit&) const {}
    __device__ __forceinline__ void done(const Unit&) const {}
};

__device__ __forceinline__ unsigned cvt_pk_bf16(float lo, float hi) { unsigned r; asm volatile("v_cvt_pk_bf16_f32 %0, %1, %2" : "=v"(r) : "v"(lo), "v"(hi)); return r; }
typedef float f32x2 __attribute__((ext_vector_type(2)));

struct EpiBf16 {
    static constexpr bool PERM = true, AFTER_DRAIN = false;
    bf16_t* O; int ldc;
    __device__ __forceinline__ void operator()(const f32x4 (&acc)[2][2][4][2], const Unit& u, int wr, int wc, int fr, int fq) const {
        const int row0 = u.pm * BM + wr * 64 + fr; const int col0 = u.pn * BM + wc * 32 + 8 * fq;
#pragma unroll
        for (int ai = 0; ai < 2; ++ai)
#pragma unroll
            for (int m = 0; m < 4; ++m) { bf16_t* rowp = O + (size_t)(row0 + ai * HALF + m * 16) * ldc + col0;
#pragma unroll
                for (int bj = 0; bj < 2; ++bj) { const f32x4 v0 = acc[ai][bj][m][0], v1 = acc[ai][bj][m][1];
                    u32x4 w; w.x = cvt_pk_bf16(v0[0], v0[1]); w.y = cvt_pk_bf16(v0[2], v0[3]); w.z = cvt_pk_bf16(v1[0], v1[1]); w.w = cvt_pk_bf16(v1[2], v1[3]);
                    *(u32x4*)(rowp + bj * HALF) = w; } }
    }
};
struct EpiResid {
    static constexpr bool PERM = false, AFTER_DRAIN = false;
    const float* xres; float* V; const float* gate; int gate_stride; int rows_per_batch; int ldc; float alpha;
    __device__ __forceinline__ void operator()(const f32x4 (&acc)[2][2][4][2], const Unit& u, int wr, int wc, int fr, int fq) const {
        const int bidx = (u.pm * BM) / rows_per_batch; const int col0 = u.pn * BM + wc * 32 + 4 * fq;
        f32x4 gv[2][2];
#pragma unroll
        for (int bj = 0; bj < 2; ++bj)
#pragma unroll
            for (int n = 0; n < 2; ++n) gv[bj][n] = *(const f32x4*)(gate + (size_t)bidx * gate_stride + col0 + bj * HALF + n * 16) + 1.0f;
#pragma unroll
        for (int ai = 0; ai < 2; ++ai)
#pragma unroll
            for (int m = 0; m < 4; ++m) { const size_t off = (size_t)(u.pm * BM + ai * HALF + wr * 64 + m * 16 + fr) * ldc + col0;
#pragma unroll
                for (int bj = 0; bj < 2; ++bj)
#pragma unroll
                    for (int n = 0; n < 2; ++n) { const f32x4 xr = *(const f32x4*)(xres + off + bj * HALF + n * 16);
                        *(f32x4*)(V + off + bj * HALF + n * 16) = xr * alpha + gv[bj][n] * acc[ai][bj][m][n]; } }
    }
};
template <class Epi, class Sched, bool ALIGN_EPI = false, bool SP2 = false>
__device__ __forceinline__ void gemm_phase(PG8_LAS unsigned char* lds, const Gemm g, const Sched& S, const Epi& E) {
    int tid_ = threadIdx.x; asm volatile("" : "+v"(tid_));
    const int tid = tid_, wid = __builtin_amdgcn_readfirstlane(tid >> 6), lane = tid & 63, wr = wid >> 2, wc = wid & 3, fr = lane & 15, fq = lane >> 4;
    const int K = g.K, nt = K / BK;
    unsigned voffA[2], voffB[2];
#pragma unroll
    for (int i = 0; i < 2; ++i) { int R, C; stage_rc(tid * 16 + i * 8192, R, C); const int Rb = Epi::PERM ? ((R & ~31) + perm32(R & 31)) : R;
        voffA[i] = (unsigned)(R * K + C) * 2u; voffB[i] = (unsigned)(Rb * K + C) * 2u; }
    const size_t kstep = (size_t)(BK * 2);
    const size_t hstep = (size_t)HALF * K * 2;
    const size_t tstep = 2 * hstep;
    const unsigned ldsw = (unsigned)wid * 1024u;
    const int aoff = lds_byte(wr * 64 + fr, fq * 8), boff = lds_byte(wc * 32 + fr, fq * 8);
#define PG8_SA(b, h) (((b) * 2 + (h)) * HTB)
#define PG8_SB(b, h) ((4 + (b) * 2 + (h)) * HTB)
#define PG8_STAGE(bufoff, gbase, voff) do { _Pragma("unroll") for (int _i = 0; _i < 2; ++_i) \
        __builtin_amdgcn_global_load_lds((const unsigned*)((const char*)(gbase) + (voff)[_i]), (PG8_LAS unsigned*)(lds + (bufoff) + ldsw + _i * 8192), 16, 0, 0); } while (0)
#define PG8_LDA(dst, b, h) do { _Pragma("unroll") for (int m = 0; m < 4; ++m) _Pragma("unroll") for (int k = 0; k < 2; ++k) dst[m][k] = *(const PG8_LAS bf16x8*)(lds + PG8_SA(b, h) + aoff + m * 2048 + k * 1024); } while (0)
#define PG8_LDB(dst, b, h) do { _Pragma("unroll") for (int n = 0; n < 2; ++n) _Pragma("unroll") for (int k = 0; k < 2; ++k) dst[n][k] = *(const PG8_LAS bf16x8*)(lds + PG8_SB(b, h) + boff + n * 2048 + k * 1024); } while (0)
#define PG8_MMA(ai, bj, At, Bt) do { __builtin_amdgcn_s_setprio(1); _Pragma("unroll") for (int m = 0; m < 4; ++m) _Pragma("unroll") for (int n = 0; n < 2; ++n) _Pragma("unroll") for (int k = 0; k < 2; ++k) \
        acc[ai][bj][m][n] = __builtin_amdgcn_mfma_f32_16x16x32_bf16(Bt[n][k], At[m][k], acc[ai][bj][m][n], 0, 0, 0); __builtin_amdgcn_s_setprio(0); } while (0)
#define PG8_WAIT_V(n) asm volatile("s_waitcnt vmcnt(" #n ")" ::: "memory")
#define PG8_WAIT_L(n) asm volatile("s_waitcnt lgkmcnt(" #n ")" ::: "memory")
#define PG8_BAR __builtin_amdgcn_s_barrier()
#define PG8_SCHED __builtin_amdgcn_sched_barrier(0)
    Unit cur, nxt; int ui = 0;
    if (!S.next(0, cur)) return;
    f32x4 acc[2][2][4][2];
#pragma unroll
    for (int a = 0; a < 2; ++a)
#pragma unroll
        for (int b = 0; b < 2; ++b)
#pragma unroll
            for (int m = 0; m < 4; ++m)
#pragma unroll
                for (int n = 0; n < 2; ++n) acc[a][b][m][n] = (f32x4){0.f, 0.f, 0.f, 0.f};
    bf16x8 At[4][2], B0[2][2], B1[2][2];
    const char* cA = (const char*)g.A + (size_t)cur.pm * tstep; const char* cB = (const char*)g.Bt + (size_t)cur.pn * tstep;
    S.a_ready(cur);
    if constexpr (SP2) {
        PG8_STAGE(PG8_SB(0, 0), cB, voffB); PG8_STAGE(PG8_SB(0, 1), cB + hstep, voffB); PG8_STAGE(PG8_SA(0, 0), cA, voffA); PG8_STAGE(PG8_SA(0, 1), cA + hstep, voffA);
        if (wr == 1) PG8_BAR;
        PG8_WAIT_V(2); PG8_BAR;
        PG8_STAGE(PG8_SB(1, 0), cB + kstep, voffB); PG8_STAGE(PG8_SA(1, 0), cA + kstep, voffA); PG8_STAGE(PG8_SB(1, 1), cB + hstep + kstep, voffB);
        PG8_WAIT_V(6); PG8_BAR;
    } else {
        PG8_STAGE(PG8_SB(0, 0), cB, voffB); PG8_STAGE(PG8_SA(0, 0), cA, voffA); PG8_STAGE(PG8_SB(0, 1), cB + hstep, voffB); PG8_STAGE(PG8_SA(0, 1), cA + hstep, voffA);
        if (wr == 1) PG8_BAR;
        PG8_WAIT_V(4); PG8_BAR;
        PG8_STAGE(PG8_SB(1, 0), cB + kstep, voffB); PG8_STAGE(PG8_SA(1, 0), cA + kstep, voffA); PG8_STAGE(PG8_SB(1, 1), cB + hstep + kstep, voffB);
        PG8_WAIT_V(6); PG8_BAR;
    }
    for (;;) {
        const bool has_next = S.next(ui + 1, nxt);
        const char* nA = has_next ? (const char*)g.A + (size_t)nxt.pm * tstep : cA; const char* nB = has_next ? (const char*)g.Bt + (size_t)nxt.pn * tstep : cB;
        for (int t = 0; t < nt; t += 2) {
            const bool last = (t == nt - 2);
            const char* a1 = cA + (size_t)(t + 1) * kstep;
            const char* a2 = last ? nA : cA + (size_t)(t + 2) * kstep; const char* b2 = last ? nB : cB + (size_t)(t + 2) * kstep;
            const char* a3 = a2 + kstep; const char* b3 = b2 + kstep;
            if (last && has_next) S.a_ready(nxt);
            if constexpr (SP2) {
            PG8_LDB(B0, 0, 0); PG8_LDB(B1, 0, 1); PG8_SCHED; PG8_LDA(At, 0, 0); PG8_STAGE(PG8_SA(1, 1), a1 + hstep, voffA);
            PG8_WAIT_V(8); PG8_WAIT_L(0); PG8_BAR; PG8_MMA(0, 0, At, B0); PG8_MMA(0, 1, At, B1); PG8_BAR; PG8_SCHED;
            PG8_LDA(At, 0, 1); PG8_STAGE(PG8_SB(0, 0), b2, voffB); PG8_STAGE(PG8_SB(0, 1), b2 + hstep, voffB); PG8_STAGE(PG8_SA(0, 0), a2, voffA);
            PG8_WAIT_V(8); PG8_WAIT_L(0); PG8_BAR; PG8_MMA(1, 0, At, B0); PG8_MMA(1, 1, At, B1); PG8_BAR; PG8_SCHED;
            PG8_LDB(B0, 1, 0); PG8_LDB(B1, 1, 1); PG8_SCHED; PG8_LDA(At, 1, 0); PG8_STAGE(PG8_SA(0, 1), a2 + hstep, voffA);
            PG8_WAIT_V(8); PG8_WAIT_L(0); PG8_BAR; PG8_MMA(0, 0, At, B0); PG8_MMA(0, 1, At, B1); PG8_BAR; PG8_SCHED;
            PG8_LDA(At, 1, 1); PG8_STAGE(PG8_SB(1, 0), b3, voffB); PG8_STAGE(PG8_SB(1, 1), b3 + hstep, voffB); PG8_STAGE(PG8_SA(1, 0), a3, voffA);
            PG8_WAIT_V(8); PG8_WAIT_L(0); PG8_BAR; PG8_MMA(1, 0, At, B0); PG8_MMA(1, 1, At, B1); PG8_BAR; PG8_SCHED;
            } else {
            PG8_LDB(B0, 0, 0); PG8_SCHED; PG8_LDA(At, 0, 0); PG8_STAGE(PG8_SA(1, 1), a1 + hstep, voffA);
            PG8_WAIT_L(8); PG8_BAR; PG8_WAIT_L(0); PG8_MMA(0, 0, At, B0); PG8_BAR; PG8_SCHED;
            PG8_LDB(B1, 0, 1); PG8_STAGE(PG8_SB(0, 0), b2, voffB);
            PG8_BAR; PG8_WAIT_L(0); PG8_MMA(0, 1, At, B1); PG8_BAR;
            PG8_LDA(At, 0, 1); PG8_STAGE(PG8_SA(0, 0), a2, voffA);
            PG8_BAR; PG8_WAIT_L(0); PG8_MMA(1, 0, At, B0); PG8_BAR; PG8_SCHED;
            PG8_STAGE(PG8_SB(0, 1), b2 + hstep, voffB);
            PG8_WAIT_V(6); PG8_BAR; PG8_MMA(1, 1, At, B1); PG8_BAR;
            PG8_LDB(B0, 1, 0); PG8_SCHED; PG8_LDA(At, 1, 0); PG8_STAGE(PG8_SA(0, 1), a2 + hstep, voffA);
            PG8_WAIT_L(8); PG8_BAR; PG8_WAIT_L(0); PG8_MMA(0, 0, At, B0); PG8_BAR; PG8_SCHED;
            PG8_LDB(B1, 1, 1); PG8_STAGE(PG8_SB(1, 0), b3, voffB);
            PG8_BAR; PG8_WAIT_L(0); PG8_MMA(0, 1, At, B1); PG8_BAR;
            PG8_LDA(At, 1, 1); PG8_STAGE(PG8_SA(1, 0), a3, voffA);
            PG8_BAR; PG8_WAIT_L(0); PG8_MMA(1, 0, At, B0); PG8_BAR; PG8_SCHED;
            PG8_STAGE(PG8_SB(1, 1), b3 + hstep, voffB);
            PG8_WAIT_V(6); PG8_BAR; PG8_MMA(1, 1, At, B1); PG8_BAR;
            }
        }
        if constexpr (ALIGN_EPI) { if (wr == 0) PG8_BAR; }
        if constexpr (!Epi::AFTER_DRAIN) { E(acc, cur, wr, wc, fr, fq); S.done(cur); }
        if (!has_next) break;
#pragma unroll
        for (int a = 0; a < 2; ++a)
#pragma unroll
            for (int b = 0; b < 2; ++b)
#pragma unroll
                for (int m = 0; m < 4; ++m)
#pragma unroll
                    for (int n = 0; n < 2; ++n) acc[a][b][m][n] = (f32x4){0.f, 0.f, 0.f, 0.f};
        cur = nxt; cA = nA; cB = nB; ++ui;
        if constexpr (ALIGN_EPI) { if (wr == 1) PG8_BAR; }
    }
    PG8_WAIT_V(0);
    if constexpr (!ALIGN_EPI) { if (wr == 0) PG8_BAR; }
    PG8_BAR;
    if constexpr (Epi::AFTER_DRAIN) { E.fused(acc, cur, wr, wc, fr, fq, lds, wid, lane); S.done(cur); }
#undef PG8_SA
#undef PG8_SB
#undef PG8_STAGE
#undef PG8_LDA
#undef PG8_LDB
#undef PG8_MMA
#undef PG8_WAIT_V
#undef PG8_WAIT_L
#undef PG8_BAR
#undef PG8_SCHED
}
}

constexpr int DM = 4096, BATCH = 4, SEQ = 2048, DEPTH = 2, MROWS = BATCH * SEQ;
constexpr int HD = 128, D_RG = 1024, D_NSA = 2048, D_HG = 1024;
constexpr int NIN = 11824, NPAD = 12032;
constexpr int NHEADS = 16, NKV = 2, NGRP = 8;
constexpr int NCMP = 127, NSEL = 32, TOPN = 16, WINDOW = 512;
constexpr int PC_RGX = 0, PC_RGG = 1024, PC_Q = 2048, PC_KVC = 4096, PC_KVS = 4608, PC_KVW = 5120, PC_NSAG = 5632,
              PC_HGQ = 7680, PC_HGF = 8704, PC_HGI = 9728, PC_HGG = 10752, PC_GL = 11776;
constexpr float LN_EPS = 1e-5f, RMS_EPS = 1e-6f, ALPHA = 1.41421356237309515f;
constexpr float SM_SCALE = 0.088388347648318440f;
constexpr float LOG2E = 1.4426950408889634f;

constexpr size_t MiB = 1u << 20;
constexpr size_t WS_CTL = 0, CTL_ZERO_BYTES = 1 * MiB;
constexpr size_t WS_WIN  = 2 * MiB;
constexpr size_t WS_WOUT = 190 * MiB;
constexpr size_t WS_W1T  = 254 * MiB;
constexpr size_t WS_W2T  = 262 * MiB;
constexpr size_t WS_RGW  = 263 * MiB;
constexpr size_t WS_MOD  = 264 * MiB;
constexpr size_t WS_U    = 266 * MiB;
constexpr size_t WS_P    = 330 * MiB;
constexpr size_t WS_XRES = 518 * MiB;
constexpr size_t WS_V    = 646 * MiB;
constexpr size_t WS_YCAT = 774 * MiB;
constexpr size_t WS_OACC = 838 * MiB;
constexpr size_t WS_HS   = 902 * MiB;
constexpr size_t WS_HDEC = 966 * MiB;
constexpr size_t WS_RGSA = 967 * MiB;
constexpr size_t WS_RGSH = 967 * MiB + 512 * 1024;
constexpr size_t WS_RGC  = 968 * MiB;
constexpr size_t WS_KCMP = 969 * MiB;
constexpr size_t WS_VCMP = 969 * MiB + 256 * 1024;
constexpr size_t WS_SEL  = 970 * MiB;
constexpr size_t WS_END  = 972 * MiB;

constexpr int CW_TMO = 0;
constexpr int CW_BAR = 4096;
constexpr int CW_Q = 8192;

constexpr int RING_BYTES = 131072;
constexpr int LDSCTL_OFF = 143360, MISC_OFF = LDSCTL_OFF + 320;
constexpr int LDS_BYTES = 147456;
constexpr int NWAVES = 8;

#define GAS __attribute__((address_space(1)))
#define LAS __attribute__((address_space(3)))
typedef unsigned short bf16;
typedef unsigned v4u __attribute__((ext_vector_type(4)));
typedef unsigned v2u __attribute__((ext_vector_type(2)));
typedef float f32x4 __attribute__((ext_vector_type(4)));
typedef float f32x16 __attribute__((ext_vector_type(16)));
typedef short bf16x8 __attribute__((ext_vector_type(8)));
typedef short s16x4 __attribute__((ext_vector_type(4)));
typedef GAS unsigned gu32;
#define RLX_AGENT __ATOMIC_RELAXED, __HIP_MEMORY_SCOPE_AGENT
#define LDS_WAIT() asm volatile("s_waitcnt lgkmcnt(0)" ::: "memory")
#define VM_WAIT() asm volatile("s_waitcnt vmcnt(0)" ::: "memory")
#define SBAR() __builtin_amdgcn_sched_barrier(0)
__device__ __forceinline__ unsigned f2bf(float f) { unsigned u = __builtin_bit_cast(unsigned, f); return (u + 0x7fffu + ((u >> 16) & 1u)) >> 16; }
__device__ __forceinline__ unsigned pk2(float lo, float hi) { return f2bf(lo) | (f2bf(hi) << 16); }
__device__ __forceinline__ float bf2f(unsigned h) { return __builtin_bit_cast(float, h << 16); }
__device__ __forceinline__ float bflo(unsigned w) { return __builtin_bit_cast(float, w << 16); }
__device__ __forceinline__ float bfhi(unsigned w) { return __builtin_bit_cast(float, w & 0xffff0000u); }
__device__ __forceinline__ float sigm(float x) { return 1.0f / (1.0f + __expf(-x)); }
__device__ __forceinline__ float silu(float x) { return x / (1.0f + __expf(-x)); }
__device__ __forceinline__ int crow(int r, int hi) { return (r & 3) + 8 * (r >> 2) + 4 * hi; }
__device__ __forceinline__ unsigned cvtpk(float lo, float hi) { unsigned r; asm volatile("v_cvt_pk_bf16_f32 %0, %1, %2" : "=v"(r) : "v"(lo), "v"(hi)); return r; }
__device__ __forceinline__ float wave_sum(float v) {
#pragma unroll
    for (int o = 1; o < 64; o <<= 1) v += __shfl_xor(v, o);
    return v;
}
#define XB_TMO      128
#define XB_XCNT(j)  (256  + 64 * (j))
#define XB_XSUB(j)  (1280 + 64 * (j))
#define XB_XGEN(j)  (2304 + 64 * (j))
#define XB_TOP      3328
#define XB_TOPGEN   3392
#define XCD_BAR_WORDS 3456
#define XB_SPIN_CAP (1u << 18)

__device__ __forceinline__ unsigned xb_ld(unsigned* p)              { return __hip_atomic_load(p, __ATOMIC_RELAXED, __HIP_MEMORY_SCOPE_AGENT); }
__device__ __forceinline__ unsigned xb_add(unsigned* p, unsigned v) { return __hip_atomic_fetch_add(p, v, __ATOMIC_RELAXED, __HIP_MEMORY_SCOPE_AGENT); }
__device__ __forceinline__ unsigned xb_xcc_id() { return (unsigned)__builtin_amdgcn_s_getreg((3 << 11) | 20) & 0xFu; }
#define XB_SPIN(cond, bar) do { unsigned _sp = 0; while (cond) { __builtin_amdgcn_s_sleep(1); \
    if ((++_sp & 255u) == 0u) { if (xb_ld(&(bar)[XB_TMO])) break; if (_sp > XB_SPIN_CAP) { atomicAdd(&(bar)[XB_TMO], 1u); break; } } } } while (0)

struct XcdBarrier {
    unsigned* bar; unsigned x;
    volatile LAS unsigned* st;
};

__device__ __forceinline__ XcdBarrier xcd_barrier_post(unsigned* bar, volatile LAS unsigned* st) {
    XcdBarrier b; b.bar = bar; b.x = xb_xcc_id(); b.st = st;
    if (threadIdx.x == 0) (void)xb_add(&bar[XB_XCNT(b.x)], 1u);
    return b;
}
__device__ __forceinline__ void xcd_barrier_complete(unsigned* bar, unsigned x, unsigned& nloc, unsigned& nx) {
    const unsigned G = gridDim.x * gridDim.y * gridDim.z;
    unsigned sum, cnt, mine, sp = 0u;
    for (;;) {
        sum = 0u; cnt = 0u; mine = 0u;
#pragma unroll
        for (unsigned j = 0; j < 16; ++j) { const unsigned c = xb_ld(&bar[XB_XCNT(j)]); sum += c; cnt += (c > 0u) ? 1u : 0u; mine = (j == x) ? c : mine; }
        if (sum == G) break;
        __builtin_amdgcn_s_sleep(1);
        if ((++sp & 255u) == 0u) { if (xb_ld(&bar[XB_TMO])) break; if (sp > XB_SPIN_CAP) { atomicAdd(&bar[XB_TMO], 1u); break; } }
    }
    nloc = mine > 0u ? mine : 1u; nx = cnt > 0u ? cnt : 1u;
}

__device__ __forceinline__ void xcd_barrier(const XcdBarrier& b) {
    asm volatile("s_waitcnt vmcnt(0)" ::: "memory");
    __syncthreads();
    if (threadIdx.x == 0) {
        unsigned* bar = b.bar;
        __builtin_amdgcn_s_waitcnt(0);
        unsigned nloc = b.st[0], nx = b.st[1];
        if (nloc == 0u) { xcd_barrier_complete(bar, b.x, nloc, nx); b.st[0] = nloc; b.st[1] = nx; }
        const unsigned old = xb_add(&bar[XB_XSUB(b.x)], 1u);
        const unsigned gen = old / nloc;
        if (old + 1u == (gen + 1u) * nloc) {
            __builtin_amdgcn_fence(__ATOMIC_RELEASE, "agent");
            asm volatile("s_waitcnt vmcnt(0)" ::: "memory");
            const unsigned og = xb_add(&bar[XB_TOP], 1u);
            const unsigned tg = og / nx;
            if (og + 1u == (tg + 1u) * nx) xb_add(&bar[XB_TOPGEN], 1u);
            else XB_SPIN(xb_ld(&bar[XB_TOPGEN]) == tg, bar);
            __builtin_amdgcn_fence(__ATOMIC_ACQUIRE, "agent");
            xb_add(&bar[XB_XGEN(b.x)], 1u);
            asm volatile("s_waitcnt vmcnt(0)" ::: "memory");
        } else {
            XB_SPIN(xb_ld(&bar[XB_XGEN(b.x)]) == gen, bar);
            __builtin_amdgcn_fence(__ATOMIC_ACQUIRE, "agent");
            asm volatile("s_waitcnt vmcnt(0)" ::: "memory");
        }
    }
    __syncthreads();
}

struct Frame {
    LAS unsigned char* lds;
    volatile LAS unsigned* MISC;
    gu32* ctl;
    int tid, lane, wave, vcu, G;
    unsigned char* ws; float* out;
    const float* const* in;
};
__device__ __forceinline__ bf16* ws_bf(const Frame& F, size_t off) { return (bf16*)(F.ws + off); }
__device__ __forceinline__ float* ws_f(const Frame& F, size_t off) { return (float*)(F.ws + off); }

__device__ __forceinline__ int launder_u(int v) { asm volatile("" : "+v"(v)); return __builtin_amdgcn_readfirstlane(v); }
template <class T> __device__ __forceinline__ T* launder_p(T* p) { const unsigned long long a = (unsigned long long)p;
    const unsigned lo = (unsigned)launder_u((int)(unsigned)a), hi = (unsigned)launder_u((int)(unsigned)(a >> 32)); return (T*)(((unsigned long long)hi << 32) | lo); }
__device__ __forceinline__ void launder(Frame& F) {
    F.ws = launder_p(F.ws); F.out = launder_p(F.out); F.ctl = (gu32*)launder_p((unsigned*)F.ctl);
    F.G = launder_u(F.G); F.vcu = launder_u(F.vcu);
    { const unsigned lb = (unsigned)launder_u((int)(unsigned)(uintptr_t)F.lds); F.lds = (LAS unsigned char*)(uintptr_t)lb; F.MISC = (volatile LAS unsigned*)(F.lds + MISC_OFF); }
    { int t = threadIdx.x; asm volatile("" : "+v"(t)); F.tid = t; F.lane = t & 63; F.wave = __builtin_amdgcn_readfirstlane(t >> 6); }
}

__device__ __forceinline__ int q_next(Frame& F, int qid) {
    __syncthreads();
    if (F.tid == 0) F.MISC[0] = __hip_atomic_fetch_add(F.ctl + CW_Q + 64 * qid, 1u, RLX_AGENT);
    __syncthreads();
    return (int)F.MISC[0];
}

__device__ __forceinline__ int win_src_col(int np) { return np < 5632 ? np : (np < 11776 ? np + 48 : (np < 11824 ? np - 11776 + 5632 : -1)); }
template <int MODE>
__device__ __forceinline__ void transpose_item(const float* W, int K, int N, bf16* WT, LAS float* scr, int kb, int nb, int lane) {
    const int k0 = 64 * kb, n0 = 64 * nb, rr = lane >> 4, cq = lane & 15;
    int nsrc = n0 + 4 * cq; if (MODE == 1) nsrc = win_src_col(nsrc);
    const float* src = W + (size_t)(k0 + rr) * N + (nsrc >= 0 ? nsrc : 0);
    f32x4 v[16];
#pragma unroll
    for (int i = 0; i < 16; ++i) v[i] = (nsrc >= 0) ? *(const GAS f32x4*)(src + (size_t)(4 * i) * N) : (f32x4){0.f, 0.f, 0.f, 0.f};
#pragma unroll
    for (int i = 0; i < 16; ++i) { LAS float* d = scr + (4 * i + rr) * 65 + 4 * cq; d[0] = v[i][0]; d[1] = v[i][1]; d[2] = v[i][2]; d[3] = v[i][3]; }
    LDS_WAIT(); asm volatile("" ::: "memory");
    const int c = lane & 7;
#pragma unroll
    for (int j = 0; j < 8; ++j) { const int n = (lane >> 3) + 8 * j; const LAS float* s = scr + (8 * c) * 65 + n;
        v4u o; o.x = pk2(s[0 * 65], s[1 * 65]); o.y = pk2(s[2 * 65], s[3 * 65]); o.z = pk2(s[4 * 65], s[5 * 65]); o.w = pk2(s[6 * 65], s[7 * 65]);
        *(GAS v4u*)(WT + (size_t)(n0 + n) * K + k0 + 8 * c) = o; }
    LDS_WAIT(); asm volatile("" ::: "memory");
}

__device__ __forceinline__ void ada_item(Frame& F, int item) {
    const int l = item / 384, n0 = (item % 384) * 32;
    const float* W = F.in[2] + (size_t)l * DM * 12288;
    const LAS float* cl = (const LAS float*)F.lds;
    LAS float* red = (LAS float*)(F.lds + 65536);
    const int kq = F.lane >> 3, nq = F.lane & 7;
    f32x4 acc[4];
#pragma unroll
    for (int b = 0; b < 4; ++b) acc[b] = (f32x4){0.f, 0.f, 0.f, 0.f};
#pragma unroll 8
    for (int i = 0; i < 64; ++i) {
        const int k = 64 * i + 8 * F.wave + kq;
        const f32x4 w = *(const GAS f32x4*)(W + (size_t)k * 12288 + n0 + 4 * nq);
#pragma unroll
        for (int b = 0; b < 4; ++b) acc[b] += w * cl[b * DM + k];
    }
#pragma unroll
    for (int b = 0; b < 4; ++b)
#pragma unroll
        for (int e = 0; e < 4; ++e) { float v = acc[b][e]; v += __shfl_xor(v, 8); v += __shfl_xor(v, 16); v += __shfl_xor(v, 32);
            if (kq == 0) red[(F.wave * 4 + b) * 32 + 4 * nq + e] = v; }
    __syncthreads();
    if (F.tid < 128) { const int b = F.tid >> 5, n = F.tid & 31; float s = 0.f;
#pragma unroll
        for (int w = 0; w < 8; ++w) s += red[(w * 4 + b) * 32 + n];
        ws_f(F, WS_MOD)[(size_t)(l * 4 + b) * 12288 + n0 + n] = s + F.in[3][l * 12288 + n0 + n]; }
    __syncthreads();
}

__device__ __forceinline__ void p0_prologue(Frame& F) {
    { LAS float* cl = (LAS float*)F.lds;
      for (int i = F.tid; i < 4 * DM / 4; i += NWAVES * 64) ((LAS f32x4*)cl)[i] = ((const GAS f32x4*)F.in[1])[i];
      __syncthreads();
      for (int it = F.vcu; it < 768; it += F.G) ada_item(F, it);
      __syncthreads(); }
    LAS float* scr = (LAS float*)(F.lds + F.wave * 16640);
    const int gw = F.vcu * NWAVES + F.wave, NGW = F.G * NWAVES;
    constexpr int I_WIN = 64 * (NPAD / 64), I_WOUT = 64 * (DM / 64), I_W1 = 64 * 4, I_W2 = 4 * 2, I_RG = 2 * 2;
    constexpr int NIT = 2 * I_WIN + 2 * I_WOUT + 4 * I_W1 + 4 * I_W2 + 32 * I_RG;
    for (int it = gw; it < NIT; it += NGW) {
        int r = it;
        if (r < 2 * I_WIN) { const int l = r / I_WIN; r -= l * I_WIN; const int nblk = NPAD / 64;
            transpose_item<1>(F.in[4] + (size_t)l * DM * NIN, DM, NIN, ws_bf(F, WS_WIN) + (size_t)l * NPAD * DM, scr, r / nblk, r % nblk, F.lane); continue; }
        r -= 2 * I_WIN;
        if (r < 2 * I_WOUT) { const int l = r / I_WOUT; r -= l * I_WOUT; const int nblk = DM / 64;
            transpose_item<0>(F.in[20] + (size_t)l * DM * DM, DM, DM, ws_bf(F, WS_WOUT) + (size_t)l * DM * DM, scr, r / nblk, r % nblk, F.lane); continue; }
        r -= 2 * I_WOUT;
        if (r < 4 * I_W1) { const int lk = r / I_W1; r -= lk * I_W1; const int l = lk >> 1, kv = lk & 1;
            transpose_item<0>((kv ? F.in[16] : F.in[14]) + (size_t)l * 4096 * 256, 4096, 256, ws_bf(F, WS_W1T) + (size_t)lk * 256 * 4096, scr, r / 4, r % 4, F.lane); continue; }
        r -= 4 * I_W1;
        if (r < 4 * I_W2) { const int lk = r / I_W2; r -= lk * I_W2; const int l = lk >> 1, kv = lk & 1;
            transpose_item<0>((kv ? F.in[17] : F.in[15]) + (size_t)l * 256 * 128, 256, 128, ws_bf(F, WS_W2T) + (size_t)lk * 128 * 256, scr, r / 2, r % 2, F.lane); continue; }
        r -= 4 * I_W2;
        { const int mi = r / I_RG; r -= mi * I_RG; const int l = mi >> 4, gate = (mi >> 3) & 1, n = mi & 7;
            transpose_item<0>((gate ? F.in[9] : F.in[7]) + (size_t)(l * 8 + n) * 128 * 128, 128, 128, ws_bf(F, WS_RGW) + (size_t)mi * 128 * 128, scr, r / 2, r % 2, F.lane); }
    }
    { const int g = F.vcu * NWAVES * 64 + F.tid;
      if (g < 2 * 8 * 128 / 2) { const int kv = g >> 9, rest = g & 511, bg = rest >> 6, e = rest & 63;
          ((unsigned*)(F.ws + (kv ? WS_VCMP : WS_KCMP)))[(size_t)(bg * 128 + 127) * 64 + e] = 0u; } }
}

__device__ __forceinline__ void p1_u0(Frame& F) {
    const int gw = F.vcu * NWAVES + F.wave, NGW = F.G * NWAVES;
    const float* mod = ws_f(F, WS_MOD);
    bf16* U = ws_bf(F, WS_U);
    for (int m = gw; m < MROWS; m += NGW) {
        const int b = m / SEQ;
        const GAS f32x4* xr = (const GAS f32x4*)(F.in[0] + (size_t)m * DM);
        const GAS f32x4* sh = (const GAS f32x4*)(mod + (size_t)b * 12288);
        const GAS f32x4* sc = (const GAS f32x4*)(mod + (size_t)b * 12288 + DM);
        GAS v2u* o = (GAS v2u*)(U + (size_t)m * DM);
#pragma unroll 4
        for (int j = 0; j < 16; ++j) { const int idx = 64 * j + F.lane; const f32x4 v = xr[idx] * (sc[idx] + 1.0f) + sh[idx];
            v2u w; w.x = pk2(v[0], v[1]); w.y = pk2(v[2], v[3]); o[idx] = w; }
    }
}

__device__ __forceinline__ void ln_phase(Frame& F, int l, float* xout, bool unext) {
    const int gw = F.vcu * NWAVES + F.wave, NGW = F.G * NWAVES;
    const float* Vb = ws_f(F, WS_V);
    const float* mod = ws_f(F, WS_MOD) + (size_t)(l + 1) * 4 * 12288;
    bf16* U = ws_bf(F, WS_U);
    const GAS f32x4* g4 = (const GAS f32x4*)(F.in[21] + (size_t)l * DM);
    const GAS f32x4* b4 = (const GAS f32x4*)(F.in[22] + (size_t)l * DM);
    for (int m = gw; m < MROWS; m += NGW) {
        const int b = m / SEQ;
        const GAS f32x4* vr = (const GAS f32x4*)(Vb + (size_t)m * DM);
        f32x4 v[16]; float s = 0.f;
#pragma unroll
        for (int j = 0; j < 16; ++j) { v[j] = vr[64 * j + F.lane]; s += (v[j][0] + v[j][1]) + (v[j][2] + v[j][3]); }
        const float mean = wave_sum(s) * (1.0f / DM); float s2 = 0.f;
#pragma unroll
        for (int j = 0; j < 16; ++j) { v[j] = v[j] - mean; s2 += (v[j][0] * v[j][0] + v[j][1] * v[j][1]) + (v[j][2] * v[j][2] + v[j][3] * v[j][3]); }
        const float rstd = 1.0f / sqrtf(wave_sum(s2) * (1.0f / DM) + LN_EPS);
        GAS f32x4* xo = (GAS f32x4*)(xout + (size_t)m * DM);
        if (unext) {
            const GAS f32x4* sh = (const GAS f32x4*)(mod + (size_t)b * 12288);
            const GAS f32x4* sc = (const GAS f32x4*)(mod + (size_t)b * 12288 + DM);
            GAS v2u* o = (GAS v2u*)(U + (size_t)m * DM);
#pragma unroll
            for (int j = 0; j < 16; ++j) { const int idx = 64 * j + F.lane; const f32x4 y = v[j] * rstd * g4[idx] + b4[idx]; xo[idx] = y;
                const f32x4 u = y * (sc[idx] + 1.0f) + sh[idx]; v2u w; w.x = pk2(u[0], u[1]); w.y = pk2(u[2], u[3]); o[idx] = w; }
        } else {
#pragma unroll
            for (int j = 0; j < 16; ++j) { const int idx = 64 * j + F.lane; xo[idx] = v[j] * rstd * g4[idx] + b4[idx]; }
        }
    }
}

__device__ __forceinline__ f32x16 mfma32(bf16x8 a, bf16x8 b, f32x16 c) { return __builtin_amdgcn_mfma_f32_32x32x16_bf16(a, b, c, 0, 0, 0); }
__device__ __forceinline__ f32x4 mfma16(bf16x8 a, bf16x8 b, f32x4 c) { return __builtin_amdgcn_mfma_f32_16x16x32_bf16(a, b, c, 0, 0, 0); }
__device__ __forceinline__ bf16x8 as_bf16x8(v4u w) { return __builtin_bit_cast(bf16x8, w); }

template <int PASS>
__device__ __forceinline__ void rg_item(Frame& F, int l, int item) {
    const int n = item & 7, c = (item >> 3) & 31, b = item >> 8;
    LAS float* xcf = (LAS float*)(F.lds);
    LAS bf16*  xcb = (LAS bf16*)(F.lds + 32768);
    LAS float* aL  = (LAS float*)(F.lds + 50176);
    LAS float* bxL = (LAS float*)(F.lds + 82944);
    LAS float* qs  = (LAS float*)(F.lds + 115712);
    const bf16* P = ws_bf(F, WS_P);
    const int d = F.tid & 127, tq = F.tid >> 7, ch = n * 128 + d;
    const size_t rowbase = (size_t)b * SEQ + 64 * c;
    {
        const float w0 = F.in[5][(l * 4 + 0) * 1024 + ch], w1 = F.in[5][(l * 4 + 1) * 1024 + ch], w2 = F.in[5][(l * 4 + 2) * 1024 + ch],
                    w3 = F.in[5][(l * 4 + 3) * 1024 + ch], cb = F.in[6][l * 1024 + ch];
        float xv[19];
#pragma unroll
        for (int i = 0; i < 19; ++i) { const int tl = 64 * c + 16 * tq - 3 + i; xv[i] = (tl >= 0) ? bf2f(P[((size_t)b * SEQ + tl) * NPAD + PC_RGX + ch]) : 0.f; }
#pragma unroll
        for (int i = 0; i < 16; ++i) { const float y = cb + w0 * xv[i] + w1 * xv[i + 1] + w2 * xv[i + 2] + w3 * xv[i + 3]; const int t = 16 * tq + i;
            xcf[t * 128 + d] = y; xcb[t * 136 + d] = (bf16)f2bf(y); }
    }
    __syncthreads();
    {
        const int rt = F.wave & 1, ct = F.wave >> 1, r32 = F.lane & 31, hi = F.lane >> 5;
        const bf16* WA = ws_bf(F, WS_RGW) + (size_t)((l * 2 + 0) * 8 + n) * 16384;
        const bf16* WX = ws_bf(F, WS_RGW) + (size_t)((l * 2 + 1) * 8 + n) * 16384;
        f32x16 ga = {}, gx = {};
#pragma unroll
        for (int s = 0; s < 8; ++s) {
            const bf16x8 a = *(const LAS bf16x8*)(xcb + (32 * rt + r32) * 136 + 16 * s + 8 * hi);
            const bf16x8 wa = *(const GAS bf16x8*)(WA + (32 * ct + r32) * 128 + 16 * s + 8 * hi);
            const bf16x8 wx = *(const GAS bf16x8*)(WX + (32 * ct + r32) * 128 + 16 * s + 8 * hi);
            ga = mfma32(a, wa, ga); gx = mfma32(a, wx, gx);
        }
        const int e = 32 * ct + r32, che = n * 128 + e;
        const float ba_ = F.in[8][l * 1024 + che], bx_ = F.in[10][l * 1024 + che], lam = F.in[11][l * 1024 + che];
        const float sp8 = 8.0f * log1pf(__expf(-lam));
#pragma unroll
        for (int r = 0; r < 16; ++r) { const int t = 32 * rt + crow(r, hi);
            const float rg = sigm(ga[r] + ba_), ig = sigm(gx[r] + bx_);
            const float la = -sp8 * rg; const float a = __expf(la); float mult = sqrtf(-expm1f(2.0f * la)); if (c == 0 && t == 0) mult = 1.0f;
            aL[t * 128 + e] = a; bxL[t * 128 + e] = mult * ig * xcf[t * 128 + e]; }
    }
    __syncthreads();
    {
        float av[16], bv[16];
#pragma unroll
        for (int i = 0; i < 16; ++i) { av[i] = aL[(16 * tq + i) * 128 + d]; bv[i] = bxL[(16 * tq + i) * 128 + d]; }
        float Ap = 1.0f, H = 0.f;
#pragma unroll
        for (int i = 0; i < 16; ++i) { H = av[i] * H + bv[i]; Ap *= av[i]; }
        qs[(tq * 128 + d) * 2 + 0] = Ap; qs[(tq * 128 + d) * 2 + 1] = H;
        __syncthreads();
        float hin = 0.f, atot = 1.0f;
        if (PASS == 3) hin = ws_f(F, WS_RGC)[(size_t)(b * 32 + c) * 1024 + ch];
        for (int q = 0; q < tq; ++q) { const float aq = qs[(q * 128 + d) * 2], hq = qs[(q * 128 + d) * 2 + 1]; hin = aq * hin + hq; atot *= aq; }
        if (PASS == 1) {
            if (tq == 3) { ws_f(F, WS_RGSA)[(size_t)(b * 32 + c) * 1024 + ch] = atot * Ap; ws_f(F, WS_RGSH)[(size_t)(b * 32 + c) * 1024 + ch] = Ap * hin + H; }
        } else {
            bf16* Y = ws_bf(F, WS_YCAT);
            float h = hin;
#pragma unroll
            for (int i = 0; i < 16; ++i) { h = av[i] * h + bv[i]; const size_t row = rowbase + 16 * tq + i;
                const float gt = bf2f(P[row * NPAD + PC_RGG + ch]);
                Y[row * DM + ch] = (bf16)f2bf(h * silu(gt)); }
        }
    }
    __syncthreads();
}
__device__ __forceinline__ void rg_pass2(Frame& F) {
    const int g = F.vcu * NWAVES * 64 + F.tid;
    if (g < BATCH * D_RG) { const int b = g >> 10, ch = g & 1023; float h = 0.f;
        const float* A = ws_f(F, WS_RGSA); const float* Hh = ws_f(F, WS_RGSH); float* C = ws_f(F, WS_RGC);
#pragma unroll 8
        for (int c = 0; c < 32; ++c) { const size_t idx = (size_t)(b * 32 + c) * 1024 + ch; C[idx] = h; h = A[idx] * h + Hh[idx]; } }
}

__device__ __forceinline__ float hg_lower_bound(const Frame& F, int l, int ch) {
    if (l == 0) return 0.f;
    return 1.0f / (1.0f + __expf(F.in[18][ch] - F.in[18][1024 + ch]));
}
__device__ __forceinline__ void hg_fk(float z, float lb, int l, float& lf, float& kk) {
    if (l == 0) { lf = fminf(z, 0.f) - log1pf(__expf(-fabsf(z))); kk = sigm(-z); }
    else { const float sg = sigm(z); lf = __logf(lb + (1.0f - lb) * sg); kk = (1.0f - lb) * sigm(-z); }
}
__device__ __forceinline__ void hg1_item(Frame& F, int l, int item) {
    const int c = item & 31, bh = item >> 5, b = bh >> 3, h = bh & 7;
    LAS float* part = (LAS float*)(F.lds);
    LAS bf16* kdT = (LAS bf16*)(F.lds + 2048);
    LAS bf16* vT  = (LAS bf16*)(F.lds + 2048 + 18432);
    const bf16* P = ws_bf(F, WS_P);
    const int k = F.tid & 127, tq = F.tid >> 7, ch = h * 128 + k;
    const size_t row0 = (size_t)b * SEQ + 64 * c + 16 * tq;
    const float lb = hg_lower_bound(F, l, ch);
    float lf[16], kk[16]; float ps = 0.f;
#pragma unroll
    for (int i = 0; i < 16; ++i) { const float z = bf2f(P[(row0 + i) * NPAD + PC_HGF + ch]); hg_fk(z, lb, l, lf[i], kk[i]); ps += lf[i]; }
    part[tq * 128 + k] = ps;
    unsigned vv[8];
#pragma unroll
    for (int i = 0; i < 8; ++i) { const unsigned lo = P[(row0 + 2 * i) * NPAD + PC_HGI + ch], hi2 = P[(row0 + 2 * i + 1) * NPAD + PC_HGI + ch]; vv[i] = lo | (hi2 << 16); }
    *(LAS v4u*)(vT + k * 72 + 16 * tq) = (v4u){vv[0], vv[1], vv[2], vv[3]};
    *(LAS v4u*)(vT + k * 72 + 16 * tq + 8) = (v4u){vv[4], vv[5], vv[6], vv[7]};
    __syncthreads();
    {
        float off = 0.f, tot = 0.f;
#pragma unroll
        for (int q = 0; q < 4; ++q) { const float pq = part[q * 128 + k]; tot += pq; if (q < tq) off += pq; }
        float run = off; unsigned w[8];
#pragma unroll
        for (int i = 0; i < 8; ++i) { run += lf[2 * i]; const float k0 = kk[2 * i] * __expf(tot - run); run += lf[2 * i + 1]; const float k1 = kk[2 * i + 1] * __expf(tot - run); w[i] = pk2(k0, k1); }
        *(LAS v4u*)(kdT + k * 72 + 16 * tq) = (v4u){w[0], w[1], w[2], w[3]};
        *(LAS v4u*)(kdT + k * 72 + 16 * tq + 8) = (v4u){w[4], w[5], w[6], w[7]};
        if (tq == 0) ws_f(F, WS_HDEC)[(size_t)item * 128 + k] = __expf(tot);
    }
    __syncthreads();
    {
        const int vt = F.wave >> 1, kt0 = 2 * (F.wave & 1), r32 = F.lane & 31, hi = F.lane >> 5;
        f32x16 a0 = {}, a1 = {};
#pragma unroll
        for (int s = 0; s < 4; ++s) {
            const bf16x8 a = *(const LAS bf16x8*)(vT + (32 * vt + r32) * 72 + 16 * s + 8 * hi);
            const bf16x8 b0 = *(const LAS bf16x8*)(kdT + (32 * kt0 + r32) * 72 + 16 * s + 8 * hi);
            const bf16x8 b1 = *(const LAS bf16x8*)(kdT + (32 * (kt0 + 1) + r32) * 72 + 16 * s + 8 * hi);
            a0 = mfma32(a, b0, a0); a1 = mfma32(a, b1, a1);
        }
        float* HS = ws_f(F, WS_HS) + (size_t)item * 16384;
#pragma unroll
        for (int r = 0; r < 16; ++r) { const int v = 32 * vt + crow(r, hi); HS[v * 128 + 32 * kt0 + r32] = a0[r]; HS[v * 128 + 32 * kt0 + 32 + r32] = a1[r]; }
    }
    __syncthreads();
}
__device__ __forceinline__ void hg_pass2(Frame& F) {
    float* HS = ws_f(F, WS_HS); const float* DEC = ws_f(F, WS_HDEC);
    for (int g = F.vcu * NWAVES * 64 + F.tid; g < 32 * 4096; g += F.G * NWAVES * 64) {
        const int bh = g >> 12, e4 = g & 4095, k4 = (e4 & 31) * 4;
        f32x4 S = {0.f, 0.f, 0.f, 0.f};
#pragma unroll 8
        for (int c = 0; c < 32; ++c) { GAS f32x4* p = (GAS f32x4*)(HS + ((size_t)(bh * 32 + c) * 16384) + e4 * 4);
            const f32x4 tmp = *p; const f32x4 d4 = *(const GAS f32x4*)(DEC + (size_t)(bh * 32 + c) * 128 + k4); *p = S; S = S * d4 + tmp; }
    }
}
__device__ __forceinline__ void hg3_item(Frame& F, int l, int item) {
    const int c = item & 31, bh = item >> 5, b = bh >> 3, h = bh & 7;
    LAS float* part = (LAS float*)(F.lds);
    LAS bf16* qi   = (LAS bf16*)(F.lds + 2048);
    LAS bf16* qd1  = (LAS bf16*)(F.lds + 19456);
    LAS bf16* kd00 = (LAS bf16*)(F.lds + 28160);
    LAS bf16* kd10 = (LAS bf16*)(F.lds + 36864);
    LAS bf16* kd11 = (LAS bf16*)(F.lds + 45568);
    LAS bf16* sT   = (LAS bf16*)(F.lds + 54272);
    LAS bf16* vT   = (LAS bf16*)(F.lds + 89088);
    LAS bf16* Abf  = (LAS bf16*)(F.lds + 107520);
    LAS float* ssq = (LAS float*)(F.lds + 116736);
    const bf16* P = ws_bf(F, WS_P);
    const int k = F.tid & 127, tq = F.tid >> 7, ch = h * 128 + k;
    const size_t row0 = (size_t)b * SEQ + 64 * c + 16 * tq;
    const float lb = hg_lower_bound(F, l, ch);
    float lf[16], kk[16], qv[16]; float ps = 0.f;
#pragma unroll
    for (int i = 0; i < 16; ++i) { const float z = bf2f(P[(row0 + i) * NPAD + PC_HGF + ch]); hg_fk(z, lb, l, lf[i], kk[i]); ps += lf[i];
        qv[i] = silu(bf2f(P[(row0 + i) * NPAD + PC_HGQ + ch])); }
    part[tq * 128 + k] = ps;
    {
        unsigned vv[8];
#pragma unroll
        for (int i = 0; i < 8; ++i) { const unsigned lo = P[(row0 + 2 * i) * NPAD + PC_HGI + ch], hi2 = P[(row0 + 2 * i + 1) * NPAD + PC_HGI + ch]; vv[i] = lo | (hi2 << 16); }
        *(LAS v4u*)(vT + k * 72 + 16 * tq) = (v4u){vv[0], vv[1], vv[2], vv[3]};
        *(LAS v4u*)(vT + k * 72 + 16 * tq + 8) = (v4u){vv[4], vv[5], vv[6], vv[7]};
    }
    {
        const int v = F.tid >> 2, k0 = (F.tid & 3) * 32;
        const GAS f32x4* src = (const GAS f32x4*)(ws_f(F, WS_HS) + (size_t)item * 16384 + v * 128 + k0);
#pragma unroll
        for (int j = 0; j < 4; ++j) { const f32x4 x0 = src[2 * j], x1 = src[2 * j + 1];
            *(LAS v4u*)(sT + v * 136 + k0 + 8 * j) = (v4u){pk2(x0[0], x0[1]), pk2(x0[2], x0[3]), pk2(x1[0], x1[1]), pk2(x1[2], x1[3])}; }
    }
    __syncthreads();
    {
        float off = 0.f;
#pragma unroll
        for (int q = 0; q < 4; ++q) { const float pq = part[q * 128 + k]; if (q < tq) off += pq; }
        const float bref1 = part[k] + part[128 + k];
        float run = off;
#pragma unroll
        for (int i = 0; i < 16; ++i) { run += lf[i]; const int t = 16 * tq + i;
            qi[t * 136 + k] = (bf16)f2bf(qv[i] * __expf(run));
            if (tq < 2) { kd00[t * 136 + k] = (bf16)f2bf(kk[i] * __expf(-run)); kd10[t * 136 + k] = (bf16)f2bf(kk[i] * __expf(bref1 - run)); }
            else { qd1[(t - 32) * 136 + k] = (bf16)f2bf(qv[i] * __expf(run - bref1)); kd11[(t - 32) * 136 + k] = (bf16)f2bf(kk[i] * __expf(bref1 - run)); } }
    }
    __syncthreads();
    const int r32 = F.lane & 31, hi = F.lane >> 5;
    if (F.wave < 4) {
        const int I = (F.wave == 0 || F.wave == 3) ? 0 : 1, J = (F.wave == 2 || F.wave == 3) ? 1 : 0;
        f32x16 a = {};
        if (F.wave != 3) {
            const LAS bf16* Aop = (F.wave == 0) ? qi : qd1;
            const LAS bf16* Bop = (F.wave == 0) ? kd00 : (F.wave == 1 ? kd10 : kd11);
#pragma unroll
            for (int s = 0; s < 8; ++s) a = mfma32(*(const LAS bf16x8*)(Aop + r32 * 136 + 16 * s + 8 * hi), *(const LAS bf16x8*)(Bop + r32 * 136 + 16 * s + 8 * hi), a);
        }
#pragma unroll
        for (int r = 0; r < 16; ++r) { const int tt = crow(r, hi); float x = a[r]; if (I == J && r32 > tt) x = 0.f;
            Abf[(32 * I + tt) * 72 + 32 * J + r32] = (bf16)f2bf(x); }
    }
    __syncthreads();
    {
        const int I = F.wave & 1, vt = F.wave >> 1;
        f32x16 o = {};
#pragma unroll
        for (int s = 0; s < 8; ++s) o = mfma32(*(const LAS bf16x8*)(qi + (32 * I + r32) * 136 + 16 * s + 8 * hi), *(const LAS bf16x8*)(sT + (32 * vt + r32) * 136 + 16 * s + 8 * hi), o);
#pragma unroll
        for (int s = 0; s < 4; ++s) if (s < 2 * (I + 1)) o = mfma32(*(const LAS bf16x8*)(Abf + (32 * I + r32) * 72 + 16 * s + 8 * hi), *(const LAS bf16x8*)(vT + (32 * vt + r32) * 72 + 16 * s + 8 * hi), o);
#pragma unroll
        for (int r = 0; r < 16; ++r) { float ss = o[r] * o[r];
            ss += __shfl_xor(ss, 1); ss += __shfl_xor(ss, 2); ss += __shfl_xor(ss, 4); ss += __shfl_xor(ss, 8); ss += __shfl_xor(ss, 16);
            if (r32 == 0) ssq[(32 * I + crow(r, hi)) * 4 + vt] = ss; }
        __syncthreads();
        const int v = 32 * vt + r32; const float ng = F.in[19][l * 128 + v];
        bf16* Y = ws_bf(F, WS_YCAT);
#pragma unroll
        for (int r = 0; r < 16; ++r) { const int t = 32 * I + crow(r, hi);
            const float tot = (ssq[t * 4] + ssq[t * 4 + 1]) + (ssq[t * 4 + 2] + ssq[t * 4 + 3]);
            const float rs = 1.0f / sqrtf(tot * (1.0f / 128.0f) + RMS_EPS);
            const size_t row = (size_t)b * SEQ + 64 * c + t;
            const float gt = silu(bf2f(P[row * NPAD + PC_HGG + h * 128 + v]));
            Y[row * DM + 3072 + h * 128 + v] = (bf16)f2bf(o[r] * rs * ng * gt); }
    }
    __syncthreads();
}

__device__ __forceinline__ void cmp_item(Frame& F, int l, int item) {
    const int kv = item >> 6, rt = item & 63;
    const int arow = F.lane & 15, kq = F.lane >> 4;
    LAS float* slots = (LAS float*)F.lds;
    LAS bf16* hbf = (LAS bf16*)(F.lds + 65536);
    const bf16* P = ws_bf(F, WS_P);
    int rho = rt * 16 + arow; if (rho > 1015) rho = 1015;
    const int b = rho / 254, rem = rho - b * 254, j = rem >> 1, g = rem & 1;
    const bf16* xrow = P + ((size_t)b * SEQ + 16 * j) * NPAD + PC_KVC + kv * 256 + g * 128;
    const bf16* W1T = ws_bf(F, WS_W1T) + (size_t)(l * 2 + kv) * 256 * 4096;
    const float* pe = (kv ? F.in[13] : F.in[12]) + l * 32 * 128;
    f32x4 acc[16];
#pragma unroll
    for (int n = 0; n < 16; ++n) acc[n] = (f32x4){0.f, 0.f, 0.f, 0.f};
    for (int li = 0; li < 4; ++li) { const int lidx = 4 * F.wave + li;
#pragma unroll
        for (int ds = 0; ds < 4; ++ds) { const int d = 32 * ds + 8 * kq;
            const v4u xa = *(const GAS v4u*)(xrow + (size_t)lidx * NPAD + d);
            const f32x4 p0 = *(const GAS f32x4*)(pe + lidx * 128 + d), p1 = *(const GAS f32x4*)(pe + lidx * 128 + d + 4);
            v4u aw; aw.x = pk2(bflo(xa.x) + p0[0], bfhi(xa.x) + p0[1]); aw.y = pk2(bflo(xa.y) + p0[2], bfhi(xa.y) + p0[3]);
            aw.z = pk2(bflo(xa.z) + p1[0], bfhi(xa.z) + p1[1]); aw.w = pk2(bflo(xa.w) + p1[2], bfhi(xa.w) + p1[3]);
            const bf16x8 a = as_bf16x8(aw); const int kbase = lidx * 128 + d;
#pragma unroll
            for (int n = 0; n < 16; ++n) { const bf16x8 bb = *(const GAS bf16x8*)(W1T + (size_t)(16 * n + arow) * 4096 + kbase); acc[n] = mfma16(a, bb, acc[n]); }
        } }
    if (F.wave >= 4) {
#pragma unroll
        for (int n = 0; n < 16; ++n)
#pragma unroll
            for (int rg = 0; rg < 4; ++rg) slots[((F.wave - 4) * 16 + 4 * kq + rg) * 256 + 16 * n + arow] = acc[n][rg]; }
    __syncthreads();
    if (F.wave < 4) {
#pragma unroll
        for (int n = 0; n < 16; ++n)
#pragma unroll
            for (int rg = 0; rg < 4; ++rg) slots[(F.wave * 16 + 4 * kq + rg) * 256 + 16 * n + arow] += acc[n][rg]; }
    __syncthreads();
#pragma unroll
    for (int e = 0; e < 8; ++e) { const int idx = F.tid * 8 + e; const float s = (slots[idx] + slots[4096 + idx]) + (slots[8192 + idx] + slots[12288 + idx]);
        hbf[(idx >> 8) * 264 + (idx & 255)] = (bf16)f2bf(silu(s)); }
    __syncthreads();
    {
        const bf16* W2T = ws_bf(F, WS_W2T) + (size_t)(l * 2 + kv) * 128 * 256;
        f32x4 a2 = {0.f, 0.f, 0.f, 0.f};
#pragma unroll
        for (int ks = 0; ks < 8; ++ks) { const bf16x8 a = *(const LAS bf16x8*)(hbf + arow * 264 + 32 * ks + 8 * kq);
            const bf16x8 bb = *(const GAS bf16x8*)(W2T + (size_t)(16 * F.wave + arow) * 256 + 32 * ks + 8 * kq); a2 = mfma16(a, bb, a2); }
        bf16* CMP = ws_bf(F, kv ? WS_VCMP : WS_KCMP);
#pragma unroll
        for (int rg = 0; rg < 4; ++rg) { const int rho2 = rt * 16 + 4 * kq + rg;
            if (rho2 < 1016) { const int b2 = rho2 / 254, rem2 = rho2 - b2 * 254, j2 = rem2 >> 1, g2 = rem2 & 1;
                CMP[((size_t)(b2 * 2 + g2) * 128 + j2) * 128 + 16 * F.wave + arow] = (bf16)f2bf(a2[rg]); } }
    }
    __syncthreads();
}

#define KSWZ(row, colB) ((row) * 256 + ((colB) ^ (((row) & 7) << 4)))
__device__ __forceinline__ int v_st(int k, int c) { const int kk = (k & ~0xC) | ((k & 4) << 1) | ((k & 8) >> 1); return ((kk >> 3) * 4 + (c >> 5)) * 512 + ((kk & 7) * 32 + (c & 31)) * 2; }
__device__ __forceinline__ int v_rd_base(int lane) { return ((lane & 3) << 3) | (((lane >> 2) & 3) << 6) | (((lane >> 4) & 1) << 5) | (((lane >> 5) & 1) << 8); }
constexpr int v_rd_off(int d0, int ks, int half) { return d0 * 512 + ks * 4096 + half * 2048; }
template <int OFF> __device__ __forceinline__ s16x4 tr_read(int vb) {
    s16x4 r; asm volatile("ds_read_b64_tr_b16 %0, %1 offset:%2" : "=&v"(r) : "v"(vb), "i"(OFF) : "memory"); return r;
}
template <int D0> __device__ __forceinline__ void pv_one(f32x16& od, int vb, bf16x8 pa0, bf16x8 pa1, bf16x8 pa2, bf16x8 pa3) {
    const s16x4 l0 = tr_read<v_rd_off(D0, 0, 0)>(vb), h0 = tr_read<v_rd_off(D0, 0, 1)>(vb), l1 = tr_read<v_rd_off(D0, 1, 0)>(vb), h1 = tr_read<v_rd_off(D0, 1, 1)>(vb);
    const s16x4 l2 = tr_read<v_rd_off(D0, 2, 0)>(vb), h2 = tr_read<v_rd_off(D0, 2, 1)>(vb), l3 = tr_read<v_rd_off(D0, 3, 0)>(vb), h3 = tr_read<v_rd_off(D0, 3, 1)>(vb);
    asm volatile("s_waitcnt lgkmcnt(0)" ::: "memory"); SBAR();
#define PK(L, H) (bf16x8){L[0], L[1], L[2], L[3], H[0], H[1], H[2], H[3]}
    od = mfma32(pa0, PK(l0, h0), od);
    od = mfma32(pa1, PK(l1, h1), od);
    od = mfma32(pa2, PK(l2, h2), od);
    od = mfma32(pa3, PK(l3, h3), od);
#undef PK
}
__device__ __forceinline__ void pv_d0(f32x16* o, int vb, bf16x8 pa0, bf16x8 pa1, bf16x8 pa2, bf16x8 pa3) {
    pv_one<0>(o[0], vb, pa0, pa1, pa2, pa3); pv_one<1>(o[1], vb, pa0, pa1, pa2, pa3); pv_one<2>(o[2], vb, pa0, pa1, pa2, pa3); pv_one<3>(o[3], vb, pa0, pa1, pa2, pa3);
}
__device__ __forceinline__ void qkt(f32x16& p0, f32x16& p1, const LAS char* Ks, const bf16x8* qr, int r32, int hi) {
    p0 = f32x16{}; p1 = f32x16{};
#pragma unroll
    for (int d0 = 0; d0 < 8; ++d0) { const int cb = (d0 * 16 + hi * 8) * 2;
        const bf16x8 b0 = *(const LAS bf16x8*)(Ks + KSWZ(r32, cb));
        const bf16x8 b1 = *(const LAS bf16x8*)(Ks + KSWZ(32 + r32, cb));
        p0 = mfma32(b0, qr[d0], p0);
        p1 = mfma32(b1, qr[d0], p1); }
}
__device__ __forceinline__ void p_to_frag(const f32x16& p0, const f32x16& p1, bf16x8& pa0, bf16x8& pa1, bf16x8& pa2, bf16x8& pa3) {
#define PK4(P, BASE, OUT) do { unsigned a0 = cvtpk(P[BASE + 0], P[BASE + 1]), a1 = cvtpk(P[BASE + 2], P[BASE + 3]);   \
    unsigned b0 = cvtpk(P[BASE + 4], P[BASE + 5]), b1 = cvtpk(P[BASE + 6], P[BASE + 7]);                              \
    auto r0 = __builtin_amdgcn_permlane32_swap(a0, b0, false, false); auto r1 = __builtin_amdgcn_permlane32_swap(a1, b1, false, false); \
    v4u w = {r0[0], r1[0], r0[1], r1[1]}; OUT = as_bf16x8(w); } while (0)
    PK4(p0, 0, pa0); PK4(p0, 8, pa1); PK4(p1, 0, pa2); PK4(p1, 8, pa3);
#undef PK4
}
__device__ __forceinline__ float half_swap_max(float v) { auto rr = __builtin_amdgcn_permlane32_swap(__float_as_uint(v), __float_as_uint(v), false, false); return fmaxf(__uint_as_float(rr[0]), __uint_as_float(rr[1])); }
__device__ __forceinline__ float half_swap_sum(float v) { auto rr = __builtin_amdgcn_permlane32_swap(__float_as_uint(v), __float_as_uint(v), false, false); return __uint_as_float(rr[0]) + __uint_as_float(rr[1]); }

struct KVRegs { v4u k0, k1, v0, v1; };
__device__ __forceinline__ void kv_load(KVRegs& R, const bf16* Kg, const bf16* Vg, size_t ld, int sr, int sc) {
    R.k0 = *(const GAS v4u*)(Kg + (size_t)sr * ld + sc); R.k1 = *(const GAS v4u*)(Kg + (size_t)(32 + sr) * ld + sc);
    R.v0 = *(const GAS v4u*)(Vg + (size_t)sr * ld + sc); R.v1 = *(const GAS v4u*)(Vg + (size_t)(32 + sr) * ld + sc);
}
__device__ __forceinline__ void kv_write(const KVRegs& R, LAS char* Kl, LAS char* Vl, int sr, int sc) {
    *(LAS v4u*)(Kl + KSWZ(sr, sc * 2)) = R.k0; *(LAS v4u*)(Kl + KSWZ(32 + sr, sc * 2)) = R.k1;
    *(LAS v4u*)(Vl + v_st(sr, sc)) = R.v0; *(LAS v4u*)(Vl + v_st(32 + sr, sc)) = R.v1;
}
constexpr int koff(int r) { return (r & 3) + 8 * (r >> 2); }
template <int MODE>
__device__ __forceinline__ void sm_tile(f32x16& p0, f32x16& p1, int dist0, bool rowsel, float C1, float C2, float& m, float& l, float& alpha) {
    float pmax = -1e30f;
#pragma unroll
    for (int r = 0; r < 16; ++r) { const int d = dist0 - koff(r); const bool ok = (MODE == 0) ? (rowsel && d >= 0) : (d >= 0 && d < WINDOW);
        const float lg = ok ? fmaf(p0[r], C1, -C2 * (float)d) : -1e30f; p0[r] = lg; pmax = fmaxf(pmax, lg); }
#pragma unroll
    for (int r = 0; r < 16; ++r) { const int d = dist0 - 32 - koff(r); const bool ok = (MODE == 0) ? (rowsel && d >= 0) : (d >= 0 && d < WINDOW);
        const float lg = ok ? fmaf(p1[r], C1, -C2 * (float)d) : -1e30f; p1[r] = lg; pmax = fmaxf(pmax, lg); }
    pmax = half_swap_max(pmax);
    const float mn = fmaxf(m, pmax);
    alpha = __builtin_amdgcn_exp2f(m - mn);
    const float mref = (mn < -1e29f) ? 0.f : mn;
    float ps = 0.f;
#pragma unroll
    for (int r = 0; r < 16; ++r) { p0[r] = __builtin_amdgcn_exp2f(p0[r] - mref); ps += p0[r]; }
#pragma unroll
    for (int r = 0; r < 16; ++r) { p1[r] = __builtin_amdgcn_exp2f(p1[r] - mref); ps += p1[r]; }
    ps = half_swap_sum(ps);
    l = l * alpha + ps; m = mn;
}
__device__ __forceinline__ void o_rescale(f32x16* o, float a, LAS float* al_l, int r32, int hi) {
    if (__any(a < 1.0f)) { if (hi == 0) al_l[r32] = a; LDS_WAIT();
#pragma unroll
        for (int r = 0; r < 16; ++r) { const float s = al_l[crow(r, hi)];
#pragma unroll
            for (int d = 0; d < 4; ++d) o[d][r] *= s; }
        LDS_WAIT(); }
}
__device__ __forceinline__ void row_bcast16(float v, float* out16, LAS float* li_l, int r32, int hi) {
    if (hi == 0) li_l[r32] = v; LDS_WAIT();
#pragma unroll
    for (int r = 0; r < 16; ++r) out16[r] = li_l[crow(r, hi)];
    LDS_WAIT();
}

__device__ __forceinline__ void nsa_cmp_item(Frame& F, int l, int item) {
    const int qb = item & 31, g = (item >> 5) & 1, b = item >> 6, q0 = 64 * qb;
    const int ntile = (4 * qb + 3) > 64 ? 2 : 1;
    LAS char* Kl = (LAS char*)F.lds; LAS char* Vl = Kl + 32768;
    LAS float* wsf = (LAS float*)(F.lds + 65536) + F.wave * 64;
    LAS float* impP = (LAS float*)(F.lds + 67584);
    const bf16* P = ws_bf(F, WS_P);
    const int r32 = F.lane & 31, hi = F.lane >> 5;
    {   const int sr = F.tid >> 4, sc = (F.tid & 15) * 8;
        const bf16* KC = ws_bf(F, WS_KCMP) + (size_t)(b * 2 + g) * 128 * 128; const bf16* VC = ws_bf(F, WS_VCMP) + (size_t)(b * 2 + g) * 128 * 128;
        for (int tl = 0; tl < ntile; ++tl) { KVRegs R; kv_load(R, KC + tl * 64 * 128, VC + tl * 64 * 128, 128, sr, sc); kv_write(R, Kl + tl * 16384, Vl + tl * 16384, sr, sc); } }
    __syncthreads();
    const int hg = g * 8 + F.wave;
    const float slope = exp2f(-0.5f * (float)(hg + 1));
    const int vb0 = (int)(uintptr_t)Vl + v_rd_base(F.lane);
    float* OACC = ws_f(F, WS_OACC);
    for (int qh = 0; qh < 2; ++qh) {
        const int t = q0 + 32 * qh + r32; const size_t row = (size_t)b * SEQ + t;
        bf16x8 qr[8];
#pragma unroll
        for (int d0 = 0; d0 < 8; ++d0) qr[d0] = *(const GAS bf16x8*)(P + row * NPAD + PC_Q + hg * 128 + 16 * d0 + 8 * hi);
        f32x16 p0, p1, p2, p3;
        qkt(p0, p1, Kl, qr, r32, hi);
        if (ntile == 2) qkt(p2, p3, Kl + 16384, qr, r32, hi); else { p2 = f32x16{}; p3 = f32x16{}; }
        const int base0 = t - 31 - 64 * hi; float mx = -1e30f;
#define LG(Pv, SH) _Pragma("unroll") for (int r = 0; r < 16; ++r) { const int d = base0 - (SH) - 16 * koff(r); const float lg = (d >= 0) ? (Pv[r] * SM_SCALE - slope * (float)d) : -1e30f; Pv[r] = lg; mx = fmaxf(mx, lg); }
        LG(p0, 0) LG(p1, 512) LG(p2, 1024) LG(p3, 1536)
#undef LG
        mx = half_swap_max(mx);
        const float mref = (mx < -1e29f) ? 0.f : mx; float sum = 0.f;
#define EX(Pv) _Pragma("unroll") for (int r = 0; r < 16; ++r) { Pv[r] = __expf(Pv[r] - mref); sum += Pv[r]; }
        EX(p0) EX(p1) EX(p2) EX(p3)
#undef EX
        sum = half_swap_sum(sum);
        const float inv = sum > 0.f ? 1.0f / sum : 0.f;
#define SC(Pv, S) _Pragma("unroll") for (int r = 0; r < 16; ++r) Pv[r] *= (S);
        SC(p0, inv) SC(p1, inv) SC(p2, inv) SC(p3, inv)
        {   float cg[16], sp[16];
#define GRP(Pv, GB) _Pragma("unroll") for (int i = 0; i < 4; ++i) { sp[(GB) + i] = 0.5f * Pv[4 * i + 3]; cg[(GB) + i] = (Pv[4 * i] + Pv[4 * i + 1]) + (Pv[4 * i + 2] + sp[(GB) + i]); }
            GRP(p0, 0) GRP(p1, 4) GRP(p2, 8) GRP(p3, 12)
#undef GRP
            float oth[16];
#pragma unroll
            for (int G = 0; G < 16; ++G) oth[G] = __shfl_xor(sp[G], 32);
#pragma unroll
            for (int G = 0; G < 16; ++G) { float v = cg[G]; if (hi) v += oth[G]; else if (G > 0) v += oth[G - 1];
                impP[(F.wave * 64 + 32 * qh + r32) * 32 + 2 * G + hi] = v; }
        }
        const float g0 = sigm(bf2f(P[row * NPAD + PC_GL + hg * 3 + 0]));
        SC(p0, g0) SC(p1, g0) SC(p2, g0) SC(p3, g0)
#undef SC
        f32x16 o[4] = {};
        { bf16x8 pa0, pa1, pa2, pa3; p_to_frag(p0, p1, pa0, pa1, pa2, pa3); pv_d0(o, vb0, pa0, pa1, pa2, pa3); }
        if (ntile == 2) { bf16x8 pa0, pa1, pa2, pa3; p_to_frag(p2, p3, pa0, pa1, pa2, pa3); pv_d0(o, vb0 + 16384, pa0, pa1, pa2, pa3); }
#pragma unroll
        for (int r = 0; r < 16; ++r) { const size_t orow = (size_t)b * SEQ + q0 + 32 * qh + crow(r, hi);
#pragma unroll
            for (int d0 = 0; d0 < 4; ++d0) OACC[orow * D_NSA + hg * 128 + 32 * d0 + r32] = o[d0][r]; }
    }
    __syncthreads();
    LAS float* impS = (LAS float*)F.lds;
    const int q = F.tid >> 3, sub = F.tid & 7;
#pragma unroll
    for (int e = 0; e < 4; ++e) { const int n = 4 * sub + e; float s = 0.f;
#pragma unroll
        for (int w = 0; w < 8; ++w) s += impP[(w * 64 + q) * 32 + n];
        if (n > qb) s = -1e30f; else if (n == 0 || n == qb || n == qb - 1) s = 1e9f;
        impS[q * 33 + n] = s; }
    __syncthreads();
    {   float mine[4]; int rank[4];
#pragma unroll
        for (int e = 0; e < 4; ++e) { mine[e] = impS[q * 33 + 4 * sub + e]; rank[e] = 0; }
        for (int mI = 0; mI < 32; ++mI) { const float sm = impS[q * 33 + mI];
#pragma unroll
            for (int e = 0; e < 4; ++e) rank[e] += (sm > mine[e] || (sm == mine[e] && mI < 4 * sub + e)) ? 1 : 0; }
        unsigned bits = 0u;
#pragma unroll
        for (int e = 0; e < 4; ++e) if (rank[e] < TOPN && (4 * sub + e) <= qb) bits |= 1u << (4 * sub + e);
        bits |= __shfl_xor(bits, 1); bits |= __shfl_xor(bits, 2); bits |= __shfl_xor(bits, 4);
        if (sub == 0) ((unsigned*)(F.ws + WS_SEL))[(size_t)(b * 2 + g) * SEQ + q0 + q] = bits;
    }
    __syncthreads();
}

template <int MODE>
__device__ __forceinline__ void attn_branch(Frame& F, f32x16* o, float& lsum, const bf16x8* qr, const bf16* Kg, const bf16* Vg, unsigned tiles, unsigned mymask,
                                            int t, float C1, float C2, LAS char* Kl, LAS char* Vl, LAS float* wsf, int vb0) {
    const int r32 = F.lane & 31, hi = F.lane >> 5, sr = F.tid >> 4, sc = (F.tid & 15) * 8;
    float m = -1e30f; lsum = 0.f;
    unsigned rem = tiles;
    KVRegs R;
    { const int n = __builtin_ctz(rem); kv_load(R, Kg + (size_t)(64 * n) * NPAD, Vg + (size_t)(64 * n) * NPAD, NPAD, sr, sc); }
    while (rem) {
        const int n = __builtin_ctz(rem); rem &= rem - 1u;
        __syncthreads();
        kv_write(R, Kl, Vl, sr, sc);
        __syncthreads();
        if (rem) { const int n2 = __builtin_ctz(rem); kv_load(R, Kg + (size_t)(64 * n2) * NPAD, Vg + (size_t)(64 * n2) * NPAD, NPAD, sr, sc); }
        f32x16 p0, p1; qkt(p0, p1, Kl, qr, r32, hi);
        float alpha;
        int dist0 = t - 64 * n - 4 * hi; asm volatile("" : "+v"(dist0));
        sm_tile<MODE>(p0, p1, dist0, ((mymask >> n) & 1u) != 0u, C1, C2, m, lsum, alpha);
        o_rescale(o, alpha, wsf, r32, hi);
        bf16x8 pa0, pa1, pa2, pa3; p_to_frag(p0, p1, pa0, pa1, pa2, pa3);
        pv_d0(o, vb0, pa0, pa1, pa2, pa3);
    }
}
__device__ __forceinline__ void nsa_attn_item(Frame& F, int l, int item) {
    const int qb = 31 - (item >> 4), rest = item & 15, b = rest >> 2, g = (rest >> 1) & 1, hh = rest & 1, q0 = 64 * qb;
    const int r32 = F.lane & 31, hi = F.lane >> 5;
    const int hg = 8 * g + 4 * hh + (F.wave >> 1), qh = F.wave & 1, t = q0 + 32 * qh + r32;
    const size_t row = (size_t)b * SEQ + t;
    const float slope = exp2f(-0.5f * (float)(hg + 1)), C1 = SM_SCALE * LOG2E, C2 = slope * LOG2E;
    LAS char* Kl = (LAS char*)F.lds; LAS char* Vl = Kl + 16384; LAS float* wsf = (LAS float*)(F.lds + 32768) + F.wave * 64;
    const int vb0 = (int)(uintptr_t)Vl + v_rd_base(F.lane);
    const bf16* P = ws_bf(F, WS_P);
    bf16x8 qr[8];
#pragma unroll
    for (int d0 = 0; d0 < 8; ++d0) qr[d0] = *(const GAS bf16x8*)(P + row * NPAD + PC_Q + hg * 128 + 16 * d0 + 8 * hi);
    const unsigned* SEL = (const unsigned*)(F.ws + WS_SEL) + (size_t)(b * 2 + g) * SEQ;
    const unsigned mymask = SEL[t];
    unsigned uni = SEL[q0 + F.lane];
#pragma unroll
    for (int o_ = 1; o_ < 64; o_ <<= 1) uni |= __shfl_xor(uni, o_);
    uni = __builtin_amdgcn_readfirstlane(uni);
    const unsigned upto = (qb == 31) ? 0xffffffffu : ((2u << qb) - 1u);
    const float* OACC = ws_f(F, WS_OACC);
    LAS unsigned* stash = (LAS unsigned*)(F.lds + 36864) + F.tid;
    float lsum, rs[16];
    {
        f32x16 o[4] = {};
        attn_branch<0>(F, o, lsum, qr, P + (size_t)b * SEQ * NPAD + PC_KVS + g * 128, P + (size_t)b * SEQ * NPAD + PC_KVS + 256 + g * 128, uni & upto, mymask, t, C1, C2, Kl, Vl, wsf, vb0);
        const float g1 = sigm(bf2f(P[row * NPAD + PC_GL + hg * 3 + 1]));
        row_bcast16(g1 / lsum, rs, wsf + 32, r32, hi);
#pragma unroll
        for (int d0 = 0; d0 < 4; ++d0)
#pragma unroll
            for (int r = 0; r < 16; r += 2) stash[(d0 * 8 + (r >> 1)) * 512] = cvtpk(o[d0][r] * rs[r], o[d0][r + 1] * rs[r + 1]);
    }
    {
        f32x16 o[4] = {};
        const int nlo = qb > 8 ? qb - 8 : 0;
        const unsigned wt = upto & ~((1u << nlo) - 1u);
        attn_branch<1>(F, o, lsum, qr, P + (size_t)b * SEQ * NPAD + PC_KVW + g * 128, P + (size_t)b * SEQ * NPAD + PC_KVW + 256 + g * 128, wt, 0xffffffffu, t, C1, C2, Kl, Vl, wsf, vb0);
        const float g2 = sigm(bf2f(P[row * NPAD + PC_GL + hg * 3 + 2]));
        row_bcast16(g2 / lsum, rs, wsf + 32, r32, hi);
        const size_t rb = (size_t)b * SEQ + q0 + 32 * qh + 4 * hi;
        const float* oa = OACC + rb * D_NSA + hg * 128 + r32;
        const bf16* gp = P + rb * NPAD + PC_NSAG + hg * 128 + r32;
        bf16* yp = ws_bf(F, WS_YCAT) + rb * DM + 1024 + hg * 128 + r32;
#pragma unroll
        for (int r = 0; r < 16; ++r) {
#pragma unroll
            for (int d0 = 0; d0 < 4; ++d0) { const unsigned sw = stash[(d0 * 8 + (r >> 1)) * 512];
                const float sel = (r & 1) ? bfhi(sw) : bflo(sw);
                const float v = oa[(size_t)koff(r) * D_NSA + 32 * d0] + sel + o[d0][r] * rs[r];
                const float gt = silu(bf2f(gp[(size_t)koff(r) * NPAD + 32 * d0]));
                yp[(size_t)koff(r) * DM + 32 * d0] = (bf16)f2bf(v * gt); }
            asm volatile("" ::: "memory");
        }
    }
    __syncthreads();
}

#ifndef PROBE_DUP
#define PROBE_DUP -1
#endif
#ifndef MK_SPLIT
#define MK_SPLIT 0
#endif
constexpr int N_PHASES = 2 + 6 * DEPTH;
struct Args { const float* in[23]; float* out; unsigned char* ws; int ph_lo, ph_hi; };
__global__ void __launch_bounds__(NWAVES * 64, 2) hymba_fwd(Args args) {
    extern __shared__ __attribute__((aligned(16))) unsigned char lds[];
    Frame F;
    F.lds = (LAS unsigned char*)lds;
    F.MISC = (volatile LAS unsigned*)(F.lds + MISC_OFF);
    F.tid = threadIdx.x; F.lane = F.tid & 63; F.wave = __builtin_amdgcn_readfirstlane(F.tid >> 6);
    F.G = gridDim.x; { const int bx = blockIdx.x; F.vcu = (F.G % 8 == 0) ? (bx % 8) * (F.G / 8) + bx / 8 : bx; }
    F.ws = args.ws; F.out = args.out; F.ctl = (gu32*)(args.ws + WS_CTL);
    F.in = args.in;
    for (int u = F.tid; u < (LDS_BYTES - LDSCTL_OFF) / 4; u += NWAVES * 64) ((LAS unsigned*)(F.lds + LDSCTL_OFF))[u] = 0u;
    __syncthreads();
#if MK_SPLIT
#define GRID_BAR() do { } while (0)
#else
    XcdBarrier bar = xcd_barrier_post((unsigned*)(F.ctl + CW_BAR), F.MISC + 8);
#define GRID_BAR() xcd_barrier(bar)
#endif
#if MK_SPLIT
    const int lo = args.ph_lo, hi_ = args.ph_hi;
#define IN(k) (lo <= (k) && (k) < hi_)
#define BOTH(k) (IN(k) && IN((k) + 1))
#else
#define IN(k) true
#define BOTH(k) ((k) + 1 < N_PHASES)
#endif

    if (IN(0)) { launder(F); p0_prologue(F);
#if PROBE_DUP == 0
            launder(F); __syncthreads(); p0_prologue(F);
#endif
        if (BOTH(0)) GRID_BAR(); }
    if (IN(1)) { launder(F); p1_u0(F); if (BOTH(1)) GRID_BAR(); }
    for (int l = 0; l < DEPTH; ++l) {
        const int pb = 2 + 6 * l;
        if (IN(pb + 0)) { launder(F);
            pg8::Gemm g{ws_bf(F, WS_U), ws_bf(F, WS_WIN) + (size_t)l * NPAD * DM, MROWS, NPAD, DM}; pg8::StaticOrder S; S.init(MROWS, NPAD, F.G, (int)blockIdx.x);
            pg8::EpiBf16 E{ws_bf(F, WS_P), NPAD};
            pg8::gemm_phase<pg8::EpiBf16, pg8::StaticOrder, true, true>(F.lds, g, S, E);
#if PROBE_DUP == 1
            launder(F); __syncthreads(); pg8::gemm_phase<pg8::EpiBf16, pg8::StaticOrder, true, true>(F.lds, g, S, E);
#endif
            if (BOTH(pb + 0)) GRID_BAR();
        }
        if (IN(pb + 1)) { launder(F);
            for (int it = F.vcu; it < 128; it += F.G) cmp_item(F, l, it);
            launder(F);
            for (int it = F.vcu; it < 1024; it += F.G) hg1_item(F, l, it);
            launder(F);
            for (int it = F.vcu; it < 1024; it += F.G) rg_item<1>(F, l, it);
#if PROBE_DUP == 2
            launder(F); for (int it = F.vcu; it < 128; it += F.G) cmp_item(F, l, it); launder(F); for (int it = F.vcu; it < 1024; it += F.G) hg1_item(F, l, it); launder(F); for (int it = F.vcu; it < 1024; it += F.G) rg_item<1>(F, l, it);
#endif
            if (BOTH(pb + 1)) GRID_BAR();
        }
        if (IN(pb + 2)) { launder(F);
            for (int it = F.vcu; it < 256; it += F.G) nsa_cmp_item(F, l, it);
#if PROBE_DUP == 3
            launder(F); for (int it = F.vcu; it < 256; it += F.G) nsa_cmp_item(F, l, it);
#endif
            launder(F);
            hg_pass2(F);
            launder(F);
            rg_pass2(F);
            if (BOTH(pb + 2)) GRID_BAR();
        }
        if (IN(pb + 3)) { launder(F);
            for (;;) { const int it = q_next(F, l * 4 + 0); if (it >= 512) break; nsa_attn_item(F, l, it); }
#if PROBE_DUP == 4
            launder(F); for (;;) { const int it = q_next(F, 8 + l * 4 + 0); if (it >= 512) break; nsa_attn_item(F, l, it); }
#endif
            launder(F);
            for (;;) { const int it = q_next(F, l * 4 + 1); if (it >= 1024) break; hg3_item(F, l, it); }
            launder(F);
            for (;;) { const int it = q_next(F, l * 4 + 2); if (it >= 1024) break; rg_item<3>(F, l, it); }
#if PROBE_DUP == 5
            launder(F); for (;;) { const int it = q_next(F, 8 + l * 4 + 1); if (it >= 1024) break; hg3_item(F, l, it); } launder(F); for (;;) { const int it = q_next(F, 8 + l * 4 + 2); if (it >= 1024) break; rg_item<3>(F, l, it); }
#endif
            if (BOTH(pb + 3)) GRID_BAR();
        }
        if (IN(pb + 4)) { launder(F);
            pg8::Gemm g{ws_bf(F, WS_YCAT), ws_bf(F, WS_WOUT) + (size_t)l * DM * DM, MROWS, DM, DM}; pg8::StaticOrder S; S.init(MROWS, DM, F.G, (int)blockIdx.x);
            pg8::EpiResid E{l == 0 ? F.in[0] : ws_f(F, WS_XRES), ws_f(F, WS_V), ws_f(F, WS_MOD) + (size_t)l * 4 * 12288 + 2 * DM, 12288, SEQ, DM, ALPHA};
            pg8::gemm_phase<pg8::EpiResid, pg8::StaticOrder, true, true>(F.lds, g, S, E);
#if PROBE_DUP == 6
            launder(F); __syncthreads(); pg8::gemm_phase<pg8::EpiResid, pg8::StaticOrder, true, true>(F.lds, g, S, E);
#endif
            if (BOTH(pb + 4)) GRID_BAR();
        }
        if (IN(pb + 5)) { launder(F);
            ln_phase(F, l, (l == DEPTH - 1) ? F.out : ws_f(F, WS_XRES), l != DEPTH - 1);
#if PROBE_DUP == 7
            launder(F); ln_phase(F, l, (l == DEPTH - 1) ? F.out : ws_f(F, WS_XRES), l != DEPTH - 1);
#endif
            if (BOTH(pb + 5)) GRID_BAR();
        }
    }
#undef IN
#undef BOTH
}

extern "C" void kernel_launch(void* const* d_in, const int* in_sizes, int n_in, void* d_out, int out_size, void* d_ws, size_t ws_size, hipStream_t stream) {
    static int grid = 0;
    if (grid == 0) {
        if (n_in != 23 || in_sizes[0] != MROWS * DM || out_size != MROWS * DM || ws_size < WS_END) {
            fprintf(stderr, "kernel_launch: shape/workspace mismatch: n_in %d in0 %d out %d ws %zu (need %zu)\n", n_in, n_in > 0 ? in_sizes[0] : -1, out_size, ws_size, (size_t)WS_END); grid = -1; return; }
        int dev = 0, cus = 0, per_cu = 0;
        if (hipGetDevice(&dev) != hipSuccess || hipDeviceGetAttribute(&cus, hipDeviceAttributeMultiprocessorCount, dev) != hipSuccess) { fprintf(stderr, "kernel_launch: device query failed\n"); grid = -1; return; }
        if (hipFuncSetAttribute((const void*)hymba_fwd, hipFuncAttributeMaxDynamicSharedMemorySize, LDS_BYTES) != hipSuccess) { fprintf(stderr, "kernel_launch: hipFuncSetAttribute failed\n"); grid = -1; return; }
        if (hipOccupancyMaxActiveBlocksPerMultiprocessor(&per_cu, (const void*)hymba_fwd, NWAVES * 64, LDS_BYTES) != hipSuccess || per_cu < 1)
            fprintf(stderr, "kernel_launch: note: occupancy query reports %d workgroups per CU\n", per_cu);
        (void)hipGetLastError();
        grid = cus;
    }
    if (grid < 0) return;
    if (hipMemsetAsync((char*)d_ws + WS_CTL, 0, CTL_ZERO_BYTES, stream) != hipSuccess) { fprintf(stderr, "kernel_launch: memset failed\n"); return; }
    Args a{};
    for (int i = 0; i < 23; ++i) a.in[i] = (const float*)d_in[i];
    a.out = (float*)d_out; a.ws = (unsigned char*)d_ws;
#if MK_SPLIT
    for (int ph = 0; ph < N_PHASES; ++ph) { a.ph_lo = ph; a.ph_hi = ph + 1;
        hipLaunchKernelGGL(hymba_fwd, dim3(grid), dim3(NWAVES * 64), LDS_BYTES, stream, a); }
#else
    a.ph_lo = 0; a.ph_hi = N_PHASES;
    hipLaunchKernelGGL(hymba_fwd, dim3(grid), dim3(NWAVES * 64), LDS_BYTES, stream, a);
#endif
    const hipError_t le = hipPeekAtLastError();
    if (le != hipSuccess) fprintf(stderr, "kernel_launch: launch failed: %s\n", hipGetErrorName(le));
}
```

```cpp
#include <hip/hip_runtime.h>
#include <cstdio>
#include <cstdint>
#define MK_SPLIT 0
#define PROBE_DUP -1
namespace pg8 {
#define PG8_LAS __attribute__((address_space(3)))
typedef unsigned short bf16_t;
typedef short bf16x8 __attribute__((ext_vector_type(8)));
typedef float f32x4 __attribute__((ext_vector_type(4)));
typedef unsigned u32x4 __attribute__((ext_vector_type(4)));
constexpr int BM = 256, BK = 64, HALF = 128, HTB = HALF * BK * 2  , STAGE_BYTES = 8 * HTB, NXCD = 8, WGM = 8;

__host__ __device__ __forceinline__ int lds_byte(int r, int c) { const int st = (r >> 4) * 2 + (c >> 5), rr = r & 15, cc = c & 31, ob = rr * 64 + cc * 2; return st * 1024 + (ob ^ (((ob >> 9) & 1) << 5)); }
__host__ __device__ __forceinline__ void stage_rc(int b, int& R, int& C) { const int st = b / 1024, sb = b % 1024, swz = sb ^ (((sb >> 9) & 1) << 5); R = (st >> 1) * 16 + swz / 64; C = (st & 1) * 32 + (swz % 64) / 2; }
__host__ __device__ __forceinline__ int perm32(int rho) { const int n = rho >> 4, i = rho & 15; return 8 * (i >> 2) + 4 * n + (i & 3); }

struct Unit { int pm, pn; };
struct Gemm { const bf16_t* A; const bf16_t* Bt; int M, N, K; };

struct StaticOrder {
    int nM, nN, nwg, G, c;
    __host__ __device__ void init(int M, int N, int G_, int c_) { nM = M / BM; nN = N / BM; nwg = nM * nN; G = G_; c = c_; }
    __host__ __device__ bool next(int i, Unit& u) const {
        const long L = (long)i * G + c; if (L >= nwg) return false;
        int wgid = (int)L; { const int q = nwg / NXCD, r = nwg % NXCD, xcd = wgid % NXCD, off = wgid / NXCD; wgid = (xcd < r ? xcd * (q + 1) : r * (q + 1) + (xcd - r) * q) + off; }
        const int nig = WGM * nN, gid = wgid / nig, fm = gid * WGM, gsz = (nM - fm) < WGM ? (nM - fm) : WGM;
        u.pm = fm + ((wgid % nig) % gsz); u.pn = (wgid % nig) / gsz; return true;
    }
    __device__ __forceinline__ void a_ready(const Unit&) const {}
    __device__ __forceinline__ void done(const Unit&) const {}
};

__device__ __forceinline__ unsigned cvt_pk_bf16(float lo, float hi) { unsigned r; asm volatile("v_cvt_pk_bf16_f32 %0, %1, %2" : "=v"(r) : "v"(lo), "v"(hi)); return r; }
typedef float f32x2 __attribute__((ext_vector_type(2)));

struct EpiBf16 {
    static constexpr bool PERM = true, AFTER_DRAIN = false;
    bf16_t* O; int ldc;
    __device__ __forceinline__ void operator()(const f32x4 (&acc)[2][2][4][2], const Unit& u, int wr, int wc, int fr, int fq) const {
        const int row0 = u.pm * BM + wr * 64 + fr; const int col0 = u.pn * BM + wc * 32 + 8 * fq;
#pragma unroll
        for (int ai = 0; ai < 2; ++ai)
#pragma unroll
            for (int m = 0; m < 4; ++m) { bf16_t* rowp = O + (size_t)(row0 + ai * HALF + m * 16) * ldc + col0;
#pragma unroll
                for (int bj = 0; bj < 2; ++bj) { const f32x4 v0 = acc[ai][bj][m][0], v1 = acc[ai][bj][m][1];
                    u32x4 w; w.x = cvt_pk_bf16(v0[0], v0[1]); w.y = cvt_pk_bf16(v0[2], v0[3]); w.z = cvt_pk_bf16(v1[0], v1[1]); w.w = cvt_pk_bf16(v1[2], v1[3]);
                    *(u32x4*)(rowp + bj * HALF) = w; } }
    }
};
struct EpiResid {
    static constexpr bool PERM = false, AFTER_DRAIN = false;
    const float* xres; float* V; const float* gate; int gate_stride; int rows_per_batch; int ldc; float alpha;
    __device__ __forceinline__ void operator()(const f32x4 (&acc)[2][2][4][2], const Unit& u, int wr, int wc, int fr, int fq) const {
        const int bidx = (u.pm * BM) / rows_per_batch; const int col0 = u.pn * BM + wc * 32 + 4 * fq;
        f32x4 gv[2][2];
#pragma unroll
        for (int bj = 0; bj < 2; ++bj)
#pragma unroll
            for (int n = 0; n < 2; ++n) gv[bj][n] = *(const f32x4*)(gate + (size_t)bidx * gate_stride + col0 + bj * HALF + n * 16) + 1.0f;
#pragma unroll
        for (int ai = 0; ai < 2; ++ai)
#pragma unroll
            for (int m = 0; m < 4; ++m) { const size_t off = (size_t)(u.pm * BM + ai * HALF + wr * 64 + m * 16 + fr) * ldc + col0;
#pragma unroll
                for (int bj = 0; bj < 2; ++bj)
#pragma unroll
                    for (int n = 0; n < 2; ++n) { const f32x4 xr = *(const f32x4*)(xres + off + bj * HALF + n * 16);
                        *(f32x4*)(V + off + bj * HALF + n * 16) = xr * alpha + gv[bj][n] * acc[ai][bj][m][n]; } }
    }
};
template <class Epi, class Sched, bool ALIGN_EPI = false, bool SP2 = false>
__device__ __forceinline__ void gemm_phase(PG8_LAS unsigned char* lds, const Gemm g, const Sched& S, const Epi& E) {
    int tid_ = threadIdx.x; asm volatile("" : "+v"(tid_));
    const int tid = tid_, wid = __builtin_amdgcn_readfirstlane(tid >> 6), lane = tid & 63, wr = wid >> 2, wc = wid & 3, fr = lane & 15, fq = lane >> 4;
    const int K = g.K, nt = K / BK;
    unsigned voffA[2], voffB[2];
#pragma unroll
    for (int i = 0; i < 2; ++i) { int R, C; stage_rc(tid * 16 + i * 8192, R, C); const int Rb = Epi::PERM ? ((R & ~31) + perm32(R & 31)) : R;
        voffA[i] = (unsigned)(R * K + C) * 2u; voffB[i] = (unsigned)(Rb * K + C) * 2u; }
    const size_t kstep = (size_t)(BK * 2);
    const size_t hstep = (size_t)HALF * K * 2;
    const size_t tstep = 2 * hstep;
    const unsigned ldsw = (unsigned)wid * 1024u;
    const int aoff = lds_byte(wr * 64 + fr, fq * 8), boff = lds_byte(wc * 32 + fr, fq * 8);
#define PG8_SA(b, h) (((b) * 2 + (h)) * HTB)
#define PG8_SB(b, h) ((4 + (b) * 2 + (h)) * HTB)
#define PG8_STAGE(bufoff, gbase, voff) do { _Pragma("unroll") for (int _i = 0; _i < 2; ++_i) \
        __builtin_amdgcn_global_load_lds((const unsigned*)((const char*)(gbase) + (voff)[_i]), (PG8_LAS unsigned*)(lds + (bufoff) + ldsw + _i * 8192), 16, 0, 0); } while (0)
#define PG8_LDA(dst, b, h) do { _Pragma("unroll") for (int m = 0; m < 4; ++m) _Pragma("unroll") for (int k = 0; k < 2; ++k) dst[m][k] = *(const PG8_LAS bf16x8*)(lds + PG8_SA(b, h) + aoff + m * 2048 + k * 1024); } while (0)
#define PG8_LDB(dst, b, h) do { _Pragma("unroll") for (int n = 0; n < 2; ++n) _Pragma("unroll") for (int k = 0; k < 2; ++k) dst[n][k] = *(const PG8_LAS bf16x8*)(lds + PG8_SB(b, h) + boff + n * 2048 + k * 1024); } while (0)
#define PG8_MMA(ai, bj, At, Bt) do { __builtin_amdgcn_s_setprio(1); _Pragma("unroll") for (int m = 0; m < 4; ++m) _Pragma("unroll") for (int n = 0; n < 2; ++n) _Pragma("unroll") for (int k = 0; k < 2; ++k) \
        acc[ai][bj][m][n] = __builtin_amdgcn_mfma_f32_16x16x32_bf16(Bt[n][k], At[m][k], acc[ai][bj][m][n], 0, 0, 0); __builtin_amdgcn_s_setprio(0); } while (0)
#define PG8_WAIT_V(n) asm volatile("s_waitcnt vmcnt(" #n ")" ::: "memory")
#define PG8_WAIT_L(n) asm volatile("s_waitcnt lgkmcnt(" #n ")" ::: "memory")
#define PG8_BAR __builtin_amdgcn_s_barrier()
#define PG8_SCHED __builtin_amdgcn_sched_barrier(0)
    Unit cur, nxt; int ui = 0;
    if (!S.next(0, cur)) return;
    f32x4 acc[2][2][4][2];
#pragma unroll
    for (int a = 0; a < 2; ++a)
#pragma unroll
        for (int b = 0; b < 2; ++b)
#pragma unroll
            for (int m = 0; m < 4; ++m)
#pragma unroll
                for (int n = 0; n < 2; ++n) acc[a][b][m][n] = (f32x4){0.f, 0.f, 0.f, 0.f};
    bf16x8 At[4][2], B0[2][2], B1[2][2];
    const char* cA = (const char*)g.A + (size_t)cur.pm * tstep; const char* cB = (const char*)g.Bt + (size_t)cur.pn * tstep;
    S.a_ready(cur);
    if constexpr (SP2) {
        PG8_STAGE(PG8_SB(0, 0), cB, voffB); PG8_STAGE(PG8_SB(0, 1), cB + hstep, voffB); PG8_STAGE(PG8_SA(0, 0), cA, voffA); PG8_STAGE(PG8_SA(0, 1), cA + hstep, voffA);
        if (wr == 1) PG8_BAR;
        PG8_WAIT_V(2); PG8_BAR;
        PG8_STAGE(PG8_SB(1, 0), cB + kstep, voffB); PG8_STAGE(PG8_SA(1, 0), cA + kstep, voffA); PG8_STAGE(PG8_SB(1, 1), cB + hstep + kstep, voffB);
        PG8_WAIT_V(6); PG8_BAR;
    } else {
        PG8_STAGE(PG8_SB(0, 0), cB, voffB); PG8_STAGE(PG8_SA(0, 0), cA, voffA); PG8_STAGE(PG8_SB(0, 1), cB + hstep, voffB); PG8_STAGE(PG8_SA(0, 1), cA + hstep, voffA);
        if (wr == 1) PG8_BAR;
        PG8_WAIT_V(4); PG8_BAR;
        PG8_STAGE(PG8_SB(1, 0), cB + kstep, voffB); PG8_STAGE(PG8_SA(1, 0), cA + kstep, voffA); PG8_STAGE(PG8_SB(1, 1), cB + hstep + kstep, voffB);
        PG8_WAIT_V(6); PG8_BAR;
    }
    for (;;) {
        const bool has_next = S.next(ui + 1, nxt);
        const char* nA = has_next ? (const char*)g.A + (size_t)nxt.pm * tstep : cA; const char* nB = has_next ? (const char*)g.Bt + (size_t)nxt.pn * tstep : cB;
        for (int t = 0; t < nt; t += 2) {
            const bool last = (t == nt - 2);
            const char* a1 = cA + (size_t)(t + 1) * kstep;
            const char* a2 = last ? nA : cA + (size_t)(t + 2) * kstep; const char* b2 = last ? nB : cB + (size_t)(t + 2) * kstep;
            const char* a3 = a2 + kstep; const char* b3 = b2 + kstep;
            if (last && has_next) S.a_ready(nxt);
            if constexpr (SP2) {
            PG8_LDB(B0, 0, 0); PG8_LDB(B1, 0, 1); PG8_SCHED; PG8_LDA(At, 0, 0); PG8_STAGE(PG8_SA(1, 1), a1 + hstep, voffA);
            PG8_WAIT_V(8); PG8_WAIT_L(0); PG8_BAR; PG8_MMA(0, 0, At, B0); PG8_MMA(0, 1, At, B1); PG8_BAR; PG8_SCHED;
            PG8_LDA(At, 0, 1); PG8_STAGE(PG8_SB(0, 0), b2, voffB); PG8_STAGE(PG8_SB(0, 1), b2 + hstep, voffB); PG8_STAGE(PG8_SA(0, 0), a2, voffA);
            PG8_WAIT_V(8); PG8_WAIT_L(0); PG8_BAR; PG8_MMA(1, 0, At, B0); PG8_MMA(1, 1, At, B1); PG8_BAR; PG8_SCHED;
            PG8_LDB(B0, 1, 0); PG8_LDB(B1, 1, 1); PG8_SCHED; PG8_LDA(At, 1, 0); PG8_STAGE(PG8_SA(0, 1), a2 + hstep, voffA);
            PG8_WAIT_V(8); PG8_WAIT_L(0); PG8_BAR; PG8_MMA(0, 0, At, B0); PG8_MMA(0, 1, At, B1); PG8_BAR; PG8_SCHED;
            PG8_LDA(At, 1, 1); PG8_STAGE(PG8_SB(1, 0), b3, voffB); PG8_STAGE(PG8_SB(1, 1), b3 + hstep, voffB); PG8_STAGE(PG8_SA(1, 0), a3, voffA);
            PG8_WAIT_V(8); PG8_WAIT_L(0); PG8_BAR; PG8_MMA(1, 0, At, B0); PG8_MMA(1, 1, At, B1); PG8_BAR; PG8_SCHED;
            } else {
            PG8_LDB(B0, 0, 0); PG8_SCHED; PG8_LDA(At, 0, 0); PG8_STAGE(PG8_SA(1, 1), a1 + hstep, voffA);
            PG8_WAIT_L(8); PG8_BAR; PG8_WAIT_L(0); PG8_MMA(0, 0, At, B0); PG8_BAR; PG8_SCHED;
            PG8_LDB(B1, 0, 1); PG8_STAGE(PG8_SB(0, 0), b2, voffB);
            PG8_BAR; PG8_WAIT_L(0); PG8_MMA(0, 1, At, B1); PG8_BAR;
            PG8_LDA(At, 0, 1); PG8_STAGE(PG8_SA(0, 0), a2, voffA);
            PG8_BAR; PG8_WAIT_L(0); PG8_MMA(1, 0, At, B0); PG8_BAR; PG8_SCHED;
            PG8_STAGE(PG8_SB(0, 1), b2 + hstep, voffB);
            PG8_WAIT_V(6); PG8_BAR; PG8_MMA(1, 1, At, B1); PG8_BAR;
            PG8_LDB(B0, 1, 0); PG8_SCHED; PG8_LDA(At, 1, 0); PG8_STAGE(PG8_SA(0, 1), a2 + hstep, voffA);
            PG8_WAIT_L(8); PG8_BAR; PG8_WAIT_L(0); PG8_MMA(0, 0, At, B0); PG8_BAR; PG8_SCHED;
            PG8_LDB(B1, 1, 1); PG8_STAGE(PG8_SB(1, 0), b3, voffB);
            PG8_BAR; PG8_WAIT_L(0); PG8_MMA(0, 1, At, B1); PG8_BAR;
            PG8_LDA(At, 1, 1); PG8_STAGE(PG8_SA(1, 0), a3, voffA);
            PG8_BAR; PG8_WAIT_L(0); PG8_MMA(1, 0, At, B0); PG8_BAR; PG8_SCHED;
            PG8_STAGE(PG8_SB(1, 1), b3 + hstep, voffB);
            PG8_WAIT_V(6); PG8_BAR; PG8_MMA(1, 1, At, B1); PG8_BAR;
            }
        }
        if constexpr (ALIGN_EPI) { if (wr == 0) PG8_BAR; }
        if constexpr (!Epi::AFTER_DRAIN) { E(acc, cur, wr, wc, fr, fq); S.done(cur); }
        if (!has_next) break;
#pragma unroll
        for (int a = 0; a < 2; ++a)
#pragma unroll
            for (int b = 0; b < 2; ++b)
#pragma unroll
                for (int m = 0; m < 4; ++m)
#pragma unroll
                    for (int n = 0; n < 2; ++n) acc[a][b][m][n] = (f32x4){0.f, 0.f, 0.f, 0.f};
        cur = nxt; cA = nA; cB = nB; ++ui;
        if constexpr (ALIGN_EPI) { if (wr == 1) PG8_BAR; }
    }
    PG8_WAIT_V(0);
    if constexpr (!ALIGN_EPI) { if (wr == 0) PG8_BAR; }
    PG8_BAR;
    if constexpr (Epi::AFTER_DRAIN) { E.fused(acc, cur, wr, wc, fr, fq, lds, wid, lane); S.done(cur); }
#undef PG8_SA
#undef PG8_SB
#undef PG8_STAGE
#undef PG8_LDA
#undef PG8_LDB
#undef PG8_MMA
#undef PG8_WAIT_V
#undef PG8_WAIT_L
#undef PG8_BAR
#undef PG8_SCHED
}
}

constexpr int DM = 4096, BATCH = 4, SEQ = 2048, DEPTH = 2, MROWS = BATCH * SEQ;
constexpr int HD = 128, D_RG = 1024, D_NSA = 2048, D_HG = 1024;
constexpr int NIN = 11824, NPAD = 12032;
constexpr int NHEADS = 16, NKV = 2, NGRP = 8;
constexpr int NCMP = 127, NSEL = 32, TOPN = 16, WINDOW = 512;
constexpr int PC_RGX = 0, PC_RGG = 1024, PC_Q = 2048, PC_KVC = 4096, PC_KVS = 4608, PC_KVW = 5120, PC_NSAG = 5632,
              PC_HGQ = 7680, PC_HGF = 8704, PC_HGI = 9728, PC_HGG = 10752, PC_GL = 11776;
constexpr float LN_EPS = 1e-5f, RMS_EPS = 1e-6f, ALPHA = 1.41421356237309515f;
constexpr float SM_SCALE = 0.088388347648318440f;
constexpr float LOG2E = 1.4426950408889634f;

constexpr size_t MiB = 1u << 20;
constexpr size_t WS_CTL = 0, CTL_ZERO_BYTES = 1 * MiB;
constexpr size_t WS_WIN  = 2 * MiB;
constexpr size_t WS_WOUT = 190 * MiB;
constexpr size_t WS_W1T  = 254 * MiB;
constexpr size_t WS_W2T  = 262 * MiB;
constexpr size_t WS_RGW  = 263 * MiB;
constexpr size_t WS_MOD  = 264 * MiB;
constexpr size_t WS_U    = 266 * MiB;
constexpr size_t WS_P    = 330 * MiB;
constexpr size_t WS_XRES = 518 * MiB;
constexpr size_t WS_V    = 646 * MiB;
constexpr size_t WS_YCAT = 774 * MiB;
constexpr size_t WS_OACC = 838 * MiB;
constexpr size_t WS_HS   = 902 * MiB;
constexpr size_t WS_HDEC = 966 * MiB;
constexpr size_t WS_RGSA = 967 * MiB;
constexpr size_t WS_RGSH = 967 * MiB + 512 * 1024;
constexpr size_t WS_RGC  = 968 * MiB;
constexpr size_t WS_KCMP = 969 * MiB;
constexpr size_t WS_VCMP = 969 * MiB + 256 * 1024;
constexpr size_t WS_SEL  = 970 * MiB;
constexpr size_t WS_END  = 972 * MiB;

constexpr int CW_TMO = 0;
constexpr int CW_BAR = 4096;
constexpr int CW_Q = 8192;

constexpr int RING_BYTES = 131072;
constexpr int LDSCTL_OFF = 143360, MISC_OFF = LDSCTL_OFF + 320;
constexpr int LDS_BYTES = 147456;
constexpr int NWAVES = 8;

#define GAS __attribute__((address_space(1)))
#define LAS __attribute__((address_space(3)))
typedef unsigned short bf16;
typedef unsigned v4u __attribute__((ext_vector_type(4)));
typedef unsigned v2u __attribute__((ext_vector_type(2)));
typedef float f32x4 __attribute__((ext_vector_type(4)));
typedef float f32x16 __attribute__((ext_vector_type(16)));
typedef short bf16x8 __attribute__((ext_vector_type(8)));
typedef short s16x4 __attribute__((ext_vector_type(4)));
typedef GAS unsigned gu32;
#define RLX_AGENT __ATOMIC_RELAXED, __HIP_MEMORY_SCOPE_AGENT
#define LDS_WAIT() asm volatile("s_waitcnt lgkmcnt(0)" ::: "memory")
#define VM_WAIT() asm volatile("s_waitcnt vmcnt(0)" ::: "memory")
#define SBAR() __builtin_amdgcn_sched_barrier(0)
__device__ __forceinline__ unsigned f2bf(float f) { unsigned u = __builtin_bit_cast(unsigned, f); return (u + 0x7fffu + ((u >> 16) & 1u)) >> 16; }
__device__ __forceinline__ unsigned pk2(float lo, float hi) { return f2bf(lo) | (f2bf(hi) << 16); }
__device__ __forceinline__ float bf2f(unsigned h) { return __builtin_bit_cast(float, h << 16); }
__device__ __forceinline__ float bflo(unsigned w) { return __builtin_bit_cast(float, w << 16); }
__device__ __forceinline__ float bfhi(unsigned w) { return __builtin_bit_cast(float, w & 0xffff0000u); }
__device__ __forceinline__ float sigm(float x) { return 1.0f / (1.0f + __expf(-x)); }
__device__ __forceinline__ float silu(float x) { return x / (1.0f + __expf(-x)); }
__device__ __forceinline__ int crow(int r, int hi) { return (r & 3) + 8 * (r >> 2) + 4 * hi; }
__device__ __forceinline__ unsigned cvtpk(float lo, float hi) { unsigned r; asm volatile("v_cvt_pk_bf16_f32 %0, %1, %2" : "=v"(r) : "v"(lo), "v"(hi)); return r; }
__device__ __forceinline__ float wave_sum(float v) {
#pragma unroll
    for (int o = 1; o < 64; o <<= 1) v += __shfl_xor(v, o);
    return v;
}
#define XB_TMO      128
#define XB_XCNT(j)  (256  + 64 * (j))
#define XB_XSUB(j)  (1280 + 64 * (j))
#define XB_XGEN(j)  (2304 + 64 * (j))
#define XB_TOP      3328
#define XB_TOPGEN   3392
#define XCD_BAR_WORDS 3456
#define XB_SPIN_CAP (1u << 18)

__device__ __forceinline__ unsigned xb_ld(unsigned* p)              { return __hip_atomic_load(p, __ATOMIC_RELAXED, __HIP_MEMORY_SCOPE_AGENT); }
__device__ __forceinline__ unsigned xb_add(unsigned* p, unsigned v) { return __hip_atomic_fetch_add(p, v, __ATOMIC_RELAXED, __HIP_MEMORY_SCOPE_AGENT); }
__device__ __forceinline__ unsigned xb_xcc_id() { return (unsigned)__builtin_amdgcn_s_getreg((3 << 11) | 20) & 0xFu; }
#define XB_SPIN(cond, bar) do { unsigned _sp = 0; while (cond) { __builtin_amdgcn_s_sleep(1); \
    if ((++_sp & 255u) == 0u) { if (xb_ld(&(bar)[XB_TMO])) break; if (_sp > XB_SPIN_CAP) { atomicAdd(&(bar)[XB_TMO], 1u); break; } } } } while (0)

struct XcdBarrier {
    unsigned* bar; unsigned x;
    volatile LAS unsigned* st;
};

__device__ __forceinline__ XcdBarrier xcd_barrier_post(unsigned* bar, volatile LAS unsigned* st) {
    XcdBarrier b; b.bar = bar; b.x = xb_xcc_id(); b.st = st;
    if (threadIdx.x == 0) (void)xb_add(&bar[XB_XCNT(b.x)], 1u);
    return b;
}
__device__ __forceinline__ void xcd_barrier_complete(unsigned* bar, unsigned x, unsigned& nloc, unsigned& nx) {
    const unsigned G = gridDim.x * gridDim.y * gridDim.z;
    unsigned sum, cnt, mine, sp = 0u;
    for (;;) {
        sum = 0u; cnt = 0u; mine = 0u;
#pragma unroll 1
        for (unsigned j = 0; j < 16; ++j) { const unsigned c = xb_ld(&bar[XB_XCNT(j)]); sum += c; cnt += (c > 0u) ? 1u : 0u; mine = (j == x) ? c : mine; }
        if (sum == G) break;
        __builtin_amdgcn_s_sleep(1);
        if ((++sp & 255u) == 0u) { if (xb_ld(&bar[XB_TMO])) break; if (sp > XB_SPIN_CAP) { atomicAdd(&bar[XB_TMO], 1u); break; } }
    }
    nloc = mine > 0u ? mine : 1u; nx = cnt > 0u ? cnt : 1u;
}

__device__ __forceinline__ void xcd_barrier(const XcdBarrier& b) {
    asm volatile("s_waitcnt vmcnt(0)" ::: "memory");
    __syncthreads();
    if (threadIdx.x == 0) {
        unsigned* bar = b.bar;
        __builtin_amdgcn_s_waitcnt(0);
        unsigned nloc = b.st[0], nx = b.st[1];
        if (nloc == 0u) { xcd_barrier_complete(bar, b.x, nloc, nx); b.st[0] = nloc; b.st[1] = nx; }
        const unsigned old = xb_add(&bar[XB_XSUB(b.x)], 1u);
        const unsigned gen = old / nloc;
        if (old + 1u == (gen + 1u) * nloc) {
            __builtin_amdgcn_fence(__ATOMIC_RELEASE, "agent");
            asm volatile("s_waitcnt vmcnt(0)" ::: "memory");
            const unsigned og = xb_add(&bar[XB_TOP], 1u);
            const unsigned tg = og / nx;
            if (og + 1u == (tg + 1u) * nx) xb_add(&bar[XB_TOPGEN], 1u);
            else XB_SPIN(xb_ld(&bar[XB_TOPGEN]) == tg, bar);
            __builtin_amdgcn_fence(__ATOMIC_ACQUIRE, "agent");
            xb_add(&bar[XB_XGEN(b.x)], 1u);
            asm volatile("s_waitcnt vmcnt(0)" ::: "memory");
        } else {
            XB_SPIN(xb_ld(&bar[XB_XGEN(b.x)]) == gen, bar);
            __builtin_amdgcn_fence(__ATOMIC_ACQUIRE, "agent");
            asm volatile("s_waitcnt vmcnt(0)" ::: "memory");
        }
    }
    __syncthreads();
}

struct Frame {
    LAS unsigned char* lds;
    volatile LAS unsigned* MISC;
    gu32* ctl;
    int tid, lane, wave, vcu, G;
    unsigned char* ws; float* out;
    const float* const* in;
};
__device__ __forceinline__ bf16* ws_bf(const Frame& F, size_t off) { return (bf16*)(F.ws + off); }
__device__ __forceinline__ float* ws_f(const Frame& F, size_t off) { return (float*)(F.ws + off); }

__device__ __forceinline__ int launder_u(int v) { asm volatile("" : "+v"(v)); return __builtin_amdgcn_readfirstlane(v); }
template <class T> __device__ __forceinline__ T* launder_p(T* p) { const unsigned long long a = (unsigned long long)p;
    const unsigned lo = (unsigned)launder_u((int)(unsigned)a), hi = (unsigned)launder_u((int)(unsigned)(a >> 32)); return (T*)(((unsigned long long)hi << 32) | lo); }
__device__ __forceinline__ void launder(Frame& F) {
    F.ws = launder_p(F.ws); F.out = launder_p(F.out); F.ctl = (gu32*)launder_p((unsigned*)F.ctl);
    F.G = launder_u(F.G); F.vcu = launder_u(F.vcu);
    { const unsigned lb = (unsigned)launder_u((int)(unsigned)(uintptr_t)F.lds); F.lds = (LAS unsigned char*)(uintptr_t)lb; F.MISC = (volatile LAS unsigned*)(F.lds + MISC_OFF); }
    { int t = threadIdx.x; asm volatile("" : "+v"(t)); F.tid = t; F.lane = t & 63; F.wave = __builtin_amdgcn_readfirstlane(t >> 6); }
}

__device__ __forceinline__ int q_next(Frame& F, int qid) {
    __syncthreads();
    if (F.tid == 0) F.MISC[0] = __hip_atomic_fetch_add(F.ctl + CW_Q + 64 * qid, 1u, RLX_AGENT);
    __syncthreads();
    return (int)F.MISC[0];
}

__device__ __forceinline__ int win_src_col(int np) { return np < 5632 ? np : (np < 11776 ? np + 48 : (np < 11824 ? np - 11776 + 5632 : -1)); }
template <int MODE>
__device__ __forceinline__ void transpose_item(const float* W, int K, int N, bf16* WT, LAS float* scr, int kb, int nb, int lane) {
    const int k0 = 64 * kb, n0 = 64 * nb, rr = lane >> 4, cq = lane & 15;
    int nsrc = n0 + 4 * cq; if (MODE == 1) nsrc = win_src_col(nsrc);
    const float* src = W + (size_t)(k0 + rr) * N + (nsrc >= 0 ? nsrc : 0);
    f32x4 v[16];
#pragma unroll
    for (int i = 0; i < 16; ++i) v[i] = (nsrc >= 0) ? *(const GAS f32x4*)(src + (size_t)(4 * i) * N) : (f32x4){0.f, 0.f, 0.f, 0.f};
#pragma unroll
    for (int i = 0; i < 16; ++i) { LAS float* d = scr + (4 * i + rr) * 65 + 4 * cq; d[0] = v[i][0]; d[1] = v[i][1]; d[2] = v[i][2]; d[3] = v[i][3]; }
    LDS_WAIT(); asm volatile("" ::: "memory");
    const int c = lane & 7;
#pragma unroll
    for (int j = 0; j < 8; ++j) { const int n = (lane >> 3) + 8 * j; const LAS float* s = scr + (8 * c) * 65 + n;
        v4u o; o.x = pk2(s[0 * 65], s[1 * 65]); o.y = pk2(s[2 * 65], s[3 * 65]); o.z = pk2(s[4 * 65], s[5 * 65]); o.w = pk2(s[6 * 65], s[7 * 65]);
        *(GAS v4u*)(WT + (size_t)(n0 + n) * K + k0 + 8 * c) = o; }
    LDS_WAIT(); asm volatile("" ::: "memory");
}

__device__ __forceinline__ void ada_item(Frame& F, int item) {
    const int l = item / 384, n0 = (item % 384) * 32;
    const float* W = F.in[2] + (size_t)l * DM * 12288;
    const LAS float* cl = (const LAS float*)F.lds;
    LAS float* red = (LAS float*)(F.lds + 65536);
    const int kq = F.lane >> 3, nq = F.lane & 7;
    f32x4 acc[4];
#pragma unroll
    for (int b = 0; b < 4; ++b) acc[b] = (f32x4){0.f, 0.f, 0.f, 0.f};
#pragma unroll 8
    for (int i = 0; i < 64; ++i) {
        const int k = 64 * i + 8 * F.wave + kq;
        const f32x4 w = *(const GAS f32x4*)(W + (size_t)k * 12288 + n0 + 4 * nq);
#pragma unroll
        for (int b = 0; b < 4; ++b) acc[b] += w * cl[b * DM + k];
    }
#pragma unroll
    for (int b = 0; b < 4; ++b)
#pragma unroll
        for (int e = 0; e < 4; ++e) { float v = acc[b][e]; v += __shfl_xor(v, 8); v += __shfl_xor(v, 16); v += __shfl_xor(v, 32);
            if (kq == 0) red[(F.wave * 4 + b) * 32 + 4 * nq + e] = v; }
    __syncthreads();
    if (F.tid < 128) { const int b = F.tid >> 5, n = F.tid & 31; float s = 0.f;
#pragma unroll
        for (int w = 0; w < 8; ++w) s += red[(w * 4 + b) * 32 + n];
        ws_f(F, WS_MOD)[(size_t)(l * 4 + b) * 12288 + n0 + n] = s + F.in[3][l * 12288 + n0 + n]; }
    __syncthreads();
}

__device__ __forceinline__ void p0_prologue(Frame& F) {
    { LAS float* cl = (LAS float*)F.lds;
      for (int i = F.tid; i < 4 * DM / 4; i += NWAVES * 64) ((LAS f32x4*)cl)[i] = ((const GAS f32x4*)F.in[1])[i];
      __syncthreads();
      for (int it = F.vcu; it < 768; it += F.G) ada_item(F, it);
      __syncthreads(); }
    LAS float* scr = (LAS float*)(F.lds + F.wave * 16640);
    const int gw = F.vcu * NWAVES + F.wave, NGW = F.G * NWAVES;
    constexpr int I_WIN = 64 * (NPAD / 64), I_WOUT = 64 * (DM / 64), I_W1 = 64 * 4, I_W2 = 4 * 2, I_RG = 2 * 2;
    constexpr int NIT = 2 * I_WIN + 2 * I_WOUT + 4 * I_W1 + 4 * I_W2 + 32 * I_RG;
    for (int it = gw; it < NIT; it += NGW) {
        int r = it;
        if (r < 2 * I_WIN) { const int l = r / I_WIN; r -= l * I_WIN; const int nblk = NPAD / 64;
            transpose_item<1>(F.in[4] + (size_t)l * DM * NIN, DM, NIN, ws_bf(F, WS_WIN) + (size_t)l * NPAD * DM, scr, r / nblk, r % nblk, F.lane); continue; }
        r -= 2 * I_WIN;
        if (r < 2 * I_WOUT) { const int l = r / I_WOUT; r -= l * I_WOUT; const int nblk = DM / 64;
            transpose_item<0>(F.in[20] + (size_t)l * DM * DM, DM, DM, ws_bf(F, WS_WOUT) + (size_t)l * DM * DM, scr, r / nblk, r % nblk, F.lane); continue; }
        r -= 2 * I_WOUT;
        if (r < 4 * I_W1) { const int lk = r / I_W1; r -= lk * I_W1; const int l = lk >> 1, kv = lk & 1;
            transpose_item<0>((kv ? F.in[16] : F.in[14]) + (size_t)l * 4096 * 256, 4096, 256, ws_bf(F, WS_W1T) + (size_t)lk * 256 * 4096, scr, r / 4, r % 4, F.lane); continue; }
        r -= 4 * I_W1;
        if (r < 4 * I_W2) { const int lk = r / I_W2; r -= lk * I_W2; const int l = lk >> 1, kv = lk & 1;
            transpose_item<0>((kv ? F.in[17] : F.in[15]) + (size_t)l * 256 * 128, 256, 128, ws_bf(F, WS_W2T) + (size_t)lk * 128 * 256, scr, r / 2, r % 2, F.lane); continue; }
        r -= 4 * I_W2;
        { const int mi = r / I_RG; r -= mi * I_RG; const int l = mi >> 4, gate = (mi >> 3) & 1, n = mi & 7;
            transpose_item<0>((gate ? F.in[9] : F.in[7]) + (size_t)(l * 8 + n) * 128 * 128, 128, 128, ws_bf(F, WS_RGW) + (size_t)mi * 128 * 128, scr, r / 2, r % 2, F.lane); }
    }
    { const int g = F.vcu * NWAVES * 64 + F.tid;
      if (g < 2 * 8 * 128 / 2) { const int kv = g >> 9, rest = g & 511, bg = rest >> 6, e = rest & 63;
          ((unsigned*)(F.ws + (kv ? WS_VCMP : WS_KCMP)))[(size_t)(bg * 128 + 127) * 64 + e] = 0u; } }
}

__device__ __forceinline__ void p1_u0(Frame& F) {
    const int gw = F.vcu * NWAVES + F.wave, NGW = F.G * NWAVES;
    const float* mod = ws_f(F, WS_MOD);
    bf16* U = ws_bf(F, WS_U);
    for (int m = gw; m < MROWS; m += NGW) {
        const int b = m / SEQ;
        const GAS f32x4* xr = (const GAS f32x4*)(F.in[0] + (size_t)m * DM);
        const GAS f32x4* sh = (const GAS f32x4*)(mod + (size_t)b * 12288);
        const GAS f32x4* sc = (const GAS f32x4*)(mod + (size_t)b * 12288 + DM);
        GAS v2u* o = (GAS v2u*)(U + (size_t)m * DM);
#pragma unroll 4
        for (int j = 0; j < 16; ++j) { const int idx = 64 * j + F.lane; const f32x4 v = xr[idx] * (sc[idx] + 1.0f) + sh[idx];
            v2u w; w.x = pk2(v[0], v[1]); w.y = pk2(v[2], v[3]); o[idx] = w; }
    }
}

__device__ __forceinline__ void ln_phase(Frame& F, int l, float* xout, bool unext) {
    const int gw = F.vcu * NWAVES + F.wave, NGW = F.G * NWAVES;
    const float* Vb = ws_f(F, WS_V);
    const float* mod = ws_f(F, WS_MOD) + (size_t)(l + 1) * 4 * 12288;
    bf16* U = ws_bf(F, WS_U);
    const GAS f32x4* g4 = (const GAS f32x4*)(F.in[21] + (size_t)l * DM);
    const GAS f32x4* b4 = (const GAS f32x4*)(F.in[22] + (size_t)l * DM);
    for (int m = gw; m < MROWS; m += NGW) {
        const int b = m / SEQ;
        const GAS f32x4* vr = (const GAS f32x4*)(Vb + (size_t)m * DM);
        f32x4 v[16]; float s = 0.f;
#pragma unroll
        for (int j = 0; j < 16; ++j) { v[j] = vr[64 * j + F.lane]; s += (v[j][0] + v[j][1]) + (v[j][2] + v[j][3]); }
        const float mean = wave_sum(s) * (1.0f / DM); float s2 = 0.f;
#pragma unroll
        for (int j = 0; j < 16; ++j) { v[j] = v[j] - mean; s2 += (v[j][0] * v[j][0] + v[j][1] * v[j][1]) + (v[j][2] * v[j][2] + v[j][3] * v[j][3]); }
        const float rstd = 1.0f / sqrtf(wave_sum(s2) * (1.0f / DM) + LN_EPS);
        GAS f32x4* xo = (GAS f32x4*)(xout + (size_t)m * DM);
        if (unext) {
            const GAS f32x4* sh = (const GAS f32x4*)(mod + (size_t)b * 12288);
            const GAS f32x4* sc = (const GAS f32x4*)(mod + (size_t)b * 12288 + DM);
            GAS v2u* o = (GAS v2u*)(U + (size_t)m * DM);
#pragma unroll
            for (int j = 0; j < 16; ++j) { const int idx = 64 * j + F.lane; const f32x4 y = v[j] * rstd * g4[idx] + b4[idx]; xo[idx] = y;
                const f32x4 u = y * (sc[idx] + 1.0f) + sh[idx]; v2u w; w.x = pk2(u[0], u[1]); w.y = pk2(u[2], u[3]); o[idx] = w; }
        } else {
#pragma unroll
            for (int j = 0; j < 16; ++j) { const int idx = 64 * j + F.lane; xo[idx] = v[j] * rstd * g4[idx] + b4[idx]; }
        }
    }
}

__device__ __forceinline__ f32x16 mfma32(bf16x8 a, bf16x8 b, f32x16 c) { return __builtin_amdgcn_mfma_f32_32x32x16_bf16(a, b, c, 0, 0, 0); }
__device__ __forceinline__ f32x4 mfma16(bf16x8 a, bf16x8 b, f32x4 c) { return __builtin_amdgcn_mfma_f32_16x16x32_bf16(a, b, c, 0, 0, 0); }
__device__ __forceinline__ bf16x8 as_bf16x8(v4u w) { return __builtin_bit_cast(bf16x8, w); }

template <int PASS>
__device__ __forceinline__ void rg_item(Frame& F, int l, int item) {
    const int n = item & 7, c = (item >> 3) & 31, b = item >> 8;
    LAS float* xcf = (LAS float*)(F.lds);
    LAS bf16*  xcb = (LAS bf16*)(F.lds + 32768);
    LAS float* aL  = (LAS float*)(F.lds + 50176);
    LAS float* bxL = (LAS float*)(F.lds + 82944);
    LAS float* qs  = (LAS float*)(F.lds + 115712);
    const bf16* P = ws_bf(F, WS_P);
    const int d = F.tid & 127, tq = F.tid >> 7, ch = n * 128 + d;
    const size_t rowbase = (size_t)b * SEQ + 64 * c;
    {
        const float w0 = F.in[5][(l * 4 + 0) * 1024 + ch], w1 = F.in[5][(l * 4 + 1) * 1024 + ch], w2 = F.in[5][(l * 4 + 2) * 1024 + ch],
                    w3 = F.in[5][(l * 4 + 3) * 1024 + ch], cb = F.in[6][l * 1024 + ch];
        float xv[19];
#pragma unroll
        for (int i = 0; i < 19; ++i) { const int tl = 64 * c + 16 * tq - 3 + i; xv[i] = (tl >= 0) ? bf2f(P[((size_t)b * SEQ + tl) * NPAD + PC_RGX + ch]) : 0.f; }
#pragma unroll
        for (int i = 0; i < 16; ++i) { const float y = cb + w0 * xv[i] + w1 * xv[i + 1] + w2 * xv[i + 2] + w3 * xv[i + 3]; const int t = 16 * tq + i;
            xcf[t * 128 + d] = y; xcb[t * 136 + d] = (bf16)f2bf(y); }
    }
    __syncthreads();
    {
        const int rt = F.wave & 1, ct = F.wave >> 1, r32 = F.lane & 31, hi = F.lane >> 5;
        const bf16* WA = ws_bf(F, WS_RGW) + (size_t)((l * 2 + 0) * 8 + n) * 16384;
        const bf16* WX = ws_bf(F, WS_RGW) + (size_t)((l * 2 + 1) * 8 + n) * 16384;
        f32x16 ga = {}, gx = {};
#pragma unroll
        for (int s = 0; s < 8; ++s) {
            const bf16x8 a = *(const LAS bf16x8*)(xcb + (32 * rt + r32) * 136 + 16 * s + 8 * hi);
            const bf16x8 wa = *(const GAS bf16x8*)(WA + (32 * ct + r32) * 128 + 16 * s + 8 * hi);
            const bf16x8 wx = *(const GAS bf16x8*)(WX + (32 * ct + r32) * 128 + 16 * s + 8 * hi);
            ga = mfma32(a, wa, ga); gx = mfma32(a, wx, gx);
        }
        const int e = 32 * ct + r32, che = n * 128 + e;
        const float ba_ = F.in[8][l * 1024 + che], bx_ = F.in[10][l * 1024 + che], lam = F.in[11][l * 1024 + che];
        const float sp8 = 8.0f * log1pf(__expf(-lam));
#pragma unroll
        for (int r = 0; r < 16; ++r) { const int t = 32 * rt + crow(r, hi);
            const float rg = sigm(ga[r] + ba_), ig = sigm(gx[r] + bx_);
            const float la = -sp8 * rg; const float a = __expf(la); float mult = sqrtf(-expm1f(2.0f * la)); if (c == 0 && t == 0) mult = 1.0f;
            aL[t * 128 + e] = a; bxL[t * 128 + e] = mult * ig * xcf[t * 128 + e]; }
    }
    __syncthreads();
    {
        float av[16], bv[16];
#pragma unroll
        for (int i = 0; i < 16; ++i) { av[i] = aL[(16 * tq + i) * 128 + d]; bv[i] = bxL[(16 * tq + i) * 128 + d]; }
        float Ap = 1.0f, H = 0.f;
#pragma unroll
        for (int i = 0; i < 16; ++i) { H = av[i] * H + bv[i]; Ap *= av[i]; }
        qs[(tq * 128 + d) * 2 + 0] = Ap; qs[(tq * 128 + d) * 2 + 1] = H;
        __syncthreads();
        float hin = 0.f, atot = 1.0f;
        if (PASS == 3) hin = ws_f(F, WS_RGC)[(size_t)(b * 32 + c) * 1024 + ch];
        for (int q = 0; q < tq; ++q) { const float aq = qs[(q * 128 + d) * 2], hq = qs[(q * 128 + d) * 2 + 1]; hin = aq * hin + hq; atot *= aq; }
        if (PASS == 1) {
            if (tq == 3) { ws_f(F, WS_RGSA)[(size_t)(b * 32 + c) * 1024 + ch] = atot * Ap; ws_f(F, WS_RGSH)[(size_t)(b * 32 + c) * 1024 + ch] = Ap * hin + H; }
        } else {
            bf16* Y = ws_bf(F, WS_YCAT);
            float h = hin;
#pragma unroll
            for (int i = 0; i < 16; ++i) { h = av[i] * h + bv[i]; const size_t row = rowbase + 16 * tq + i;
                const float gt = bf2f(P[row * NPAD + PC_RGG + ch]);
                Y[row * DM + ch] = (bf16)f2bf(h * silu(gt)); }
        }
    }
    __syncthreads();
}
__device__ __forceinline__ void rg_pass2(Frame& F) {
    const int g = F.vcu * NWAVES * 64 + F.tid;
    if (g < BATCH * D_RG) { const int b = g >> 10, ch = g & 1023; float h = 0.f;
        const float* A = ws_f(F, WS_RGSA); const float* Hh = ws_f(F, WS_RGSH); float* C = ws_f(F, WS_RGC);
#pragma unroll 8
        for (int c = 0; c < 32; ++c) { const size_t idx = (size_t)(b * 32 + c) * 1024 + ch; C[idx] = h; h = A[idx] * h + Hh[idx]; } }
}

__device__ __forceinline__ float hg_lower_bound(const Frame& F, int l, int ch) {
    if (l == 0) return 0.f;
    return 1.0f / (1.0f + __expf(F.in[18][ch] - F.in[18][1024 + ch]));
}
__device__ __forceinline__ void hg_fk(float z, float lb, int l, float& lf, float& kk) {
    if (l == 0) { lf = fminf(z, 0.f) - log1pf(__expf(-fabsf(z))); kk = sigm(-z); }
    else { const float sg = sigm(z); lf = __logf(lb + (1.0f - lb) * sg); kk = (1.0f - lb) * sigm(-z); }
}
__device__ __forceinline__ void hg1_item(Frame& F, int l, int item) {
    const int c = item & 31, bh = item >> 5, b = bh >> 3, h = bh & 7;
    LAS float* part = (LAS float*)(F.lds);
    LAS bf16* kdT = (LAS bf16*)(F.lds + 2048);
    LAS bf16* vT  = (LAS bf16*)(F.lds + 2048 + 18432);
    const bf16* P = ws_bf(F, WS_P);
    const int k = F.tid & 127, tq = F.tid >> 7, ch = h * 128 + k;
    const size_t row0 = (size_t)b * SEQ + 64 * c + 16 * tq;
    const float lb = hg_lower_bound(F, l, ch);
    float lf[16], kk[16]; float ps = 0.f;
#pragma unroll
    for (int i = 0; i < 16; ++i) { const float z = bf2f(P[(row0 + i) * NPAD + PC_HGF + ch]); hg_fk(z, lb, l, lf[i], kk[i]); ps += lf[i]; }
    part[tq * 128 + k] = ps;
    unsigned vv[8];
#pragma unroll
    for (int i = 0; i < 8; ++i) { const unsigned lo = P[(row0 + 2 * i) * NPAD + PC_HGI + ch], hi2 = P[(row0 + 2 * i + 1) * NPAD + PC_HGI + ch]; vv[i] = lo | (hi2 << 16); }
    *(LAS v4u*)(vT + k * 72 + 16 * tq) = (v4u){vv[0], vv[1], vv[2], vv[3]};
    *(LAS v4u*)(vT + k * 72 + 16 * tq + 8) = (v4u){vv[4], vv[5], vv[6], vv[7]};
    __syncthreads();
    {
        float off = 0.f, tot = 0.f;
#pragma unroll
        for (int q = 0; q < 4; ++q) { const float pq = part[q * 128 + k]; tot += pq; if (q < tq) off += pq; }
        float run = off; unsigned w[8];
#pragma unroll
        for (int i = 0; i < 8; ++i) { run += lf[2 * i]; const float k0 = kk[2 * i] * __expf(tot - run); run += lf[2 * i + 1]; const float k1 = kk[2 * i + 1] * __expf(tot - run); w[i] = pk2(k0, k1); }
        *(LAS v4u*)(kdT + k * 72 + 16 * tq) = (v4u){w[0], w[1], w[2], w[3]};
        *(LAS v4u*)(kdT + k * 72 + 16 * tq + 8) = (v4u){w[4], w[5], w[6], w[7]};
        if (tq == 0) ws_f(F, WS_HDEC)[(size_t)item * 128 + k] = __expf(tot);
    }
    __syncthreads();
    {
        const int vt = F.wave >> 1, kt0 = 2 * (F.wave & 1), r32 = F.lane & 31, hi = F.lane >> 5;
        f32x16 a0 = {}, a1 = {};
#pragma unroll
        for (int s = 0; s < 4; ++s) {
            const bf16x8 a = *(const LAS bf16x8*)(vT + (32 * vt + r32) * 72 + 16 * s + 8 * hi);
            const bf16x8 b0 = *(const LAS bf16x8*)(kdT + (32 * kt0 + r32) * 72 + 16 * s + 8 * hi);
            const bf16x8 b1 = *(const LAS bf16x8*)(kdT + (32 * (kt0 + 1) + r32) * 72 + 16 * s + 8 * hi);
            a0 = mfma32(a, b0, a0); a1 = mfma32(a, b1, a1);
        }
        float* HS = ws_f(F, WS_HS) + (size_t)item * 16384;
#pragma unroll
        for (int r = 0; r < 16; ++r) { const int v = 32 * vt + crow(r, hi); HS[v * 128 + 32 * kt0 + r32] = a0[r]; HS[v * 128 + 32 * kt0 + 32 + r32] = a1[r]; }
    }
    __syncthreads();
}
__device__ __forceinline__ void hg_pass2(Frame& F) {
    float* HS = ws_f(F, WS_HS); const float* DEC = ws_f(F, WS_HDEC);
    for (int g = F.vcu * NWAVES * 64 + F.tid; g < 32 * 4096; g += F.G * NWAVES * 64) {
        const int bh = g >> 12, e4 = g & 4095, k4 = (e4 & 31) * 4;
        f32x4 S = {0.f, 0.f, 0.f, 0.f};
#pragma unroll 8
        for (int c = 0; c < 32; ++c) { GAS f32x4* p = (GAS f32x4*)(HS + ((size_t)(bh * 32 + c) * 16384) + e4 * 4);
            const f32x4 tmp = *p; const f32x4 d4 = *(const GAS f32x4*)(DEC + (size_t)(bh * 32 + c) * 128 + k4); *p = S; S = S * d4 + tmp; }
    }
}
__device__ __forceinline__ void hg3_item(Frame& F, int l, int item) {
    const int c = item & 31, bh = item >> 5, b = bh >> 3, h = bh & 7;
    LAS float* part = (LAS float*)(F.lds);
    LAS bf16* qi   = (LAS bf16*)(F.lds + 2048);
    LAS bf16* qd1  = (LAS bf16*)(F.lds + 19456);
    LAS bf16* kd00 = (LAS bf16*)(F.lds + 28160);
    LAS bf16* kd10 = (LAS bf16*)(F.lds + 36864);
    LAS bf16* kd11 = (LAS bf16*)(F.lds + 45568);
    LAS bf16* sT   = (LAS bf16*)(F.lds + 54272);
    LAS bf16* vT   = (LAS bf16*)(F.lds + 89088);
    LAS bf16* Abf  = (LAS bf16*)(F.lds + 107520);
    LAS float* ssq = (LAS float*)(F.lds + 116736);
    const bf16* P = ws_bf(F, WS_P);
    const int k = F.tid & 127, tq = F.tid >> 7, ch = h * 128 + k;
    const size_t row0 = (size_t)b * SEQ + 64 * c + 16 * tq;
    const float lb = hg_lower_bound(F, l, ch);
    float lf[16], kk[16], qv[16]; float ps = 0.f;
#pragma unroll
    for (int i = 0; i < 16; ++i) { const float z = bf2f(P[(row0 + i) * NPAD + PC_HGF + ch]); hg_fk(z, lb, l, lf[i], kk[i]); ps += lf[i];
        qv[i] = silu(bf2f(P[(row0 + i) * NPAD + PC_HGQ + ch])); }
    part[tq * 128 + k] = ps;
    {
        unsigned vv[8];
#pragma unroll
        for (int i = 0; i < 8; ++i) { const unsigned lo = P[(row0 + 2 * i) * NPAD + PC_HGI + ch], hi2 = P[(row0 + 2 * i + 1) * NPAD + PC_HGI + ch]; vv[i] = lo | (hi2 << 16); }
        *(LAS v4u*)(vT + k * 72 + 16 * tq) = (v4u){vv[0], vv[1], vv[2], vv[3]};
        *(LAS v4u*)(vT + k * 72 + 16 * tq + 8) = (v4u){vv[4], vv[5], vv[6], vv[7]};
    }
    {
        const int v = F.tid >> 2, k0 = (F.tid & 3) * 32;
        const GAS f32x4* src = (const GAS f32x4*)(ws_f(F, WS_HS) + (size_t)item * 16384 + v * 128 + k0);
#pragma unroll
        for (int j = 0; j < 4; ++j) { const f32x4 x0 = src[2 * j], x1 = src[2 * j + 1];
            *(LAS v4u*)(sT + v * 136 + k0 + 8 * j) = (v4u){pk2(x0[0], x0[1]), pk2(x0[2], x0[3]), pk2(x1[0], x1[1]), pk2(x1[2], x1[3])}; }
    }
    __syncthreads();
    {
        float off = 0.f;
#pragma unroll
        for (int q = 0; q < 4; ++q) { const float pq = part[q * 128 + k]; if (q < tq) off += pq; }
        const float bref1 = part[k] + part[128 + k];
        float run = off;
#pragma unroll
        for (int i = 0; i < 16; ++i) { run += lf[i]; const int t = 16 * tq + i;
            qi[t * 136 + k] = (bf16)f2bf(qv[i] * __expf(run));
            if (tq < 2) { kd00[t * 136 + k] = (bf16)f2bf(kk[i] * __expf(-run)); kd10[t * 136 + k] = (bf16)f2bf(kk[i] * __expf(bref1 - run)); }
            else { qd1[(t - 32) * 136 + k] = (bf16)f2bf(qv[i] * __expf(run - bref1)); kd11[(t - 32) * 136 + k] = (bf16)f2bf(kk[i] * __expf(bref1 - run)); } }
    }
    __syncthreads();
    const int r32 = F.lane & 31, hi = F.lane >> 5;
    if (F.wave < 4) {
        const int I = (F.wave == 0 || F.wave == 3) ? 0 : 1, J = (F.wave == 2 || F.wave == 3) ? 1 : 0;
        f32x16 a = {};
        if (F.wave != 3) {
            const LAS bf16* Aop = (F.wave == 0) ? qi : qd1;
            const LAS bf16* Bop = (F.wave == 0) ? kd00 : (F.wave == 1 ? kd10 : kd11);
#pragma unroll
            for (int s = 0; s < 8; ++s) a = mfma32(*(const LAS bf16x8*)(Aop + r32 * 136 + 16 * s + 8 * hi), *(const LAS bf16x8*)(Bop + r32 * 136 + 16 * s + 8 * hi), a);
        }
#pragma unroll
        for (int r = 0; r < 16; ++r) { const int tt = crow(r, hi); float x = a[r]; if (I == J && r32 > tt) x = 0.f;
            Abf[(32 * I + tt) * 72 + 32 * J + r32] = (bf16)f2bf(x); }
    }
    __syncthreads();
    {
        const int I = F.wave & 1, vt = F.wave >> 1;
        f32x16 o = {};
#pragma unroll
        for (int s = 0; s < 8; ++s) o = mfma32(*(const LAS bf16x8*)(qi + (32 * I + r32) * 136 + 16 * s + 8 * hi), *(const LAS bf16x8*)(sT + (32 * vt + r32) * 136 + 16 * s + 8 * hi), o);
#pragma unroll
        for (int s = 0; s < 4; ++s) if (s < 2 * (I + 1)) o = mfma32(*(const LAS bf16x8*)(Abf + (32 * I + r32) * 72 + 16 * s + 8 * hi), *(const LAS bf16x8*)(vT + (32 * vt + r32) * 72 + 16 * s + 8 * hi), o);
#pragma unroll
        for (int r = 0; r < 16; ++r) { float ss = o[r] * o[r];
            ss += __shfl_xor(ss, 1); ss += __shfl_xor(ss, 2); ss += __shfl_xor(ss, 4); ss += __shfl_xor(ss, 8); ss += __shfl_xor(ss, 16);
            if (r32 == 0) ssq[(32 * I + crow(r, hi)) * 4 + vt] = ss; }
        __syncthreads();
        const int v = 32 * vt + r32; const float ng = F.in[19][l * 128 + v];
        bf16* Y = ws_bf(F, WS_YCAT);
#pragma unroll
        for (int r = 0; r < 16; ++r) { const int t = 32 * I + crow(r, hi);
            const float tot = (ssq[t * 4] + ssq[t * 4 + 1]) + (ssq[t * 4 + 2] + ssq[t * 4 + 3]);
            const float rs = 1.0f / sqrtf(tot * (1.0f / 128.0f) + RMS_EPS);
            const size_t row = (size_t)b * SEQ + 64 * c + t;
            const float gt = silu(bf2f(P[row * NPAD + PC_HGG + h * 128 + v]));
            Y[row * DM + 3072 + h * 128 + v] = (bf16)f2bf(o[r] * rs * ng * gt); }
    }
    __syncthreads();
}

__device__ __forceinline__ void cmp_item(Frame& F, int l, int item) {
    const int kv = item >> 6, rt = item & 63;
    const int arow = F.lane & 15, kq = F.lane >> 4;
    LAS float* slots = (LAS float*)F.lds;
    LAS bf16* hbf = (LAS bf16*)(F.lds + 65536);
    const bf16* P = ws_bf(F, WS_P);
    int rho = rt * 16 + arow; if (rho > 1015) rho = 1015;
    const int b = rho / 254, rem = rho - b * 254, j = rem >> 1, g = rem & 1;
    const bf16* xrow = P + ((size_t)b * SEQ + 16 * j) * NPAD + PC_KVC + kv * 256 + g * 128;
    const bf16* W1T = ws_bf(F, WS_W1T) + (size_t)(l * 2 + kv) * 256 * 4096;
    const float* pe = (kv ? F.in[13] : F.in[12]) + l * 32 * 128;
    f32x4 acc[16];
#pragma unroll
    for (int n = 0; n < 16; ++n) acc[n] = (f32x4){0.f, 0.f, 0.f, 0.f};
    for (int li = 0; li < 4; ++li) { const int lidx = 4 * F.wave + li;
#pragma unroll
        for (int ds = 0; ds < 4; ++ds) { const int d = 32 * ds + 8 * kq;
            const v4u xa = *(const GAS v4u*)(xrow + (size_t)lidx * NPAD + d);
            const f32x4 p0 = *(const GAS f32x4*)(pe + lidx * 128 + d), p1 = *(const GAS f32x4*)(pe + lidx * 128 + d + 4);
            v4u aw; aw.x = pk2(bflo(xa.x) + p0[0], bfhi(xa.x) + p0[1]); aw.y = pk2(bflo(xa.y) + p0[2], bfhi(xa.y) + p0[3]);
            aw.z = pk2(bflo(xa.z) + p1[0], bfhi(xa.z) + p1[1]); aw.w = pk2(bflo(xa.w) + p1[2], bfhi(xa.w) + p1[3]);
            const bf16x8 a = as_bf16x8(aw); const int kbase = lidx * 128 + d;
#pragma unroll
            for (int n = 0; n < 16; ++n) { const bf16x8 bb = *(const GAS bf16x8*)(W1T + (size_t)(16 * n + arow) * 4096 + kbase); acc[n] = mfma16(a, bb, acc[n]); }
        } }
    if (F.wave >= 4) {
#pragma unroll
        for (int n = 0; n < 16; ++n)
#pragma unroll
            for (int rg = 0; rg < 4; ++rg) slots[((F.wave - 4) * 16 + 4 * kq + rg) * 256 + 16 * n + arow] = acc[n][rg]; }
    __syncthreads();
    if (F.wave < 4) {
#pragma unroll
        for (int n = 0; n < 16; ++n)
#pragma unroll
            for (int rg = 0; rg < 4; ++rg) slots[(F.wave * 16 + 4 * kq + rg) * 256 + 16 * n + arow] += acc[n][rg]; }
    __syncthreads();
#pragma unroll
    for (int e = 0; e < 8; ++e) { const int idx = F.tid * 8 + e; const float s = (slots[idx] + slots[4096 + idx]) + (slots[8192 + idx] + slots[12288 + idx]);
        hbf[(idx >> 8) * 264 + (idx & 255)] = (bf16)f2bf(silu(s)); }
    __syncthreads();
    {
        const bf16* W2T = ws_bf(F, WS_W2T) + (size_t)(l * 2 + kv) * 128 * 256;
        f32x4 a2 = {0.f, 0.f, 0.f, 0.f};
#pragma unroll
        for (int ks = 0; ks < 8; ++ks) { const bf16x8 a = *(const LAS bf16x8*)(hbf + arow * 264 + 32 * ks + 8 * kq);
            const bf16x8 bb = *(const GAS bf16x8*)(W2T + (size_t)(16 * F.wave + arow) * 256 + 32 * ks + 8 * kq); a2 = mfma16(a, bb, a2); }
        bf16* CMP = ws_bf(F, kv ? WS_VCMP : WS_KCMP);
#pragma unroll
        for (int rg = 0; rg < 4; ++rg) { const int rho2 = rt * 16 + 4 * kq + rg;
            if (rho2 < 1016) { const int b2 = rho2 / 254, rem2 = rho2 - b2 * 254, j2 = rem2 >> 1, g2 = rem2 & 1;
                CMP[((size_t)(b2 * 2 + g2) * 128 + j2) * 128 + 16 * F.wave + arow] = (bf16)f2bf(a2[rg]); } }
    }
    __syncthreads();
}

#define KSWZ(row, colB) ((row) * 256 + ((colB) ^ (((row) & 7) << 4)))
__device__ __forceinline__ int v_st(int k, int c) { const int kk = (k & ~0xC) | ((k & 4) << 1) | ((k & 8) >> 1); return ((kk >> 3) * 4 + (c >> 5)) * 512 + ((kk & 7) * 32 + (c & 31)) * 2; }
__device__ __forceinline__ int v_rd_base(int lane) { return ((lane & 3) << 3) | (((lane >> 2) & 3) << 6) | (((lane >> 4) & 1) << 5) | (((lane >> 5) & 1) << 8); }
constexpr int v_rd_off(int d0, int ks, int half) { return d0 * 512 + ks * 4096 + half * 2048; }
template <int OFF> __device__ __forceinline__ s16x4 tr_read(int vb) {
    s16x4 r; asm volatile("ds_read_b64_tr_b16 %0, %1 offset:%2" : "=&v"(r) : "v"(vb), "i"(OFF) : "memory"); return r;
}
template <int D0> __device__ __forceinline__ void pv_one(f32x16& od, int vb, bf16x8 pa0, bf16x8 pa1, bf16x8 pa2, bf16x8 pa3) {
    const s16x4 l0 = tr_read<v_rd_off(D0, 0, 0)>(vb), h0 = tr_read<v_rd_off(D0, 0, 1)>(vb), l1 = tr_read<v_rd_off(D0, 1, 0)>(vb), h1 = tr_read<v_rd_off(D0, 1, 1)>(vb);
    const s16x4 l2 = tr_read<v_rd_off(D0, 2, 0)>(vb), h2 = tr_read<v_rd_off(D0, 2, 1)>(vb), l3 = tr_read<v_rd_off(D0, 3, 0)>(vb), h3 = tr_read<v_rd_off(D0, 3, 1)>(vb);
    asm volatile("s_waitcnt lgkmcnt(0)" ::: "memory"); SBAR();
#define PK(L, H) (bf16x8){L[0], L[1], L[2], L[3], H[0], H[1], H[2], H[3]}
    od = mfma32(pa0, PK(l0, h0), od);
    od = mfma32(pa1, PK(l1, h1), od);
    od = mfma32(pa2, PK(l2, h2), od);
    od = mfma32(pa3, PK(l3, h3), od);
#undef PK
}
__device__ __forceinline__ void pv_d0(f32x16* o, int vb, bf16x8 pa0, bf16x8 pa1, bf16x8 pa2, bf16x8 pa3) {
    pv_one<0>(o[0], vb, pa0, pa1, pa2, pa3); pv_one<1>(o[1], vb, pa0, pa1, pa2, pa3); pv_one<2>(o[2], vb, pa0, pa1, pa2, pa3); pv_one<3>(o[3], vb, pa0, pa1, pa2, pa3);
}
__device__ __forceinline__ void qkt(f32x16& p0, f32x16& p1, const LAS char* Ks, const bf16x8* qr, int r32, int hi) {
    p0 = f32x16{}; p1 = f32x16{};
#pragma unroll
    for (int d0 = 0; d0 < 8; ++d0) { const int cb = (d0 * 16 + hi * 8) * 2;
        const bf16x8 b0 = *(const LAS bf16x8*)(Ks + KSWZ(r32, cb));
        const bf16x8 b1 = *(const LAS bf16x8*)(Ks + KSWZ(32 + r32, cb));
        p0 = mfma32(b0, qr[d0], p0);
        p1 = mfma32(b1, qr[d0], p1); }
}
__device__ __forceinline__ void p_to_frag(const f32x16& p0, const f32x16& p1, bf16x8& pa0, bf16x8& pa1, bf16x8& pa2, bf16x8& pa3) {
#define PK4(P, BASE, OUT) do { unsigned a0 = cvtpk(P[BASE + 0], P[BASE + 1]), a1 = cvtpk(P[BASE + 2], P[BASE + 3]);   \
    unsigned b0 = cvtpk(P[BASE + 4], P[BASE + 5]), b1 = cvtpk(P[BASE + 6], P[BASE + 7]);                              \
    auto r0 = __builtin_amdgcn_permlane32_swap(a0, b0, false, false); auto r1 = __builtin_amdgcn_permlane32_swap(a1, b1, false, false); \
    v4u w = {r0[0], r1[0], r0[1], r1[1]}; OUT = as_bf16x8(w); } while (0)
    PK4(p0, 0, pa0); PK4(p0, 8, pa1); PK4(p1, 0, pa2); PK4(p1, 8, pa3);
#undef PK4
}
__device__ __forceinline__ float half_swap_max(float v) { auto rr = __builtin_amdgcn_permlane32_swap(__float_as_uint(v), __float_as_uint(v), false, false); return fmaxf(__uint_as_float(rr[0]), __uint_as_float(rr[1])); }
__device__ __forceinline__ float half_swap_sum(float v) { auto rr = __builtin_amdgcn_permlane32_swap(__float_as_uint(v), __float_as_uint(v), false, false); return __uint_as_float(rr[0]) + __uint_as_float(rr[1]); }

struct KVRegs { v4u k0, k1, v0, v1; };
__device__ __forceinline__ void kv_load(KVRegs& R, const bf16* Kg, const bf16* Vg, size_t ld, int sr, int sc) {
    R.k0 = *(const GAS v4u*)(Kg + (size_t)sr * ld + sc); R.k1 = *(const GAS v4u*)(Kg + (size_t)(32 + sr) * ld + sc);
    R.v0 = *(const GAS v4u*)(Vg + (size_t)sr * ld + sc); R.v1 = *(const GAS v4u*)(Vg + (size_t)(32 + sr) * ld + sc);
}
__device__ __forceinline__ void kv_write(const KVRegs& R, LAS char* Kl, LAS char* Vl, int sr, int sc) {
    *(LAS v4u*)(Kl + KSWZ(sr, sc * 2)) = R.k0; *(LAS v4u*)(Kl + KSWZ(32 + sr, sc * 2)) = R.k1;
    *(LAS v4u*)(Vl + v_st(sr, sc)) = R.v0; *(LAS v4u*)(Vl + v_st(32 + sr, sc)) = R.v1;
}
constexpr int koff(int r) { return (r & 3) + 8 * (r >> 2); }
template <int MODE>
__device__ __forceinline__ void sm_tile(f32x16& p0, f32x16& p1, int dist0, bool rowsel, float C1, float C2, float& m, float& l, float& alpha) {
    float pmax = -1e30f;
#pragma unroll
    for (int r = 0; r < 16; ++r) { const int d = dist0 - koff(r); const bool ok = (MODE == 0) ? (rowsel && d >= 0) : (d >= 0 && d < WINDOW);
        const float lg = ok ? fmaf(p0[r], C1, -C2 * (float)d) : -1e30f; p0[r] = lg; pmax = fmaxf(pmax, lg); }
#pragma unroll
    for (int r = 0; r < 16; ++r) { const int d = dist0 - 32 - koff(r); const bool ok = (MODE == 0) ? (rowsel && d >= 0) : (d >= 0 && d < WINDOW);
        const float lg = ok ? fmaf(p1[r], C1, -C2 * (float)d) : -1e30f; p1[r] = lg; pmax = fmaxf(pmax, lg); }
    pmax = half_swap_max(pmax);
    const float mn = fmaxf(m, pmax);
    alpha = __builtin_amdgcn_exp2f(m - mn);
    const float mref = (mn < -1e29f) ? 0.f : mn;
    float ps = 0.f;
#pragma unroll
    for (int r = 0; r < 16; ++r) { p0[r] = __builtin_amdgcn_exp2f(p0[r] - mref); ps += p0[r]; }
#pragma unroll
    for (int r = 0; r < 16; ++r) { p1[r] = __builtin_amdgcn_exp2f(p1[r] - mref); ps += p1[r]; }
    ps = half_swap_sum(ps);
    l = l * alpha + ps; m = mn;
}
__device__ __forceinline__ void sm_tile_fast(f32x16& p0, f32x16& p1, float base, float C1, float C2, float& m, float& l, float& alpha) {
    float pmax = -1e30f;
#pragma unroll
    for (int r = 0; r < 16; ++r) { const float lg = fmaf(p0[r], C1, fmaf((float)koff(r), C2, base)); p0[r] = lg; pmax = fmaxf(pmax, lg); }
#pragma unroll
    for (int r = 0; r < 16; ++r) { const float lg = fmaf(p1[r], C1, fmaf((float)(koff(r) + 32), C2, base)); p1[r] = lg; pmax = fmaxf(pmax, lg); }
    pmax = half_swap_max(pmax);
    const float mn = fmaxf(m, pmax);
    alpha = __builtin_amdgcn_exp2f(m - mn);
    const float mref = (mn < -1e29f) ? 0.f : mn;
    float ps = 0.f;
#pragma unroll
    for (int r = 0; r < 16; ++r) { p0[r] = __builtin_amdgcn_exp2f(p0[r] - mref); ps += p0[r]; }
#pragma unroll
    for (int r = 0; r < 16; ++r) { p1[r] = __builtin_amdgcn_exp2f(p1[r] - mref); ps += p1[r]; }
    ps = half_swap_sum(ps);
    l = l * alpha + ps; m = mn;
}
__device__ __forceinline__ void o_rescale(f32x16* o, float a, LAS float* al_l, int r32, int hi) {
    if (__any(a < 1.0f)) { if (hi == 0) al_l[r32] = a; LDS_WAIT();
#pragma unroll
        for (int r = 0; r < 16; ++r) { const float s = al_l[crow(r, hi)];
#pragma unroll
            for (int d = 0; d < 4; ++d) o[d][r] *= s; }
        LDS_WAIT(); }
}
__device__ __forceinline__ void row_bcast16(float v, float* out16, LAS float* li_l, int r32, int hi) {
    if (hi == 0) li_l[r32] = v; LDS_WAIT();
#pragma unroll
    for (int r = 0; r < 16; ++r) out16[r] = li_l[crow(r, hi)];
    LDS_WAIT();
}

__device__ __forceinline__ void nsa_cmp_item(Frame& F, int l, int item) {
    const int qb = item & 31, g = (item >> 5) & 1, b = item >> 6, q0 = 64 * qb;
    const int ntile = (4 * qb + 3) > 64 ? 2 : 1;
    LAS char* Kl = (LAS char*)F.lds; LAS char* Vl = Kl + 32768;
    LAS float* wsf = (LAS float*)(F.lds + 65536) + F.wave * 64;
    LAS float* impP = (LAS float*)(F.lds + 67584);
    const bf16* P = ws_bf(F, WS_P);
    const int r32 = F.lane & 31, hi = F.lane >> 5;
    {   const int sr = F.tid >> 4, sc = (F.tid & 15) * 8;
        const bf16* KC = ws_bf(F, WS_KCMP) + (size_t)(b * 2 + g) * 128 * 128; const bf16* VC = ws_bf(F, WS_VCMP) + (size_t)(b * 2 + g) * 128 * 128;
        for (int tl = 0; tl < ntile; ++tl) { KVRegs R; kv_load(R, KC + tl * 64 * 128, VC + tl * 64 * 128, 128, sr, sc); kv_write(R, Kl + tl * 16384, Vl + tl * 16384, sr, sc); } }
    __syncthreads();
    const int hg = g * 8 + F.wave;
    const float slope = exp2f(-0.5f * (float)(hg + 1));
    const int vb0 = (int)(uintptr_t)Vl + v_rd_base(F.lane);
    float* OACC = ws_f(F, WS_OACC);
    for (int qh = 0; qh < 2; ++qh) {
        const int t = q0 + 32 * qh + r32; const size_t row = (size_t)b * SEQ + t;
        bf16x8 qr[8];
#pragma unroll
        for (int d0 = 0; d0 < 8; ++d0) qr[d0] = *(const GAS bf16x8*)(P + row * NPAD + PC_Q + hg * 128 + 16 * d0 + 8 * hi);
        f32x16 p0, p1, p2, p3;
        qkt(p0, p1, Kl, qr, r32, hi);
        if (ntile == 2) qkt(p2, p3, Kl + 16384, qr, r32, hi); else { p2 = f32x16{}; p3 = f32x16{}; }
        const int base0 = t - 31 - 64 * hi; float mx = -1e30f;
#define LG(Pv, SH) _Pragma("unroll") for (int r = 0; r < 16; ++r) { const int d = base0 - (SH) - 16 * koff(r); const float lg = (d >= 0) ? (Pv[r] * SM_SCALE - slope * (float)d) : -1e30f; Pv[r] = lg; mx = fmaxf(mx, lg); }
        LG(p0, 0) LG(p1, 512) LG(p2, 1024) LG(p3, 1536)
#undef LG
        mx = half_swap_max(mx);
        const float mref = (mx < -1e29f) ? 0.f : mx; float sum = 0.f;
#define EX(Pv) _Pragma("unroll") for (int r = 0; r < 16; ++r) { Pv[r] = __expf(Pv[r] - mref); sum += Pv[r]; }
        EX(p0) EX(p1) EX(p2) EX(p3)
#undef EX
        sum = half_swap_sum(sum);
        const float inv = sum > 0.f ? 1.0f / sum : 0.f;
#define SC(Pv, S) _Pragma("unroll") for (int r = 0; r < 16; ++r) Pv[r] *= (S);
        SC(p0, inv) SC(p1, inv) SC(p2, inv) SC(p3, inv)
        {   float cg[16], sp[16];
#define GRP(Pv, GB) _Pragma("unroll") for (int i = 0; i < 4; ++i) { sp[(GB) + i] = 0.5f * Pv[4 * i + 3]; cg[(GB) + i] = (Pv[4 * i] + Pv[4 * i + 1]) + (Pv[4 * i + 2] + sp[(GB) + i]); }
            GRP(p0, 0) GRP(p1, 4) GRP(p2, 8) GRP(p3, 12)
#undef GRP
            float oth[16];
#pragma unroll
            for (int G = 0; G < 16; ++G) oth[G] = __shfl_xor(sp[G], 32);
#pragma unroll
            for (int G = 0; G < 16; ++G) { float v = cg[G]; if (hi) v += oth[G]; else if (G > 0) v += oth[G - 1];
                impP[(F.wave * 64 + 32 * qh + r32) * 32 + 2 * G + hi] = v; }
        }
        const float g0 = sigm(bf2f(P[row * NPAD + PC_GL + hg * 3 + 0]));
        SC(p0, g0) SC(p1, g0) SC(p2, g0) SC(p3, g0)
#undef SC
        f32x16 o[4] = {};
        { bf16x8 pa0, pa1, pa2, pa3; p_to_frag(p0, p1, pa0, pa1, pa2, pa3); pv_d0(o, vb0, pa0, pa1, pa2, pa3); }
        if (ntile == 2) { bf16x8 pa0, pa1, pa2, pa3; p_to_frag(p2, p3, pa0, pa1, pa2, pa3); pv_d0(o, vb0 + 16384, pa0, pa1, pa2, pa3); }
#pragma unroll
        for (int r = 0; r < 16; ++r) { const size_t orow = (size_t)b * SEQ + q0 + 32 * qh + crow(r, hi);
#pragma unroll
            for (int d0 = 0; d0 < 4; ++d0) OACC[orow * D_NSA + hg * 128 + 32 * d0 + r32] = o[d0][r]; }
    }
    __syncthreads();
    LAS float* impS = (LAS float*)F.lds;
    const int q = F.tid >> 3, sub = F.tid & 7;
#pragma unroll
    for (int e = 0; e < 4; ++e) { const int n = 4 * sub + e; float s = 0.f;
#pragma unroll
        for (int w = 0; w < 8; ++w) s += impP[(w * 64 + q) * 32 + n];
        if (n > qb) s = -1e30f; else if (n == 0 || n == qb || n == qb - 1) s = 1e9f;
        impS[q * 33 + n] = s; }
    __syncthreads();
    {   float mine[4]; int rank[4];
#pragma unroll
        for (int e = 0; e < 4; ++e) { mine[e] = impS[q * 33 + 4 * sub + e]; rank[e] = 0; }
        for (int mI = 0; mI < 32; ++mI) { const float sm = impS[q * 33 + mI];
#pragma unroll
            for (int e = 0; e < 4; ++e) rank[e] += (sm > mine[e] || (sm == mine[e] && mI < 4 * sub + e)) ? 1 : 0; }
        unsigned bits = 0u;
#pragma unroll
        for (int e = 0; e < 4; ++e) if (rank[e] < TOPN && (4 * sub + e) <= qb) bits |= 1u << (4 * sub + e);
        bits |= __shfl_xor(bits, 1); bits |= __shfl_xor(bits, 2); bits |= __shfl_xor(bits, 4);
        if (sub == 0) ((unsigned*)(F.ws + WS_SEL))[(size_t)(b * 2 + g) * SEQ + q0 + q] = bits;
    }
    __syncthreads();
}

template <int MODE>
__device__ __forceinline__ void attn_branch(Frame& F, f32x16* o, float& lsum, const bf16x8* qr, const bf16* Kg, const bf16* Vg, unsigned tiles, unsigned mymask,
                                            int t, int qb, float C1, float C2, LAS char* KV, LAS float* wsf) {
    const int r32 = F.lane & 31, hi = F.lane >> 5, sr = F.tid >> 4, sc = (F.tid & 15) * 8;
    float m = -1e30f; lsum = 0.f;
    unsigned rem = tiles; int cur = 0;
    KVRegs R;
    { const int n = 31 - __builtin_clz(rem); kv_load(R, Kg + (size_t)(64 * n) * NPAD, Vg + (size_t)(64 * n) * NPAD, NPAD, sr, sc); }
    __syncthreads();
    kv_write(R, KV, KV + 16384, sr, sc);
    __syncthreads();
    while (rem) {
        const int n = 31 - __builtin_clz(rem); rem &= ~(1u << n);
        LAS char* Kl = KV + cur * 32768; LAS char* Vl = Kl + 16384;
        if (rem) { const int n2 = 31 - __builtin_clz(rem); kv_load(R, Kg + (size_t)(64 * n2) * NPAD, Vg + (size_t)(64 * n2) * NPAD, NPAD, sr, sc); }
        f32x16 p0, p1; qkt(p0, p1, Kl, qr, r32, hi);
        float alpha;
        int dist0 = t - 64 * n - 4 * hi; asm volatile("" : "+v"(dist0));
        const bool rowsel = ((mymask >> n) & 1u) != 0u;
        const bool masked = (n == qb) || (MODE == 1 && n == qb - 8);
        if (masked) sm_tile<MODE>(p0, p1, dist0, rowsel, C1, C2, m, lsum, alpha);
        else sm_tile_fast(p0, p1, rowsel ? -C2 * (float)dist0 : -1e30f, C1, C2, m, lsum, alpha);
        o_rescale(o, alpha, wsf, r32, hi);
        bf16x8 pa0, pa1, pa2, pa3; p_to_frag(p0, p1, pa0, pa1, pa2, pa3);
        pv_d0(o, (int)(uintptr_t)Vl + v_rd_base(F.lane), pa0, pa1, pa2, pa3);
        if (rem) kv_write(R, KV + (cur ^ 1) * 32768, KV + (cur ^ 1) * 32768 + 16384, sr, sc);
        __syncthreads();
        cur ^= 1;
    }
}
__device__ __forceinline__ void nsa_attn_item(Frame& F, int l, int item) {
    const int qb = 31 - (item >> 4), rest = item & 15, b = rest >> 2, g = (rest >> 1) & 1, hh = rest & 1, q0 = 64 * qb;
    const int r32 = F.lane & 31, hi = F.lane >> 5;
    const int hg = 8 * g + 4 * hh + (F.wave >> 1), qh = F.wave & 1, t = q0 + 32 * qh + r32;
    const size_t row = (size_t)b * SEQ + t;
    const float slope = exp2f(-0.5f * (float)(hg + 1)), C1 = SM_SCALE * LOG2E, C2 = slope * LOG2E;
    LAS char* KV = (LAS char*)F.lds; LAS float* wsf = (LAS float*)(F.lds + 65536) + F.wave * 64;
    const bf16* P = ws_bf(F, WS_P);
    bf16x8 qr[8];
#pragma unroll
    for (int d0 = 0; d0 < 8; ++d0) qr[d0] = *(const GAS bf16x8*)(P + row * NPAD + PC_Q + hg * 128 + 16 * d0 + 8 * hi);
    const unsigned* SEL = (const unsigned*)(F.ws + WS_SEL) + (size_t)(b * 2 + g) * SEQ;
    const unsigned mymask = SEL[t];
    unsigned uni = SEL[q0 + F.lane];
#pragma unroll
    for (int o_ = 1; o_ < 64; o_ <<= 1) uni |= __shfl_xor(uni, o_);
    uni = __builtin_amdgcn_readfirstlane(uni);
    const unsigned upto = (qb == 31) ? 0xffffffffu : ((2u << qb) - 1u);
    const float* OACC = ws_f(F, WS_OACC);
    LAS unsigned* stash = (LAS unsigned*)(F.lds + 67584) + F.tid;
    float lsum, rs[16];
    {
        f32x16 o[4] = {};
        attn_branch<0>(F, o, lsum, qr, P + (size_t)b * SEQ * NPAD + PC_KVS + g * 128, P + (size_t)b * SEQ * NPAD + PC_KVS + 256 + g * 128, uni & upto, mymask, t, qb, C1, C2, KV, wsf);
        const float g1 = sigm(bf2f(P[row * NPAD + PC_GL + hg * 3 + 1]));
        row_bcast16(g1 / lsum, rs, wsf + 32, r32, hi);
#pragma unroll
        for (int d0 = 0; d0 < 4; ++d0)
#pragma unroll
            for (int r = 0; r < 16; r += 2) stash[(d0 * 8 + (r >> 1)) * 512] = cvtpk(o[d0][r] * rs[r], o[d0][r + 1] * rs[r + 1]);
    }
    {
        f32x16 o[4] = {};
        const int nlo = qb > 8 ? qb - 8 : 0;
        const unsigned wt = upto & ~((1u << nlo) - 1u);
        attn_branch<1>(F, o, lsum, qr, P + (size_t)b * SEQ * NPAD + PC_KVW + g * 128, P + (size_t)b * SEQ * NPAD + PC_KVW + 256 + g * 128, wt, 0xffffffffu, t, qb, C1, C2, KV, wsf);
        const float g2 = sigm(bf2f(P[row * NPAD + PC_GL + hg * 3 + 2]));
        row_bcast16(g2 / lsum, rs, wsf + 32, r32, hi);
        const size_t rb = (size_t)b * SEQ + q0 + 32 * qh + 4 * hi;
        const float* oa = OACC + rb * D_NSA + hg * 128 + r32;
        const bf16* gp = P + rb * NPAD + PC_NSAG + hg * 128 + r32;
        bf16* yp = ws_bf(F, WS_YCAT) + rb * DM + 1024 + hg * 128 + r32;
#pragma unroll
        for (int r = 0; r < 16; ++r) {
#pragma unroll
            for (int d0 = 0; d0 < 4; ++d0) { const unsigned sw = stash[(d0 * 8 + (r >> 1)) * 512];
                const float sel = (r & 1) ? bfhi(sw) : bflo(sw);
                const float v = oa[(size_t)koff(r) * D_NSA + 32 * d0] + sel + o[d0][r] * rs[r];
                const float gt = silu(bf2f(gp[(size_t)koff(r) * NPAD + 32 * d0]));
                yp[(size_t)koff(r) * DM + 32 * d0] = (bf16)f2bf(v * gt); }
            asm volatile("" ::: "memory");
        }
    }
    __syncthreads();
}

#ifndef PROBE_DUP
#define PROBE_DUP -1
#endif
#ifndef MK_SPLIT
#define MK_SPLIT 0
#endif
constexpr int N_PHASES = 2 + 6 * DEPTH;
struct Args { const float* in[23]; float* out; unsigned char* ws; int ph_lo, ph_hi; };
__global__ void __launch_bounds__(NWAVES * 64, 2) hymba_fwd(Args args) {
    extern __shared__ __attribute__((aligned(16))) unsigned char lds[];
    Frame F;
    F.lds = (LAS unsigned char*)lds;
    F.MISC = (volatile LAS unsigned*)(F.lds + MISC_OFF);
    F.tid = threadIdx.x; F.lane = F.tid & 63; F.wave = __builtin_amdgcn_readfirstlane(F.tid >> 6);
    F.G = gridDim.x; { const int bx = blockIdx.x; F.vcu = (F.G % 8 == 0) ? (bx % 8) * (F.G / 8) + bx / 8 : bx; }
    F.ws = args.ws; F.out = args.out; F.ctl = (gu32*)(args.ws + WS_CTL);
    F.in = args.in;
    for (int u = F.tid; u < (LDS_BYTES - LDSCTL_OFF) / 4; u += NWAVES * 64) ((LAS unsigned*)(F.lds + LDSCTL_OFF))[u] = 0u;
    __syncthreads();
#if MK_SPLIT
#define GRID_BAR() do { } while (0)
#else
    XcdBarrier bar = xcd_barrier_post((unsigned*)(F.ctl + CW_BAR), F.MISC + 8);
#define GRID_BAR() xcd_barrier(bar)
#endif
#if MK_SPLIT
    const int lo = args.ph_lo, hi_ = args.ph_hi;
#define IN(k) (lo <= (k) && (k) < hi_)
#define BOTH(k) (IN(k) && IN((k) + 1))
#else
#define IN(k) true
#define BOTH(k) ((k) + 1 < N_PHASES)
#endif

    if (IN(0)) { launder(F); p0_prologue(F);
#if PROBE_DUP == 0
            launder(F); __syncthreads(); p0_prologue(F);
#endif
        if (BOTH(0)) GRID_BAR(); }
    if (IN(1)) { launder(F); p1_u0(F); if (BOTH(1)) GRID_BAR(); }
    for (int l = 0; l < DEPTH; ++l) {
        const int pb = 2 + 6 * l;
        if (IN(pb + 0)) { launder(F);
            pg8::Gemm g{ws_bf(F, WS_U), ws_bf(F, WS_WIN) + (size_t)l * NPAD * DM, MROWS, NPAD, DM}; pg8::StaticOrder S; S.init(MROWS, NPAD, F.G, (int)blockIdx.x);
            pg8::EpiBf16 E{ws_bf(F, WS_P), NPAD};
            pg8::gemm_phase<pg8::EpiBf16, pg8::StaticOrder, true, true>(F.lds, g, S, E);
#if PROBE_DUP == 1
            launder(F); __syncthreads(); pg8::gemm_phase<pg8::EpiBf16, pg8::StaticOrder, true, true>(F.lds, g, S, E);
#endif
            if (BOTH(pb + 0)) GRID_BAR();
        }
        if (IN(pb + 1)) { launder(F);
            for (int it = F.vcu; it < 128; it += F.G) cmp_item(F, l, it);
            launder(F);
            for (int it = F.vcu; it < 1024; it += F.G) hg1_item(F, l, it);
            launder(F);
            for (int it = F.vcu; it < 1024; it += F.G) rg_item<1>(F, l, it);
#if PROBE_DUP == 2
            launder(F); for (int it = F.vcu; it < 128; it += F.G) cmp_item(F, l, it); launder(F); for (int it = F.vcu; it < 1024; it += F.G) hg1_item(F, l, it); launder(F); for (int it = F.vcu; it < 1024; it += F.G) rg_item<1>(F, l, it);
#endif
            if (BOTH(pb + 1)) GRID_BAR();
        }
        if (IN(pb + 2)) { launder(F);
            for (int it = F.vcu; it < 256; it += F.G) nsa_cmp_item(F, l, it);
#if PROBE_DUP == 3
            launder(F); for (int it = F.vcu; it < 256; it += F.G) nsa_cmp_item(F, l, it);
#endif
            launder(F);
            hg_pass2(F);
            launder(F);
            rg_pass2(F);
            if (BOTH(pb + 2)) GRID_BAR();
        }
        if (IN(pb + 3)) { launder(F);
            for (;;) { const int it = q_next(F, l * 4 + 0); if (it >= 512) break; nsa_attn_item(F, l, it); }
#if PROBE_DUP == 4
            launder(F); for (;;) { const int it = q_next(F, 8 + l * 4 + 0); if (it >= 512) break; nsa_attn_item(F, l, it); }
#endif
            launder(F);
            for (;;) { const int it = q_next(F, l * 4 + 1); if (it >= 1024) break; hg3_item(F, l, it); }
            launder(F);
            for (;;) { const int it = q_next(F, l * 4 + 2); if (it >= 1024) break; rg_item<3>(F, l, it); }
#if PROBE_DUP == 5
            launder(F); for (;;) { const int it = q_next(F, 8 + l * 4 + 1); if (it >= 1024) break; hg3_item(F, l, it); } launder(F); for (;;) { const int it = q_next(F, 8 + l * 4 + 2); if (it >= 1024) break; rg_item<3>(F, l, it); }
#endif
            if (BOTH(pb + 3)) GRID_BAR();
        }
        if (IN(pb + 4)) { launder(F);
            pg8::Gemm g{ws_bf(F, WS_YCAT), ws_bf(F, WS_WOUT) + (size_t)l * DM * DM, MROWS, DM, DM}; pg8::StaticOrder S; S.init(MROWS, DM, F.G, (int)blockIdx.x);
            pg8::EpiResid E{l == 0 ? F.in[0] : ws_f(F, WS_XRES), ws_f(F, WS_V), ws_f(F, WS_MOD) + (size_t)l * 4 * 12288 + 2 * DM, 12288, SEQ, DM, ALPHA};
            pg8::gemm_phase<pg8::EpiResid, pg8::StaticOrder, true, true>(F.lds, g, S, E);
#if PROBE_DUP == 6
            launder(F); __syncthreads(); pg8::gemm_phase<pg8::EpiResid, pg8::StaticOrder, true, true>(F.lds, g, S, E);
#endif
            if (BOTH(pb + 4)) GRID_BAR();
        }
        if (IN(pb + 5)) { launder(F);
            ln_phase(F, l, (l == DEPTH - 1) ? F.out : ws_f(F, WS_XRES), l != DEPTH - 1);
#if PROBE_DUP == 7
            launder(F); ln_phase(F, l, (l == DEPTH - 1) ? F.out : ws_f(F, WS_XRES), l != DEPTH - 1);
#endif
            if (BOTH(pb + 5)) GRID_BAR();
        }
    }
#undef IN
#undef BOTH
}

extern "C" void kernel_launch(void* const* d_in, const int* in_sizes, int n_in, void* d_out, int out_size, void* d_ws, size_t ws_size, hipStream_t stream) {
    static int grid = 0;
    if (grid == 0) {
        if (n_in != 23 || in_sizes[0] != MROWS * DM || out_size != MROWS * DM || ws_size < WS_END) {
            fprintf(stderr, "kernel_launch: shape/workspace mismatch: n_in %d in0 %d out %d ws %zu (need %zu)\n", n_in, n_in > 0 ? in_sizes[0] : -1, out_size, ws_size, (size_t)WS_END); grid = -1; return; }
        int dev = 0, cus = 0, per_cu = 0;
        if (hipGetDevice(&dev) != hipSuccess || hipDeviceGetAttribute(&cus, hipDeviceAttributeMultiprocessorCount, dev) != hipSuccess) { fprintf(stderr, "kernel_launch: device query failed\n"); grid = -1; return; }
        if (hipFuncSetAttribute((const void*)hymba_fwd, hipFuncAttributeMaxDynamicSharedMemorySize, LDS_BYTES) != hipSuccess) { fprintf(stderr, "kernel_launch: hipFuncSetAttribute failed\n"); grid = -1; return; }
        if (hipOccupancyMaxActiveBlocksPerMultiprocessor(&per_cu, (const void*)hymba_fwd, NWAVES * 64, LDS_BYTES) != hipSuccess || per_cu < 1)
            fprintf(stderr, "kernel_launch: note: occupancy query reports %d workgroups per CU\n", per_cu);
        (void)hipGetLastError();
        grid = cus;
    }
    if (grid < 0) return;
    if (hipMemsetAsync((char*)d_ws + WS_CTL, 0, CTL_ZERO_BYTES, stream) != hipSuccess) { fprintf(stderr, "kernel_launch: memset failed\n"); return; }
    Args a{};
    for (int i = 0; i < 23; ++i) a.in[i] = (const float*)d_in[i];
    a.out = (float*)d_out; a.ws = (unsigned char*)d_ws;
#if MK_SPLIT
    for (int ph = 0; ph < N_PHASES; ++ph) { a.ph_lo = ph; a.ph_hi = ph + 1;
        hipLaunchKernelGGL(hymba_fwd, dim3(grid), dim3(NWAVES * 64), LDS_BYTES, stream, a); }
#else
    a.ph_lo = 0; a.ph_hi = N_PHASES;
    hipLaunchKernelGGL(hymba_fwd, dim3(grid), dim3(NWAVES * 64), LDS_BYTES, stream, a);
#endif
    const hipError_t le = hipPeekAtLastError();
    if (le != hipSuccess) fprintf(stderr, "kernel_launch: launch failed: %s\n", hipGetErrorName(le));
}
```

```cpp
#include <hip/hip_runtime.h>
#include <cstdio>
#include <cstdint>
#define MK_SPLIT 0
#define PROBE_DUP -1
namespace pg8 {
#define PG8_LAS __attribute__((address_space(3)))
typedef unsigned short bf16_t;
typedef short bf16x8 __attribute__((ext_vector_type(8)));
typedef float f32x4 __attribute__((ext_vector_type(4)));
typedef unsigned u32x4 __attribute__((ext_vector_type(4)));
constexpr int BM = 256, BK = 64, HALF = 128, HTB = HALF * BK * 2  , STAGE_BYTES = 8 * HTB, NXCD = 8, WGM = 8;

__host__ __device__ __forceinline__ int lds_byte(int r, int c) { const int st = (r >> 4) * 2 + (c >> 5), rr = r & 15, cc = c & 31, ob = rr * 64 + cc * 2; return st * 1024 + (ob ^ (((ob >> 9) & 1) << 5)); }
__host__ __device__ __forceinline__ void stage_rc(int b, int& R, int& C) { const int st = b / 1024, sb = b % 1024, swz = sb ^ (((sb >> 9) & 1) << 5); R = (st >> 1) * 16 + swz / 64; C = (st & 1) * 32 + (swz % 64) / 2; }
__host__ __device__ __forceinline__ int perm32(int rho) { const int n = rho >> 4, i = rho & 15; return 8 * (i >> 2) + 4 * n + (i & 3); }

struct Unit { int pm, pn; };
struct Gemm { const bf16_t* A; const bf16_t* Bt; int M, N, K; };

struct StaticOrder {
    int nM, nN, nwg, G, c;
    __host__ __device__ void init(int M, int N, int G_, int c_) { nM = M / BM; nN = N / BM; nwg = nM * nN; G = G_; c = c_; }
    __host__ __device__ bool next(int i, Unit& u) const {
        const long L = (long)i * G + c; if (L >= nwg) return false;
        int wgid = (int)L; { const int q = nwg / NXCD, r = nwg % NXCD, xcd = wgid % NXCD, off = wgid / NXCD; wgid = (xcd < r ? xcd * (q + 1) : r * (q + 1) + (xcd - r) * q) + off; }
        const int nig = WGM * nN, gid = wgid / nig, fm = gid * WGM, gsz = (nM - fm) < WGM ? (nM - fm) : WGM;
        u.pm = fm + ((wgid % nig) % gsz); u.pn = (wgid % nig) / gsz; return true;
    }
    __device__ __forceinline__ void a_ready(const Unit&) const {}
    __device__ __forceinline__ void done(const Unit&) const {}
};

__device__ __forceinline__ unsigned cvt_pk_bf16(float lo, float hi) { unsigned r; asm volatile("v_cvt_pk_bf16_f32 %0, %1, %2" : "=v"(r) : "v"(lo), "v"(hi)); return r; }
typedef float f32x2 __attribute__((ext_vector_type(2)));

struct EpiBf16 {
    static constexpr bool PERM = true, AFTER_DRAIN = false;
    bf16_t* O; int ldc;
    __device__ __forceinline__ void operator()(const f32x4 (&acc)[2][2][4][2], const Unit& u, int wr, int wc, int fr, int fq) const {
        const int row0 = u.pm * BM + wr * 64 + fr; const int col0 = u.pn * BM + wc * 32 + 8 * fq;
#pragma unroll
        for (int ai = 0; ai < 2; ++ai)
#pragma unroll
            for (int m = 0; m < 4; ++m) { bf16_t* rowp = O + (size_t)(row0 + ai * HALF + m * 16) * ldc + col0;
#pragma unroll
                for (int bj = 0; bj < 2; ++bj) { const f32x4 v0 = acc[ai][bj][m][0], v1 = acc[ai][bj][m][1];
                    u32x4 w; w.x = cvt_pk_bf16(v0[0], v0[1]); w.y = cvt_pk_bf16(v0[2], v0[3]); w.z = cvt_pk_bf16(v1[0], v1[1]); w.w = cvt_pk_bf16(v1[2], v1[3]);
                    *(u32x4*)(rowp + bj * HALF) = w; } }
    }
};
struct EpiResid {
    static constexpr bool PERM = false, AFTER_DRAIN = false;
    const float* xres; float* V; const float* gate; int gate_stride; int rows_per_batch; int ldc; float alpha;
    __device__ __forceinline__ void operator()(const f32x4 (&acc)[2][2][4][2], const Unit& u, int wr, int wc, int fr, int fq) const {
        const int bidx = (u.pm * BM) / rows_per_batch; const int col0 = u.pn * BM + wc * 32 + 4 * fq;
        f32x4 gv[2][2];
#pragma unroll
        for (int bj = 0; bj < 2; ++bj)
#pragma unroll
            for (int n = 0; n < 2; ++n) gv[bj][n] = *(const f32x4*)(gate + (size_t)bidx * gate_stride + col0 + bj * HALF + n * 16) + 1.0f;
#pragma unroll
        for (int ai = 0; ai < 2; ++ai)
#pragma unroll
            for (int m = 0; m < 4; ++m) { const size_t off = (size_t)(u.pm * BM + ai * HALF + wr * 64 + m * 16 + fr) * ldc + col0;
#pragma unroll
                for (int bj = 0; bj < 2; ++bj)
#pragma unroll
                    for (int n = 0; n < 2; ++n) { const f32x4 xr = *(const f32x4*)(xres + off + bj * HALF + n * 16);
                        *(f32x4*)(V + off + bj * HALF + n * 16) = xr * alpha + gv[bj][n] * acc[ai][bj][m][n]; } }
    }
};
template <class Epi, class Sched, bool ALIGN_EPI = false, bool SP2 = false>
__device__ __forceinline__ void gemm_phase(PG8_LAS unsigned char* lds, const Gemm g, const Sched& S, const Epi& E) {
    int tid_ = threadIdx.x; asm volatile("" : "+v"(tid_));
    const int tid = tid_, wid = __builtin_amdgcn_readfirstlane(tid >> 6), lane = tid & 63, wr = wid >> 2, wc = wid & 3, fr = lane & 15, fq = lane >> 4;
    const int K = g.K, nt = K / BK;
    unsigned voffA[2], voffB[2];
#pragma unroll
    for (int i = 0; i < 2; ++i) { int R, C; stage_rc(tid * 16 + i * 8192, R, C); const int Rb = Epi::PERM ? ((R & ~31) + perm32(R & 31)) : R;
        voffA[i] = (unsigned)(R * K + C) * 2u; voffB[i] = (unsigned)(Rb * K + C) * 2u; }
    const size_t kstep = (size_t)(BK * 2);
    const size_t hstep = (size_t)HALF * K * 2;
    const size_t tstep = 2 * hstep;
    const unsigned ldsw = (unsigned)wid * 1024u;
    const int aoff = lds_byte(wr * 64 + fr, fq * 8), boff = lds_byte(wc * 32 + fr, fq * 8);
#define PG8_SA(b, h) (((b) * 2 + (h)) * HTB)
#define PG8_SB(b, h) ((4 + (b) * 2 + (h)) * HTB)
#define PG8_STAGE(bufoff, gbase, voff) do { _Pragma("unroll") for (int _i = 0; _i < 2; ++_i) \
        __builtin_amdgcn_global_load_lds((const unsigned*)((const char*)(gbase) + (voff)[_i]), (PG8_LAS unsigned*)(lds + (bufoff) + ldsw + _i * 8192), 16, 0, 0); } while (0)
#define PG8_LDA(dst, b, h) do { _Pragma("unroll") for (int m = 0; m < 4; ++m) _Pragma("unroll") for (int k = 0; k < 2; ++k) dst[m][k] = *(const PG8_LAS bf16x8*)(lds + PG8_SA(b, h) + aoff + m * 2048 + k * 1024); } while (0)
#define PG8_LDB(dst, b, h) do { _Pragma("unroll") for (int n = 0; n < 2; ++n) _Pragma("unroll") for (int k = 0; k < 2; ++k) dst[n][k] = *(const PG8_LAS bf16x8*)(lds + PG8_SB(b, h) + boff + n * 2048 + k * 1024); } while (0)
#define PG8_MMA(ai, bj, At, Bt) do { __builtin_amdgcn_s_setprio(1); _Pragma("unroll") for (int m = 0; m < 4; ++m) _Pragma("unroll") for (int n = 0; n < 2; ++n) _Pragma("unroll") for (int k = 0; k < 2; ++k) \
        acc[ai][bj][m][n] = __builtin_amdgcn_mfma_f32_16x16x32_bf16(Bt[n][k], At[m][k], acc[ai][bj][m][n], 0, 0, 0); __builtin_amdgcn_s_setprio(0); } while (0)
#define PG8_WAIT_V(n) asm volatile("s_waitcnt vmcnt(" #n ")" ::: "memory")
#define PG8_WAIT_L(n) asm volatile("s_waitcnt lgkmcnt(" #n ")" ::: "memory")
#define PG8_BAR __builtin_amdgcn_s_barrier()
#define PG8_SCHED __builtin_amdgcn_sched_barrier(0)
    Unit cur, nxt; int ui = 0;
    if (!S.next(0, cur)) return;
    f32x4 acc[2][2][4][2];
#pragma unroll
    for (int a = 0; a < 2; ++a)
#pragma unroll
        for (int b = 0; b < 2; ++b)
#pragma unroll
            for (int m = 0; m < 4; ++m)
#pragma unroll
                for (int n = 0; n < 2; ++n) acc[a][b][m][n] = (f32x4){0.f, 0.f, 0.f, 0.f};
    bf16x8 At[4][2], B0[2][2], B1[2][2];
    const char* cA = (const char*)g.A + (size_t)cur.pm * tstep; const char* cB = (const char*)g.Bt + (size_t)cur.pn * tstep;
    S.a_ready(cur);
    if constexpr (SP2) {
        PG8_STAGE(PG8_SB(0, 0), cB, voffB); PG8_STAGE(PG8_SB(0, 1), cB + hstep, voffB); PG8_STAGE(PG8_SA(0, 0), cA, voffA); PG8_STAGE(PG8_SA(0, 1), cA + hstep, voffA);
        if (wr == 1) PG8_BAR;
        PG8_WAIT_V(2); PG8_BAR;
        PG8_STAGE(PG8_SB(1, 0), cB + kstep, voffB); PG8_STAGE(PG8_SA(1, 0), cA + kstep, voffA); PG8_STAGE(PG8_SB(1, 1), cB + hstep + kstep, voffB);
        PG8_WAIT_V(6); PG8_BAR;
    } else {
        PG8_STAGE(PG8_SB(0, 0), cB, voffB); PG8_STAGE(PG8_SA(0, 0), cA, voffA); PG8_STAGE(PG8_SB(0, 1), cB + hstep, voffB); PG8_STAGE(PG8_SA(0, 1), cA + hstep, voffA);
        if (wr == 1) PG8_BAR;
        PG8_WAIT_V(4); PG8_BAR;
        PG8_STAGE(PG8_SB(1, 0), cB + kstep, voffB); PG8_STAGE(PG8_SA(1, 0), cA + kstep, voffA); PG8_STAGE(PG8_SB(1, 1), cB + hstep + kstep, voffB);
        PG8_WAIT_V(6); PG8_BAR;
    }
    for (;;) {
        const bool has_next = S.next(ui + 1, nxt);
        const char* nA = has_next ? (const char*)g.A + (size_t)nxt.pm * tstep : cA; const char* nB = has_next ? (const char*)g.Bt + (size_t)nxt.pn * tstep : cB;
        for (int t = 0; t < nt; t += 2) {
            const bool last = (t == nt - 2);
            const char* a1 = cA + (size_t)(t + 1) * kstep;
            const char* a2 = last ? nA : cA + (size_t)(t + 2) * kstep; const char* b2 = last ? nB : cB + (size_t)(t + 2) * kstep;
            const char* a3 = a2 + kstep; const char* b3 = b2 + kstep;
            if (last && has_next) S.a_ready(nxt);
            if constexpr (SP2) {
            PG8_LDB(B0, 0, 0); PG8_LDB(B1, 0, 1); PG8_SCHED; PG8_LDA(At, 0, 0); PG8_STAGE(PG8_SA(1, 1), a1 + hstep, voffA);
            PG8_WAIT_V(8); PG8_WAIT_L(0); PG8_BAR; PG8_MMA(0, 0, At, B0); PG8_MMA(0, 1, At, B1); PG8_BAR; PG8_SCHED;
            PG8_LDA(At, 0, 1); PG8_STAGE(PG8_SB(0, 0), b2, voffB); PG8_STAGE(PG8_SB(0, 1), b2 + hstep, voffB); PG8_STAGE(PG8_SA(0, 0), a2, voffA);
            PG8_WAIT_V(8); PG8_WAIT_L(0); PG8_BAR; PG8_MMA(1, 0, At, B0); PG8_MMA(1, 1, At, B1); PG8_BAR; PG8_SCHED;
            PG8_LDB(B0, 1, 0); PG8_LDB(B1, 1, 1); PG8_SCHED; PG8_LDA(At, 1, 0); PG8_STAGE(PG8_SA(0, 1), a2 + hstep, voffA);
            PG8_WAIT_V(8); PG8_WAIT_L(0); PG8_BAR; PG8_MMA(0, 0, At, B0); PG8_MMA(0, 1, At, B1); PG8_BAR; PG8_SCHED;
            PG8_LDA(At, 1, 1); PG8_STAGE(PG8_SB(1, 0), b3, voffB); PG8_STAGE(PG8_SB(1, 1), b3 + hstep, voffB); PG8_STAGE(PG8_SA(1, 0), a3, voffA);
            PG8_WAIT_V(8); PG8_WAIT_L(0); PG8_BAR; PG8_MMA(1, 0, At, B0); PG8_MMA(1, 1, At, B1); PG8_BAR; PG8_SCHED;
            } else {
            PG8_LDB(B0, 0, 0); PG8_SCHED; PG8_LDA(At, 0, 0); PG8_STAGE(PG8_SA(1, 1), a1 + hstep, voffA);
            PG8_WAIT_L(8); PG8_BAR; PG8_WAIT_L(0); PG8_MMA(0, 0, At, B0); PG8_BAR; PG8_SCHED;
            PG8_LDB(B1, 0, 1); PG8_STAGE(PG8_SB(0, 0), b2, voffB);
            PG8_BAR; PG8_WAIT_L(0); PG8_MMA(0, 1, At, B1); PG8_BAR;
            PG8_LDA(At, 0, 1); PG8_STAGE(PG8_SA(0, 0), a2, voffA);
            PG8_BAR; PG8_WAIT_L(0); PG8_MMA(1, 0, At, B0); PG8_BAR; PG8_SCHED;
            PG8_STAGE(PG8_SB(0, 1), b2 + hstep, voffB);
            PG8_WAIT_V(6); PG8_BAR; PG8_MMA(1, 1, At, B1); PG8_BAR;
            PG8_LDB(B0, 1, 0); PG8_SCHED; PG8_LDA(At, 1, 0); PG8_STAGE(PG8_SA(0, 1), a2 + hstep, voffA);
            PG8_WAIT_L(8); PG8_BAR; PG8_WAIT_L(0); PG8_MMA(0, 0, At, B0); PG8_BAR; PG8_SCHED;
            PG8_LDB(B1, 1, 1); PG8_STAGE(PG8_SB(1, 0), b3, voffB);
            PG8_BAR; PG8_WAIT_L(0); PG8_MMA(0, 1, At, B1); PG8_BAR;
            PG8_LDA(At, 1, 1); PG8_STAGE(PG8_SA(1, 0), a3, voffA);
            PG8_BAR; PG8_WAIT_L(0); PG8_MMA(1, 0, At, B0); PG8_BAR; PG8_SCHED;
            PG8_STAGE(PG8_SB(1, 1), b3 + hstep, voffB);
            PG8_WAIT_V(6); PG8_BAR; PG8_MMA(1, 1, At, B1); PG8_BAR;
            }
        }
        if constexpr (ALIGN_EPI) { if (wr == 0) PG8_BAR; }
        if constexpr (!Epi::AFTER_DRAIN) { E(acc, cur, wr, wc, fr, fq); S.done(cur); }
        if (!has_next) break;
#pragma unroll
        for (int a = 0; a < 2; ++a)
#pragma unroll
            for (int b = 0; b < 2; ++b)
#pragma unroll
                for (int m = 0; m < 4; ++m)
#pragma unroll
                    for (int n = 0; n < 2; ++n) acc[a][b][m][n] = (f32x4){0.f, 0.f, 0.f, 0.f};
        cur = nxt; cA = nA; cB = nB; ++ui;
        if constexpr (ALIGN_EPI) { if (wr == 1) PG8_BAR; }
    }
    PG8_WAIT_V(0);
    if constexpr (!ALIGN_EPI) { if (wr == 0) PG8_BAR; }
    PG8_BAR;
    if constexpr (Epi::AFTER_DRAIN) { E.fused(acc, cur, wr, wc, fr, fq, lds, wid, lane); S.done(cur); }
#undef PG8_SA
#undef PG8_SB
#undef PG8_STAGE
#undef PG8_LDA
#undef PG8_LDB
#undef PG8_MMA
#undef PG8_WAIT_V
#undef PG8_WAIT_L
#undef PG8_BAR
#undef PG8_SCHED
}
}

constexpr int DM = 4096, BATCH = 4, SEQ = 2048, DEPTH = 2, MROWS = BATCH * SEQ;
constexpr int HD = 128, D_RG = 1024, D_NSA = 2048, D_HG = 1024;
constexpr int NIN = 11824, NPAD = 12032;
constexpr int NHEADS = 16, NKV = 2, NGRP = 8;
constexpr int NCMP = 127, NSEL = 32, TOPN = 16, WINDOW = 512;
constexpr int PC_RGX = 0, PC_RGG = 1024, PC_Q = 2048, PC_KVC = 4096, PC_KVS = 4608, PC_KVW = 5120, PC_NSAG = 5632,
              PC_HGQ = 7680, PC_HGF = 8704, PC_HGI = 9728, PC_HGG = 10752, PC_GL = 11776;
constexpr float LN_EPS = 1e-5f, RMS_EPS = 1e-6f, ALPHA = 1.41421356237309515f;
constexpr float SM_SCALE = 0.088388347648318440f;
constexpr float LOG2E = 1.4426950408889634f;

constexpr size_t MiB = 1u << 20;
constexpr size_t WS_CTL = 0, CTL_ZERO_BYTES = 1 * MiB;
constexpr size_t WS_WIN  = 2 * MiB;
constexpr size_t WS_WOUT = 190 * MiB;
constexpr size_t WS_W1T  = 254 * MiB;
constexpr size_t WS_W2T  = 262 * MiB;
constexpr size_t WS_RGW  = 263 * MiB;
constexpr size_t WS_MOD  = 264 * MiB;
constexpr size_t WS_U    = 266 * MiB;
constexpr size_t WS_P    = 330 * MiB;
constexpr size_t WS_XRES = 518 * MiB;
constexpr size_t WS_V    = 646 * MiB;
constexpr size_t WS_YCAT = 774 * MiB;
constexpr size_t WS_OACC = 838 * MiB;
constexpr size_t WS_HS   = 902 * MiB;
constexpr size_t WS_HDEC = 966 * MiB;
constexpr size_t WS_RGSA = 967 * MiB;
constexpr size_t WS_RGSH = 967 * MiB + 512 * 1024;
constexpr size_t WS_RGC  = 968 * MiB;
constexpr size_t WS_KCMP = 969 * MiB;
constexpr size_t WS_VCMP = 969 * MiB + 256 * 1024;
constexpr size_t WS_SEL  = 970 * MiB;
constexpr size_t WS_END  = 972 * MiB;

constexpr int CW_TMO = 0;
constexpr int CW_BAR = 4096;
constexpr int CW_Q = 8192;

constexpr int RING_BYTES = 131072;
constexpr int LDSCTL_OFF = 143360, MISC_OFF = LDSCTL_OFF + 320;
constexpr int LDS_BYTES = 147456;
constexpr int NWAVES = 8;

#define GAS __attribute__((address_space(1)))
#define LAS __attribute__((address_space(3)))
typedef unsigned short bf16;
typedef unsigned v4u __attribute__((ext_vector_type(4)));
typedef unsigned v2u __attribute__((ext_vector_type(2)));
typedef float f32x4 __attribute__((ext_vector_type(4)));
typedef float f32x16 __attribute__((ext_vector_type(16)));
typedef short bf16x8 __attribute__((ext_vector_type(8)));
typedef short s16x4 __attribute__((ext_vector_type(4)));
typedef GAS unsigned gu32;
#define RLX_AGENT __ATOMIC_RELAXED, __HIP_MEMORY_SCOPE_AGENT
#define LDS_WAIT() asm volatile("s_waitcnt lgkmcnt(0)" ::: "memory")
#define VM_WAIT() asm volatile("s_waitcnt vmcnt(0)" ::: "memory")
#define SBAR() __builtin_amdgcn_sched_barrier(0)
__device__ __forceinline__ unsigned f2bf(float f) { unsigned u = __builtin_bit_cast(unsigned, f); return (u + 0x7fffu + ((u >> 16) & 1u)) >> 16; }
__device__ __forceinline__ unsigned pk2(float lo, float hi) { return f2bf(lo) | (f2bf(hi) << 16); }
__device__ __forceinline__ float bf2f(unsigned h) { return __builtin_bit_cast(float, h << 16); }
__device__ __forceinline__ float bflo(unsigned w) { return __builtin_bit_cast(float, w << 16); }
__device__ __forceinline__ float bfhi(unsigned w) { return __builtin_bit_cast(float, w & 0xffff0000u); }
__device__ __forceinline__ float sigm(float x) { return 1.0f / (1.0f + __expf(-x)); }
__device__ __forceinline__ float silu(float x) { return x / (1.0f + __expf(-x)); }
__device__ __forceinline__ int crow(int r, int hi) { return (r & 3) + 8 * (r >> 2) + 4 * hi; }
__device__ __forceinline__ unsigned cvtpk(float lo, float hi) { unsigned r; asm volatile("v_cvt_pk_bf16_f32 %0, %1, %2" : "=v"(r) : "v"(lo), "v"(hi)); return r; }
__device__ __forceinline__ float wave_sum(float v) {
#pragma unroll
    for (int o = 1; o < 64; o <<= 1) v += __shfl_xor(v, o);
    return v;
}
#define XB_TMO      128
#define XB_XCNT(j)  (256  + 64 * (j))
#define XB_XSUB(j)  (1280 + 64 * (j))
#define XB_XGEN(j)  (2304 + 64 * (j))
#define XB_TOP      3328
#define XB_TOPGEN   3392
#define XCD_BAR_WORDS 3456
#define XB_SPIN_CAP (1u << 18)

__device__ __forceinline__ unsigned xb_ld(unsigned* p)              { return __hip_atomic_load(p, __ATOMIC_RELAXED, __HIP_MEMORY_SCOPE_AGENT); }
__device__ __forceinline__ unsigned xb_add(unsigned* p, unsigned v) { return __hip_atomic_fetch_add(p, v, __ATOMIC_RELAXED, __HIP_MEMORY_SCOPE_AGENT); }
__device__ __forceinline__ unsigned xb_xcc_id() { return (unsigned)__builtin_amdgcn_s_getreg((3 << 11) | 20) & 0xFu; }
#define XB_SPIN(cond, bar) do { unsigned _sp = 0; while (cond) { __builtin_amdgcn_s_sleep(1); \
    if ((++_sp & 255u) == 0u) { if (xb_ld(&(bar)[XB_TMO])) break; if (_sp > XB_SPIN_CAP) { atomicAdd(&(bar)[XB_TMO], 1u); break; } } } } while (0)

struct XcdBarrier {
    unsigned* bar; unsigned x;
    volatile LAS unsigned* st;
};

__device__ __forceinline__ XcdBarrier xcd_barrier_post(unsigned* bar, volatile LAS unsigned* st) {
    XcdBarrier b; b.bar = bar; b.x = xb_xcc_id(); b.st = st;
    if (threadIdx.x == 0) (void)xb_add(&bar[XB_XCNT(b.x)], 1u);
    return b;
}
__device__ __forceinline__ void xcd_barrier_complete(unsigned* bar, unsigned x, unsigned& nloc, unsigned& nx) {
    const unsigned G = gridDim.x * gridDim.y * gridDim.z;
    unsigned sum, cnt, mine, sp = 0u;
    for (;;) {
        sum = 0u; cnt = 0u; mine = 0u;
#pragma unroll 1
        for (unsigned j = 0; j < 16; ++j) { const unsigned c = xb_ld(&bar[XB_XCNT(j)]); sum += c; cnt += (c > 0u) ? 1u : 0u; mine = (j == x) ? c : mine; }
        if (sum == G) break;
        __builtin_amdgcn_s_sleep(1);
        if ((++sp & 255u) == 0u) { if (xb_ld(&bar[XB_TMO])) break; if (sp > XB_SPIN_CAP) { atomicAdd(&bar[XB_TMO], 1u); break; } }
    }
    nloc = mine > 0u ? mine : 1u; nx = cnt > 0u ? cnt : 1u;
}

__device__ __forceinline__ void xcd_barrier(const XcdBarrier& b) {
    asm volatile("s_waitcnt vmcnt(0)" ::: "memory");
    __syncthreads();
    if (threadIdx.x == 0) {
        unsigned* bar = b.bar;
        __builtin_amdgcn_s_waitcnt(0);
        unsigned nloc = b.st[0], nx = b.st[1];
        if (nloc == 0u) { xcd_barrier_complete(bar, b.x, nloc, nx); b.st[0] = nloc; b.st[1] = nx; }
        const unsigned old = xb_add(&bar[XB_XSUB(b.x)], 1u);
        const unsigned gen = old / nloc;
        if (old + 1u == (gen + 1u) * nloc) {
            __builtin_amdgcn_fence(__ATOMIC_RELEASE, "agent");
            asm volatile("s_waitcnt vmcnt(0)" ::: "memory");
            const unsigned og = xb_add(&bar[XB_TOP], 1u);
            const unsigned tg = og / nx;
            if (og + 1u == (tg + 1u) * nx) xb_add(&bar[XB_TOPGEN], 1u);
            else XB_SPIN(xb_ld(&bar[XB_TOPGEN]) == tg, bar);
            __builtin_amdgcn_fence(__ATOMIC_ACQUIRE, "agent");
            xb_add(&bar[XB_XGEN(b.x)], 1u);
            asm volatile("s_waitcnt vmcnt(0)" ::: "memory");
        } else {
            XB_SPIN(xb_ld(&bar[XB_XGEN(b.x)]) == gen, bar);
            __builtin_amdgcn_fence(__ATOMIC_ACQUIRE, "agent");
            asm volatile("s_waitcnt vmcnt(0)" ::: "memory");
        }
    }
    __syncthreads();
}

struct Frame {
    LAS unsigned char* lds;
    volatile LAS unsigned* MISC;
    gu32* ctl;
    int tid, lane, wave, vcu, G;
    unsigned char* ws; float* out;
    const float* const* in;
};
__device__ __forceinline__ bf16* ws_bf(const Frame& F, size_t off) { return (bf16*)(F.ws + off); }
__device__ __forceinline__ float* ws_f(const Frame& F, size_t off) { return (float*)(F.ws + off); }

__device__ __forceinline__ int launder_u(int v) { asm volatile("" : "+v"(v)); return __builtin_amdgcn_readfirstlane(v); }
template <class T> __device__ __forceinline__ T* launder_p(T* p) { const unsigned long long a = (unsigned long long)p;
    const unsigned lo = (unsigned)launder_u((int)(unsigned)a), hi = (unsigned)launder_u((int)(unsigned)(a >> 32)); return (T*)(((unsigned long long)hi << 32) | lo); }
__device__ __forceinline__ void launder(Frame& F) {
    F.ws = launder_p(F.ws); F.out = launder_p(F.out); F.ctl = (gu32*)launder_p((unsigned*)F.ctl);
    F.G = launder_u(F.G); F.vcu = launder_u(F.vcu);
    { const unsigned lb = (unsigned)launder_u((int)(unsigned)(uintptr_t)F.lds); F.lds = (LAS unsigned char*)(uintptr_t)lb; F.MISC = (volatile LAS unsigned*)(F.lds + MISC_OFF); }
    { int t = threadIdx.x; asm volatile("" : "+v"(t)); F.tid = t; F.lane = t & 63; F.wave = __builtin_amdgcn_readfirstlane(t >> 6); }
}

__device__ __forceinline__ int q_next(Frame& F, int qid) {
    __syncthreads();
    if (F.tid == 0) F.MISC[0] = __hip_atomic_fetch_add(F.ctl + CW_Q + 64 * qid, 1u, RLX_AGENT);
    __syncthreads();
    return (int)F.MISC[0];
}

__device__ __forceinline__ int win_src_col(int np) { return np < 5632 ? np : (np < 11776 ? np + 48 : (np < 11824 ? np - 11776 + 5632 : -1)); }
template <int MODE>
__device__ __forceinline__ void transpose_item(const float* W, int K, int N, bf16* WT, LAS float* scr, int kb, int nb, int lane) {
    const int k0 = 64 * kb, n0 = 64 * nb, rr = lane >> 4, cq = lane & 15;
    int nsrc = n0 + 4 * cq; if (MODE == 1) nsrc = win_src_col(nsrc);
    const float* src = W + (size_t)(k0 + rr) * N + (nsrc >= 0 ? nsrc : 0);
    f32x4 v[16];
#pragma unroll
    for (int i = 0; i < 16; ++i) v[i] = (nsrc >= 0) ? *(const GAS f32x4*)(src + (size_t)(4 * i) * N) : (f32x4){0.f, 0.f, 0.f, 0.f};
#pragma unroll
    for (int i = 0; i < 16; ++i) { LAS float* d = scr + (4 * i + rr) * 65 + 4 * cq; d[0] = v[i][0]; d[1] = v[i][1]; d[2] = v[i][2]; d[3] = v[i][3]; }
    LDS_WAIT(); asm volatile("" ::: "memory");
    const int c = lane & 7;
#pragma unroll
    for (int j = 0; j < 8; ++j) { const int n = (lane >> 3) + 8 * j; const LAS float* s = scr + (8 * c) * 65 + n;
        v4u o; o.x = pk2(s[0 * 65], s[1 * 65]); o.y = pk2(s[2 * 65], s[3 * 65]); o.z = pk2(s[4 * 65], s[5 * 65]); o.w = pk2(s[6 * 65], s[7 * 65]);
        *(GAS v4u*)(WT + (size_t)(n0 + n) * K + k0 + 8 * c) = o; }
    LDS_WAIT(); asm volatile("" ::: "memory");
}

__device__ __forceinline__ void ada_item(Frame& F, int item) {
    const int l = item / 384, n0 = (item % 384) * 32;
    const float* W = F.in[2] + (size_t)l * DM * 12288;
    const LAS float* cl = (const LAS float*)F.lds;
    LAS float* red = (LAS float*)(F.lds + 65536);
    const int kq = F.lane >> 3, nq = F.lane & 7;
    f32x4 acc[4];
#pragma unroll
    for (int b = 0; b < 4; ++b) acc[b] = (f32x4){0.f, 0.f, 0.f, 0.f};
#pragma unroll 8
    for (int i = 0; i < 64; ++i) {
        const int k = 64 * i + 8 * F.wave + kq;
        const f32x4 w = *(const GAS f32x4*)(W + (size_t)k * 12288 + n0 + 4 * nq);
#pragma unroll
        for (int b = 0; b < 4; ++b) acc[b] += w * cl[b * DM + k];
    }
#pragma unroll
    for (int b = 0; b < 4; ++b)
#pragma unroll
        for (int e = 0; e < 4; ++e) { float v = acc[b][e]; v += __shfl_xor(v, 8); v += __shfl_xor(v, 16); v += __shfl_xor(v, 32);
            if (kq == 0) red[(F.wave * 4 + b) * 32 + 4 * nq + e] = v; }
    __syncthreads();
    if (F.tid < 128) { const int b = F.tid >> 5, n = F.tid & 31; float s = 0.f;
#pragma unroll
        for (int w = 0; w < 8; ++w) s += red[(w * 4 + b) * 32 + n];
        ws_f(F, WS_MOD)[(size_t)(l * 4 + b) * 12288 + n0 + n] = s + F.in[3][l * 12288 + n0 + n]; }
    __syncthreads();
}

__device__ __forceinline__ void p0_prologue(Frame& F) {
    { LAS float* cl = (LAS float*)F.lds;
      for (int i = F.tid; i < 4 * DM / 4; i += NWAVES * 64) ((LAS f32x4*)cl)[i] = ((const GAS f32x4*)F.in[1])[i];
      __syncthreads();
      for (int it = F.vcu; it < 768; it += F.G) ada_item(F, it);
      __syncthreads(); }
    LAS float* scr = (LAS float*)(F.lds + F.wave * 16640);
    const int gw = F.vcu * NWAVES + F.wave, NGW = F.G * NWAVES;
    constexpr int I_WIN = 64 * (NPAD / 64), I_WOUT = 64 * (DM / 64), I_W1 = 64 * 4, I_W2 = 4 * 2, I_RG = 2 * 2;
    constexpr int NIT = 2 * I_WIN + 2 * I_WOUT + 4 * I_W1 + 4 * I_W2 + 32 * I_RG;
    for (int it = gw; it < NIT; it += NGW) {
        int r = it;
        if (r < 2 * I_WIN) { const int l = r / I_WIN; r -= l * I_WIN; const int nblk = NPAD / 64;
            transpose_item<1>(F.in[4] + (size_t)l * DM * NIN, DM, NIN, ws_bf(F, WS_WIN) + (size_t)l * NPAD * DM, scr, r / nblk, r % nblk, F.lane); continue; }
        r -= 2 * I_WIN;
        if (r < 2 * I_WOUT) { const int l = r / I_WOUT; r -= l * I_WOUT; const int nblk = DM / 64;
            transpose_item<0>(F.in[20] + (size_t)l * DM * DM, DM, DM, ws_bf(F, WS_WOUT) + (size_t)l * DM * DM, scr, r / nblk, r % nblk, F.lane); continue; }
        r -= 2 * I_WOUT;
        if (r < 4 * I_W1) { const int lk = r / I_W1; r -= lk * I_W1; const int l = lk >> 1, kv = lk & 1;
            transpose_item<0>((kv ? F.in[16] : F.in[14]) + (size_t)l * 4096 * 256, 4096, 256, ws_bf(F, WS_W1T) + (size_t)lk * 256 * 4096, scr, r / 4, r % 4, F.lane); continue; }
        r -= 4 * I_W1;
        if (r < 4 * I_W2) { const int lk = r / I_W2; r -= lk * I_W2; const int l = lk >> 1, kv = lk & 1;
            transpose_item<0>((kv ? F.in[17] : F.in[15]) + (size_t)l * 256 * 128, 256, 128, ws_bf(F, WS_W2T) + (size_t)lk * 128 * 256, scr, r / 2, r % 2, F.lane); continue; }
        r -= 4 * I_W2;
        { const int mi = r / I_RG; r -= mi * I_RG; const int l = mi >> 4, gate = (mi >> 3) & 1, n = mi & 7;
            transpose_item<0>((gate ? F.in[9] : F.in[7]) + (size_t)(l * 8 + n) * 128 * 128, 128, 128, ws_bf(F, WS_RGW) + (size_t)mi * 128 * 128, scr, r / 2, r % 2, F.lane); }
    }
    { const int g = F.vcu * NWAVES * 64 + F.tid;
      if (g < 2 * 8 * 128 / 2) { const int kv = g >> 9, rest = g & 511, bg = rest >> 6, e = rest & 63;
          ((unsigned*)(F.ws + (kv ? WS_VCMP : WS_KCMP)))[(size_t)(bg * 128 + 127) * 64 + e] = 0u; } }
}

__device__ __forceinline__ void p1_u0(Frame& F) {
    const int gw = F.vcu * NWAVES + F.wave, NGW = F.G * NWAVES;
    const float* mod = ws_f(F, WS_MOD);
    bf16* U = ws_bf(F, WS_U);
    for (int m = gw; m < MROWS; m += NGW) {
        const int b = m / SEQ;
        const GAS f32x4* xr = (const GAS f32x4*)(F.in[0] + (size_t)m * DM);
        const GAS f32x4* sh = (const GAS f32x4*)(mod + (size_t)b * 12288);
        const GAS f32x4* sc = (const GAS f32x4*)(mod + (size_t)b * 12288 + DM);
        GAS v2u* o = (GAS v2u*)(U + (size_t)m * DM);
#pragma unroll 4
        for (int j = 0; j < 16; ++j) { const int idx = 64 * j + F.lane; const f32x4 v = xr[idx] * (sc[idx] + 1.0f) + sh[idx];
            v2u w; w.x = pk2(v[0], v[1]); w.y = pk2(v[2], v[3]); o[idx] = w; }
    }
}

__device__ __forceinline__ void ln_phase(Frame& F, int l, float* xout, bool unext) {
    const int gw = F.vcu * NWAVES + F.wave, NGW = F.G * NWAVES;
    const float* Vb = ws_f(F, WS_V);
    const float* mod = ws_f(F, WS_MOD) + (size_t)(l + 1) * 4 * 12288;
    bf16* U = ws_bf(F, WS_U);
    const GAS f32x4* g4 = (const GAS f32x4*)(F.in[21] + (size_t)l * DM);
    const GAS f32x4* b4 = (const GAS f32x4*)(F.in[22] + (size_t)l * DM);
    for (int m = gw; m < MROWS; m += NGW) {
        const int b = m / SEQ;
        const GAS f32x4* vr = (const GAS f32x4*)(Vb + (size_t)m * DM);
        f32x4 v[16]; float s = 0.f;
#pragma unroll
        for (int j = 0; j < 16; ++j) { v[j] = vr[64 * j + F.lane]; s += (v[j][0] + v[j][1]) + (v[j][2] + v[j][3]); }
        const float mean = wave_sum(s) * (1.0f / DM); float s2 = 0.f;
#pragma unroll
        for (int j = 0; j < 16; ++j) { v[j] = v[j] - mean; s2 += (v[j][0] * v[j][0] + v[j][1] * v[j][1]) + (v[j][2] * v[j][2] + v[j][3] * v[j][3]); }
        const float rstd = 1.0f / sqrtf(wave_sum(s2) * (1.0f / DM) + LN_EPS);
        GAS f32x4* xo = (GAS f32x4*)(xout + (size_t)m * DM);
        if (unext) {
            const GAS f32x4* sh = (const GAS f32x4*)(mod + (size_t)b * 12288);
            const GAS f32x4* sc = (const GAS f32x4*)(mod + (size_t)b * 12288 + DM);
            GAS v2u* o = (GAS v2u*)(U + (size_t)m * DM);
#pragma unroll
            for (int j = 0; j < 16; ++j) { const int idx = 64 * j + F.lane; const f32x4 y = v[j] * rstd * g4[idx] + b4[idx]; xo[idx] = y;
                const f32x4 u = y * (sc[idx] + 1.0f) + sh[idx]; v2u w; w.x = pk2(u[0], u[1]); w.y = pk2(u[2], u[3]); o[idx] = w; }
        } else {
#pragma unroll
            for (int j = 0; j < 16; ++j) { const int idx = 64 * j + F.lane; xo[idx] = v[j] * rstd * g4[idx] + b4[idx]; }
        }
    }
}

__device__ __forceinline__ f32x16 mfma32(bf16x8 a, bf16x8 b, f32x16 c) { return __builtin_amdgcn_mfma_f32_32x32x16_bf16(a, b, c, 0, 0, 0); }
__device__ __forceinline__ f32x4 mfma16(bf16x8 a, bf16x8 b, f32x4 c) { return __builtin_amdgcn_mfma_f32_16x16x32_bf16(a, b, c, 0, 0, 0); }
__device__ __forceinline__ bf16x8 as_bf16x8(v4u w) { return __builtin_bit_cast(bf16x8, w); }

template <int PASS>
__device__ __forceinline__ void rg_item(Frame& F, int l, int item) {
    const int n = item & 7, c = (item >> 3) & 31, b = item >> 8;
    LAS float* xcf = (LAS float*)(F.lds);
    LAS bf16*  xcb = (LAS bf16*)(F.lds + 32768);
    LAS float* aL  = (LAS float*)(F.lds + 50176);
    LAS float* bxL = (LAS float*)(F.lds + 82944);
    LAS float* qs  = (LAS float*)(F.lds + 115712);
    const bf16* P = ws_bf(F, WS_P);
    const int d = F.tid & 127, tq = F.tid >> 7, ch = n * 128 + d;
    const size_t rowbase = (size_t)b * SEQ + 64 * c;
    {
        const float w0 = F.in[5][(l * 4 + 0) * 1024 + ch], w1 = F.in[5][(l * 4 + 1) * 1024 + ch], w2 = F.in[5][(l * 4 + 2) * 1024 + ch],
                    w3 = F.in[5][(l * 4 + 3) * 1024 + ch], cb = F.in[6][l * 1024 + ch];
        float xv[19];
#pragma unroll
        for (int i = 0; i < 19; ++i) { const int tl = 64 * c + 16 * tq - 3 + i; xv[i] = (tl >= 0) ? bf2f(P[((size_t)b * SEQ + tl) * NPAD + PC_RGX + ch]) : 0.f; }
#pragma unroll
        for (int i = 0; i < 16; ++i) { const float y = cb + w0 * xv[i] + w1 * xv[i + 1] + w2 * xv[i + 2] + w3 * xv[i + 3]; const int t = 16 * tq + i;
            xcf[t * 128 + d] = y; xcb[t * 136 + d] = (bf16)f2bf(y); }
    }
    __syncthreads();
    {
        const int rt = F.wave & 1, ct = F.wave >> 1, r32 = F.lane & 31, hi = F.lane >> 5;
        const bf16* WA = ws_bf(F, WS_RGW) + (size_t)((l * 2 + 0) * 8 + n) * 16384;
        const bf16* WX = ws_bf(F, WS_RGW) + (size_t)((l * 2 + 1) * 8 + n) * 16384;
        f32x16 ga = {}, gx = {};
#pragma unroll
        for (int s = 0; s < 8; ++s) {
            const bf16x8 a = *(const LAS bf16x8*)(xcb + (32 * rt + r32) * 136 + 16 * s + 8 * hi);
            const bf16x8 wa = *(const GAS bf16x8*)(WA + (32 * ct + r32) * 128 + 16 * s + 8 * hi);
            const bf16x8 wx = *(const GAS bf16x8*)(WX + (32 * ct + r32) * 128 + 16 * s + 8 * hi);
            ga = mfma32(a, wa, ga); gx = mfma32(a, wx, gx);
        }
        const int e = 32 * ct + r32, che = n * 128 + e;
        const float ba_ = F.in[8][l * 1024 + che], bx_ = F.in[10][l * 1024 + che], lam = F.in[11][l * 1024 + che];
        const float sp8 = 8.0f * log1pf(__expf(-lam));
#pragma unroll
        for (int r = 0; r < 16; ++r) { const int t = 32 * rt + crow(r, hi);
            const float rg = sigm(ga[r] + ba_), ig = sigm(gx[r] + bx_);
            const float la = -sp8 * rg; const float a = __expf(la); float mult = sqrtf(-expm1f(2.0f * la)); if (c == 0 && t == 0) mult = 1.0f;
            aL[t * 128 + e] = a; bxL[t * 128 + e] = mult * ig * xcf[t * 128 + e]; }
    }
    __syncthreads();
    {
        float av[16], bv[16];
#pragma unroll
        for (int i = 0; i < 16; ++i) { av[i] = aL[(16 * tq + i) * 128 + d]; bv[i] = bxL[(16 * tq + i) * 128 + d]; }
        float Ap = 1.0f, H = 0.f;
#pragma unroll
        for (int i = 0; i < 16; ++i) { H = av[i] * H + bv[i]; Ap *= av[i]; }
        qs[(tq * 128 + d) * 2 + 0] = Ap; qs[(tq * 128 + d) * 2 + 1] = H;
        __syncthreads();
        float hin = 0.f, atot = 1.0f;
        if (PASS == 3) hin = ws_f(F, WS_RGC)[(size_t)(b * 32 + c) * 1024 + ch];
        for (int q = 0; q < tq; ++q) { const float aq = qs[(q * 128 + d) * 2], hq = qs[(q * 128 + d) * 2 + 1]; hin = aq * hin + hq; atot *= aq; }
        if (PASS == 1) {
            if (tq == 3) { ws_f(F, WS_RGSA)[(size_t)(b * 32 + c) * 1024 + ch] = atot * Ap; ws_f(F, WS_RGSH)[(size_t)(b * 32 + c) * 1024 + ch] = Ap * hin + H; }
        } else {
            bf16* Y = ws_bf(F, WS_YCAT);
            float h = hin;
#pragma unroll
            for (int i = 0; i < 16; ++i) { h = av[i] * h + bv[i]; const size_t row = rowbase + 16 * tq + i;
                const float gt = bf2f(P[row * NPAD + PC_RGG + ch]);
                Y[row * DM + ch] = (bf16)f2bf(h * silu(gt)); }
        }
    }
    __syncthreads();
}
__device__ __forceinline__ void rg_pass2(Frame& F) {
    const int g = F.vcu * NWAVES * 64 + F.tid;
    if (g < BATCH * D_RG) { const int b = g >> 10, ch = g & 1023; float h = 0.f;
        const float* A = ws_f(F, WS_RGSA); const float* Hh = ws_f(F, WS_RGSH); float* C = ws_f(F, WS_RGC);
#pragma unroll 8
        for (int c = 0; c < 32; ++c) { const size_t idx = (size_t)(b * 32 + c) * 1024 + ch; C[idx] = h; h = A[idx] * h + Hh[idx]; } }
}

__device__ __forceinline__ float hg_lower_bound(const Frame& F, int l, int ch) {
    if (l == 0) return 0.f;
    return 1.0f / (1.0f + __expf(F.in[18][ch] - F.in[18][1024 + ch]));
}
__device__ __forceinline__ void hg_fk(float z, float lb, int l, float& lf, float& kk) {
    if (l == 0) { lf = fminf(z, 0.f) - log1pf(__expf(-fabsf(z))); kk = sigm(-z); }
    else { const float sg = sigm(z); lf = __logf(lb + (1.0f - lb) * sg); kk = (1.0f - lb) * sigm(-z); }
}
__device__ __forceinline__ void hg1_item(Frame& F, int l, int item) {
    const int c = item & 31, bh = item >> 5, b = bh >> 3, h = bh & 7;
    LAS float* part = (LAS float*)(F.lds);
    LAS bf16* kdT = (LAS bf16*)(F.lds + 2048);
    LAS bf16* vT  = (LAS bf16*)(F.lds + 2048 + 18432);
    const bf16* P = ws_bf(F, WS_P);
    const int k = F.tid & 127, tq = F.tid >> 7, ch = h * 128 + k;
    const size_t row0 = (size_t)b * SEQ + 64 * c + 16 * tq;
    const float lb = hg_lower_bound(F, l, ch);
    float lf[16], kk[16]; float ps = 0.f;
#pragma unroll
    for (int i = 0; i < 16; ++i) { const float z = bf2f(P[(row0 + i) * NPAD + PC_HGF + ch]); hg_fk(z, lb, l, lf[i], kk[i]); ps += lf[i]; }
    part[tq * 128 + k] = ps;
    unsigned vv[8];
#pragma unroll
    for (int i = 0; i < 8; ++i) { const unsigned lo = P[(row0 + 2 * i) * NPAD + PC_HGI + ch], hi2 = P[(row0 + 2 * i + 1) * NPAD + PC_HGI + ch]; vv[i] = lo | (hi2 << 16); }
    *(LAS v4u*)(vT + k * 72 + 16 * tq) = (v4u){vv[0], vv[1], vv[2], vv[3]};
    *(LAS v4u*)(vT + k * 72 + 16 * tq + 8) = (v4u){vv[4], vv[5], vv[6], vv[7]};
    __syncthreads();
    {
        float off = 0.f, tot = 0.f;
#pragma unroll
        for (int q = 0; q < 4; ++q) { const float pq = part[q * 128 + k]; tot += pq; if (q < tq) off += pq; }
        float run = off; unsigned w[8];
#pragma unroll
        for (int i = 0; i < 8; ++i) { run += lf[2 * i]; const float k0 = kk[2 * i] * __expf(tot - run); run += lf[2 * i + 1]; const float k1 = kk[2 * i + 1] * __expf(tot - run); w[i] = pk2(k0, k1); }
        *(LAS v4u*)(kdT + k * 72 + 16 * tq) = (v4u){w[0], w[1], w[2], w[3]};
        *(LAS v4u*)(kdT + k * 72 + 16 * tq + 8) = (v4u){w[4], w[5], w[6], w[7]};
        if (tq == 0) ws_f(F, WS_HDEC)[(size_t)item * 128 + k] = __expf(tot);
    }
    __syncthreads();
    {
        const int vt = F.wave >> 1, kt0 = 2 * (F.wave & 1), r32 = F.lane & 31, hi = F.lane >> 5;
        f32x16 a0 = {}, a1 = {};
#pragma unroll
        for (int s = 0; s < 4; ++s) {
            const bf16x8 a = *(const LAS bf16x8*)(vT + (32 * vt + r32) * 72 + 16 * s + 8 * hi);
            const bf16x8 b0 = *(const LAS bf16x8*)(kdT + (32 * kt0 + r32) * 72 + 16 * s + 8 * hi);
            const bf16x8 b1 = *(const LAS bf16x8*)(kdT + (32 * (kt0 + 1) + r32) * 72 + 16 * s + 8 * hi);
            a0 = mfma32(a, b0, a0); a1 = mfma32(a, b1, a1);
        }
        float* HS = ws_f(F, WS_HS) + (size_t)item * 16384;
#pragma unroll
        for (int r = 0; r < 16; ++r) { const int v = 32 * vt + crow(r, hi); HS[v * 128 + 32 * kt0 + r32] = a0[r]; HS[v * 128 + 32 * kt0 + 32 + r32] = a1[r]; }
    }
    __syncthreads();
}
__device__ __forceinline__ void hg_pass2(Frame& F) {
    float* HS = ws_f(F, WS_HS); const float* DEC = ws_f(F, WS_HDEC);
    for (int g = F.vcu * NWAVES * 64 + F.tid; g < 32 * 4096; g += F.G * NWAVES * 64) {
        const int bh = g >> 12, e4 = g & 4095, k4 = (e4 & 31) * 4;
        f32x4 S = {0.f, 0.f, 0.f, 0.f};
#pragma unroll 8
        for (int c = 0; c < 32; ++c) { GAS f32x4* p = (GAS f32x4*)(HS + ((size_t)(bh * 32 + c) * 16384) + e4 * 4);
            const f32x4 tmp = *p; const f32x4 d4 = *(const GAS f32x4*)(DEC + (size_t)(bh * 32 + c) * 128 + k4); *p = S; S = S * d4 + tmp; }
    }
}
__device__ __forceinline__ void hg3_item(Frame& F, int l, int item) {
    const int c = item & 31, bh = item >> 5, b = bh >> 3, h = bh & 7;
    LAS float* part = (LAS float*)(F.lds);
    LAS bf16* qi   = (LAS bf16*)(F.lds + 2048);
    LAS bf16* qd1  = (LAS bf16*)(F.lds + 19456);
    LAS bf16* kd00 = (LAS bf16*)(F.lds + 28160);
    LAS bf16* kd10 = (LAS bf16*)(F.lds + 36864);
    LAS bf16* kd11 = (LAS bf16*)(F.lds + 45568);
    LAS bf16* sT   = (LAS bf16*)(F.lds + 54272);
    LAS bf16* vT   = (LAS bf16*)(F.lds + 89088);
    LAS bf16* Abf  = (LAS bf16*)(F.lds + 107520);
    LAS float* ssq = (LAS float*)(F.lds + 116736);
    const bf16* P = ws_bf(F, WS_P);
    const int k = F.tid & 127, tq = F.tid >> 7, ch = h * 128 + k;
    const size_t row0 = (size_t)b * SEQ + 64 * c + 16 * tq;
    const float lb = hg_lower_bound(F, l, ch);
    float lf[16], kk[16], qv[16]; float ps = 0.f;
#pragma unroll
    for (int i = 0; i < 16; ++i) { const float z = bf2f(P[(row0 + i) * NPAD + PC_HGF + ch]); hg_fk(z, lb, l, lf[i], kk[i]); ps += lf[i];
        qv[i] = silu(bf2f(P[(row0 + i) * NPAD + PC_HGQ + ch])); }
    part[tq * 128 + k] = ps;
    {
        unsigned vv[8];
#pragma unroll
        for (int i = 0; i < 8; ++i) { const unsigned lo = P[(row0 + 2 * i) * NPAD + PC_HGI + ch], hi2 = P[(row0 + 2 * i + 1) * NPAD + PC_HGI + ch]; vv[i] = lo | (hi2 << 16); }
        *(LAS v4u*)(vT + k * 72 + 16 * tq) = (v4u){vv[0], vv[1], vv[2], vv[3]};
        *(LAS v4u*)(vT + k * 72 + 16 * tq + 8) = (v4u){vv[4], vv[5], vv[6], vv[7]};
    }
    {
        const int v = F.tid >> 2, k0 = (F.tid & 3) * 32;
        const GAS f32x4* src = (const GAS f32x4*)(ws_f(F, WS_HS) + (size_t)item * 16384 + v * 128 + k0);
#pragma unroll
        for (int j = 0; j < 4; ++j) { const f32x4 x0 = src[2 * j], x1 = src[2 * j + 1];
            *(LAS v4u*)(sT + v * 136 + k0 + 8 * j) = (v4u){pk2(x0[0], x0[1]), pk2(x0[2], x0[3]), pk2(x1[0], x1[1]), pk2(x1[2], x1[3])}; }
    }
    __syncthreads();
    {
        float off = 0.f;
#pragma unroll
        for (int q = 0; q < 4; ++q) { const float pq = part[q * 128 + k]; if (q < tq) off += pq; }
        const float bref1 = part[k] + part[128 + k];
        float run = off;
#pragma unroll
        for (int i = 0; i < 16; ++i) { run += lf[i]; const int t = 16 * tq + i;
            qi[t * 136 + k] = (bf16)f2bf(qv[i] * __expf(run));
            if (tq < 2) { kd00[t * 136 + k] = (bf16)f2bf(kk[i] * __expf(-run)); kd10[t * 136 + k] = (bf16)f2bf(kk[i] * __expf(bref1 - run)); }
            else { qd1[(t - 32) * 136 + k] = (bf16)f2bf(qv[i] * __expf(run - bref1)); kd11[(t - 32) * 136 + k] = (bf16)f2bf(kk[i] * __expf(bref1 - run)); } }
    }
    __syncthreads();
    const int r32 = F.lane & 31, hi = F.lane >> 5;
    if (F.wave < 4) {
        const int I = (F.wave == 0 || F.wave == 3) ? 0 : 1, J = (F.wave == 2 || F.wave == 3) ? 1 : 0;
        f32x16 a = {};
        if (F.wave != 3) {
            const LAS bf16* Aop = (F.wave == 0) ? qi : qd1;
            const LAS bf16* Bop = (F.wave == 0) ? kd00 : (F.wave == 1 ? kd10 : kd11);
#pragma unroll
            for (int s = 0; s < 8; ++s) a = mfma32(*(const LAS bf16x8*)(Aop + r32 * 136 + 16 * s + 8 * hi), *(const LAS bf16x8*)(Bop + r32 * 136 + 16 * s + 8 * hi), a);
        }
#pragma unroll
        for (int r = 0; r < 16; ++r) { const int tt = crow(r, hi); float x = a[r]; if (I == J && r32 > tt) x = 0.f;
            Abf[(32 * I + tt) * 72 + 32 * J + r32] = (bf16)f2bf(x); }
    }
    __syncthreads();
    {
        const int I = F.wave & 1, vt = F.wave >> 1;
        f32x16 o = {};
#pragma unroll
        for (int s = 0; s < 8; ++s) o = mfma32(*(const LAS bf16x8*)(qi + (32 * I + r32) * 136 + 16 * s + 8 * hi), *(const LAS bf16x8*)(sT + (32 * vt + r32) * 136 + 16 * s + 8 * hi), o);
#pragma unroll
        for (int s = 0; s < 4; ++s) if (s < 2 * (I + 1)) o = mfma32(*(const LAS bf16x8*)(Abf + (32 * I + r32) * 72 + 16 * s + 8 * hi), *(const LAS bf16x8*)(vT + (32 * vt + r32) * 72 + 16 * s + 8 * hi), o);
#pragma unroll
        for (int r = 0; r < 16; ++r) { float ss = o[r] * o[r];
            ss += __shfl_xor(ss, 1); ss += __shfl_xor(ss, 2); ss += __shfl_xor(ss, 4); ss += __shfl_xor(ss, 8); ss += __shfl_xor(ss, 16);
            if (r32 == 0) ssq[(32 * I + crow(r, hi)) * 4 + vt] = ss; }
        __syncthreads();
        const int v = 32 * vt + r32; const float ng = F.in[19][l * 128 + v];
        bf16* Y = ws_bf(F, WS_YCAT);
#pragma unroll
        for (int r = 0; r < 16; ++r) { const int t = 32 * I + crow(r, hi);
            const float tot = (ssq[t * 4] + ssq[t * 4 + 1]) + (ssq[t * 4 + 2] + ssq[t * 4 + 3]);
            const float rs = 1.0f / sqrtf(tot * (1.0f / 128.0f) + RMS_EPS);
            const size_t row = (size_t)b * SEQ + 64 * c + t;
            const float gt = silu(bf2f(P[row * NPAD + PC_HGG + h * 128 + v]));
            Y[row * DM + 3072 + h * 128 + v] = (bf16)f2bf(o[r] * rs * ng * gt); }
    }
    __syncthreads();
}

__device__ __forceinline__ void cmp_item(Frame& F, int l, int item) {
    const int kv = item >> 6, rt = item & 63;
    const int arow = F.lane & 15, kq = F.lane >> 4;
    LAS float* slots = (LAS float*)F.lds;
    LAS bf16* hbf = (LAS bf16*)(F.lds + 65536);
    const bf16* P = ws_bf(F, WS_P);
    int rho = rt * 16 + arow; if (rho > 1015) rho = 1015;
    const int b = rho / 254, rem = rho - b * 254, j = rem >> 1, g = rem & 1;
    const bf16* xrow = P + ((size_t)b * SEQ + 16 * j) * NPAD + PC_KVC + kv * 256 + g * 128;
    const bf16* W1T = ws_bf(F, WS_W1T) + (size_t)(l * 2 + kv) * 256 * 4096;
    const float* pe = (kv ? F.in[13] : F.in[12]) + l * 32 * 128;
    f32x4 acc[16];
#pragma unroll
    for (int n = 0; n < 16; ++n) acc[n] = (f32x4){0.f, 0.f, 0.f, 0.f};
    for (int li = 0; li < 4; ++li) { const int lidx = 4 * F.wave + li;
#pragma unroll
        for (int ds = 0; ds < 4; ++ds) { const int d = 32 * ds + 8 * kq;
            const v4u xa = *(const GAS v4u*)(xrow + (size_t)lidx * NPAD + d);
            const f32x4 p0 = *(const GAS f32x4*)(pe + lidx * 128 + d), p1 = *(const GAS f32x4*)(pe + lidx * 128 + d + 4);
            v4u aw; aw.x = pk2(bflo(xa.x) + p0[0], bfhi(xa.x) + p0[1]); aw.y = pk2(bflo(xa.y) + p0[2], bfhi(xa.y) + p0[3]);
            aw.z = pk2(bflo(xa.z) + p1[0], bfhi(xa.z) + p1[1]); aw.w = pk2(bflo(xa.w) + p1[2], bfhi(xa.w) + p1[3]);
            const bf16x8 a = as_bf16x8(aw); const int kbase = lidx * 128 + d;
#pragma unroll
            for (int n = 0; n < 16; ++n) { const bf16x8 bb = *(const GAS bf16x8*)(W1T + (size_t)(16 * n + arow) * 4096 + kbase); acc[n] = mfma16(a, bb, acc[n]); }
        } }
    if (F.wave >= 4) {
#pragma unroll
        for (int n = 0; n < 16; ++n)
#pragma unroll
            for (int rg = 0; rg < 4; ++rg) slots[((F.wave - 4) * 16 + 4 * kq + rg) * 256 + 16 * n + arow] = acc[n][rg]; }
    __syncthreads();
    if (F.wave < 4) {
#pragma unroll
        for (int n = 0; n < 16; ++n)
#pragma unroll
            for (int rg = 0; rg < 4; ++rg) slots[(F.wave * 16 + 4 * kq + rg) * 256 + 16 * n + arow] += acc[n][rg]; }
    __syncthreads();
#pragma unroll
    for (int e = 0; e < 8; ++e) { const int idx = F.tid * 8 + e; const float s = (slots[idx] + slots[4096 + idx]) + (slots[8192 + idx] + slots[12288 + idx]);
        hbf[(idx >> 8) * 264 + (idx & 255)] = (bf16)f2bf(silu(s)); }
    __syncthreads();
    {
        const bf16* W2T = ws_bf(F, WS_W2T) + (size_t)(l * 2 + kv) * 128 * 256;
        f32x4 a2 = {0.f, 0.f, 0.f, 0.f};
#pragma unroll
        for (int ks = 0; ks < 8; ++ks) { const bf16x8 a = *(const LAS bf16x8*)(hbf + arow * 264 + 32 * ks + 8 * kq);
            const bf16x8 bb = *(const GAS bf16x8*)(W2T + (size_t)(16 * F.wave + arow) * 256 + 32 * ks + 8 * kq); a2 = mfma16(a, bb, a2); }
        bf16* CMP = ws_bf(F, kv ? WS_VCMP : WS_KCMP);
#pragma unroll
        for (int rg = 0; rg < 4; ++rg) { const int rho2 = rt * 16 + 4 * kq + rg;
            if (rho2 < 1016) { const int b2 = rho2 / 254, rem2 = rho2 - b2 * 254, j2 = rem2 >> 1, g2 = rem2 & 1;
                CMP[((size_t)(b2 * 2 + g2) * 128 + j2) * 128 + 16 * F.wave + arow] = (bf16)f2bf(a2[rg]); } }
    }
    __syncthreads();
}

#define KSWZ(row, colB) ((row) * 256 + ((colB) ^ (((row) & 7) << 4)))
__device__ __forceinline__ int v_st(int k, int c) { const int kk = (k & ~0xC) | ((k & 4) << 1) | ((k & 8) >> 1); return ((kk >> 3) * 4 + (c >> 5)) * 512 + ((kk & 7) * 32 + (c & 31)) * 2; }
__device__ __forceinline__ int v_rd_base(int lane) { return ((lane & 3) << 3) | (((lane >> 2) & 3) << 6) | (((lane >> 4) & 1) << 5) | (((lane >> 5) & 1) << 8); }
constexpr int v_rd_off(int d0, int ks, int half) { return d0 * 512 + ks * 4096 + half * 2048; }
template <int OFF> __device__ __forceinline__ s16x4 tr_read(int vb) {
    s16x4 r; asm volatile("ds_read_b64_tr_b16 %0, %1 offset:%2" : "=&v"(r) : "v"(vb), "i"(OFF) : "memory"); return r;
}
template <int D0> __device__ __forceinline__ void pv_one(f32x16& od, int vb, bf16x8 pa0, bf16x8 pa1, bf16x8 pa2, bf16x8 pa3) {
    const s16x4 l0 = tr_read<v_rd_off(D0, 0, 0)>(vb), h0 = tr_read<v_rd_off(D0, 0, 1)>(vb), l1 = tr_read<v_rd_off(D0, 1, 0)>(vb), h1 = tr_read<v_rd_off(D0, 1, 1)>(vb);
    const s16x4 l2 = tr_read<v_rd_off(D0, 2, 0)>(vb), h2 = tr_read<v_rd_off(D0, 2, 1)>(vb), l3 = tr_read<v_rd_off(D0, 3, 0)>(vb), h3 = tr_read<v_rd_off(D0, 3, 1)>(vb);
    asm volatile("s_waitcnt lgkmcnt(0)" ::: "memory"); SBAR();
#define PK(L, H) (bf16x8){L[0], L[1], L[2], L[3], H[0], H[1], H[2], H[3]}
    od = mfma32(pa0, PK(l0, h0), od);
    od = mfma32(pa1, PK(l1, h1), od);
    od = mfma32(pa2, PK(l2, h2), od);
    od = mfma32(pa3, PK(l3, h3), od);
#undef PK
}
__device__ __forceinline__ void pv_d0(f32x16* o, int vb, bf16x8 pa0, bf16x8 pa1, bf16x8 pa2, bf16x8 pa3) {
    pv_one<0>(o[0], vb, pa0, pa1, pa2, pa3); pv_one<1>(o[1], vb, pa0, pa1, pa2, pa3); pv_one<2>(o[2], vb, pa0, pa1, pa2, pa3); pv_one<3>(o[3], vb, pa0, pa1, pa2, pa3);
}
__device__ __forceinline__ void qkt(f32x16& p0, f32x16& p1, const LAS char* Ks, const bf16x8* qr, int r32, int hi) {
    p0 = f32x16{}; p1 = f32x16{};
#pragma unroll
    for (int d0 = 0; d0 < 8; ++d0) { const int cb = (d0 * 16 + hi * 8) * 2;
        const bf16x8 b0 = *(const LAS bf16x8*)(Ks + KSWZ(r32, cb));
        const bf16x8 b1 = *(const LAS bf16x8*)(Ks + KSWZ(32 + r32, cb));
        p0 = mfma32(b0, qr[d0], p0);
        p1 = mfma32(b1, qr[d0], p1); }
}
__device__ __forceinline__ void p_to_frag(const f32x16& p0, const f32x16& p1, bf16x8& pa0, bf16x8& pa1, bf16x8& pa2, bf16x8& pa3) {
#define PK4(P, BASE, OUT) do { unsigned a0 = cvtpk(P[BASE + 0], P[BASE + 1]), a1 = cvtpk(P[BASE + 2], P[BASE + 3]);   \
    unsigned b0 = cvtpk(P[BASE + 4], P[BASE + 5]), b1 = cvtpk(P[BASE + 6], P[BASE + 7]);                              \
    auto r0 = __builtin_amdgcn_permlane32_swap(a0, b0, false, false); auto r1 = __builtin_amdgcn_permlane32_swap(a1, b1, false, false); \
    v4u w = {r0[0], r1[0], r0[1], r1[1]}; OUT = as_bf16x8(w); } while (0)
    PK4(p0, 0, pa0); PK4(p0, 8, pa1); PK4(p1, 0, pa2); PK4(p1, 8, pa3);
#undef PK4
}
__device__ __forceinline__ float half_swap_max(float v) { auto rr = __builtin_amdgcn_permlane32_swap(__float_as_uint(v), __float_as_uint(v), false, false); return fmaxf(__uint_as_float(rr[0]), __uint_as_float(rr[1])); }
__device__ __forceinline__ float half_swap_sum(float v) { auto rr = __builtin_amdgcn_permlane32_swap(__float_as_uint(v), __float_as_uint(v), false, false); return __uint_as_float(rr[0]) + __uint_as_float(rr[1]); }

struct KVRegs { v4u k0, k1, v0, v1; };
__device__ __forceinline__ void kv_load(KVRegs& R, const bf16* Kg, const bf16* Vg, size_t ld, int sr, int sc) {
    R.k0 = *(const GAS v4u*)(Kg + (size_t)sr * ld + sc); R.k1 = *(const GAS v4u*)(Kg + (size_t)(32 + sr) * ld + sc);
    R.v0 = *(const GAS v4u*)(Vg + (size_t)sr * ld + sc); R.v1 = *(const GAS v4u*)(Vg + (size_t)(32 + sr) * ld + sc);
}
__device__ __forceinline__ void kv_write(const KVRegs& R, LAS char* Kl, LAS char* Vl, int sr, int sc) {
    *(LAS v4u*)(Kl + KSWZ(sr, sc * 2)) = R.k0; *(LAS v4u*)(Kl + KSWZ(32 + sr, sc * 2)) = R.k1;
    *(LAS v4u*)(Vl + v_st(sr, sc)) = R.v0; *(LAS v4u*)(Vl + v_st(32 + sr, sc)) = R.v1;
}
constexpr int koff(int r) { return (r & 3) + 8 * (r >> 2); }
template <int MODE>
__device__ __forceinline__ void sm_tile(f32x16& p0, f32x16& p1, int dist0, bool rowsel, float C1, float C2, float& m, float& l, float& alpha) {
    float pmax = -1e30f;
#pragma unroll
    for (int r = 0; r < 16; ++r) { const int d = dist0 - koff(r); const bool ok = (MODE == 0) ? (rowsel && d >= 0) : (d >= 0 && d < WINDOW);
        const float lg = ok ? fmaf(p0[r], C1, -C2 * (float)d) : -1e30f; p0[r] = lg; pmax = fmaxf(pmax, lg); }
#pragma unroll
    for (int r = 0; r < 16; ++r) { const int d = dist0 - 32 - koff(r); const bool ok = (MODE == 0) ? (rowsel && d >= 0) : (d >= 0 && d < WINDOW);
        const float lg = ok ? fmaf(p1[r], C1, -C2 * (float)d) : -1e30f; p1[r] = lg; pmax = fmaxf(pmax, lg); }
    pmax = half_swap_max(pmax);
    const float mn = fmaxf(m, pmax);
    alpha = __builtin_amdgcn_exp2f(m - mn);
    const float mref = (mn < -1e29f) ? 0.f : mn;
    float ps = 0.f;
#pragma unroll
    for (int r = 0; r < 16; ++r) { p0[r] = __builtin_amdgcn_exp2f(p0[r] - mref); ps += p0[r]; }
#pragma unroll
    for (int r = 0; r < 16; ++r) { p1[r] = __builtin_amdgcn_exp2f(p1[r] - mref); ps += p1[r]; }
    ps = half_swap_sum(ps);
    l = l * alpha + ps; m = mn;
}
__device__ __forceinline__ void sm_tile_cmp(f32x16& p0, f32x16& p1, int dist0, float C1, float C2, float& m, float& l, float& alpha) {
    float pmax = -1e30f;
#pragma unroll
    for (int r = 0; r < 16; ++r) { const int d = dist0 - 16 * koff(r); const float lg = (d >= 0) ? fmaf(p0[r], C1, -C2 * (float)d) : -1e30f; p0[r] = lg; pmax = fmaxf(pmax, lg); }
#pragma unroll
    for (int r = 0; r < 16; ++r) { const int d = dist0 - 512 - 16 * koff(r); const float lg = (d >= 0) ? fmaf(p1[r], C1, -C2 * (float)d) : -1e30f; p1[r] = lg; pmax = fmaxf(pmax, lg); }
    pmax = half_swap_max(pmax);
    const float mn = fmaxf(m, pmax);
    alpha = __builtin_amdgcn_exp2f(m - mn);
    const float mref = (mn < -1e29f) ? 0.f : mn;
    float ps = 0.f;
#pragma unroll
    for (int r = 0; r < 16; ++r) { p0[r] = __builtin_amdgcn_exp2f(p0[r] - mref); ps += p0[r]; }
#pragma unroll
    for (int r = 0; r < 16; ++r) { p1[r] = __builtin_amdgcn_exp2f(p1[r] - mref); ps += p1[r]; }
    ps = half_swap_sum(ps);
    l = l * alpha + ps; m = mn;
}
__device__ __forceinline__ void sm_tile_fast(f32x16& p0, f32x16& p1, float base, float C1, float C2, float& m, float& l, float& alpha) {
    float pmax = -1e30f;
#pragma unroll
    for (int r = 0; r < 16; ++r) { const float lg = fmaf(p0[r], C1, fmaf((float)koff(r), C2, base)); p0[r] = lg; pmax = fmaxf(pmax, lg); }
#pragma unroll
    for (int r = 0; r < 16; ++r) { const float lg = fmaf(p1[r], C1, fmaf((float)(koff(r) + 32), C2, base)); p1[r] = lg; pmax = fmaxf(pmax, lg); }
    pmax = half_swap_max(pmax);
    const float mn = fmaxf(m, pmax);
    alpha = __builtin_amdgcn_exp2f(m - mn);
    const float mref = (mn < -1e29f) ? 0.f : mn;
    float ps = 0.f;
#pragma unroll
    for (int r = 0; r < 16; ++r) { p0[r] = __builtin_amdgcn_exp2f(p0[r] - mref); ps += p0[r]; }
#pragma unroll
    for (int r = 0; r < 16; ++r) { p1[r] = __builtin_amdgcn_exp2f(p1[r] - mref); ps += p1[r]; }
    ps = half_swap_sum(ps);
    l = l * alpha + ps; m = mn;
}
__device__ __forceinline__ void o_rescale(f32x16* o, float a, LAS float* al_l, int r32, int hi) {
    if (__any(a < 1.0f)) { if (hi == 0) al_l[r32] = a; LDS_WAIT();
#pragma unroll
        for (int r = 0; r < 16; ++r) { const float s = al_l[crow(r, hi)];
#pragma unroll
            for (int d = 0; d < 4; ++d) o[d][r] *= s; }
        LDS_WAIT(); }
}
__device__ __forceinline__ void row_bcast16(float v, float* out16, LAS float* li_l, int r32, int hi) {
    if (hi == 0) li_l[r32] = v; LDS_WAIT();
#pragma unroll
    for (int r = 0; r < 16; ++r) out16[r] = li_l[crow(r, hi)];
    LDS_WAIT();
}

__device__ __forceinline__ void nsa_cmp_item(Frame& F, int l, int item) {
    const int qb = item & 31, g = (item >> 5) & 1, b = item >> 6, q0 = 64 * qb;
    const int ntile = (4 * qb + 3) > 64 ? 2 : 1;
    LAS char* Kl = (LAS char*)F.lds;
    LAS float* impP = (LAS float*)(F.lds + 67584);
    const bf16* P = ws_bf(F, WS_P);
    const int r32 = F.lane & 31, hi = F.lane >> 5;
    {   const int sr = F.tid >> 4, sc = (F.tid & 15) * 8;
        const bf16* KC = ws_bf(F, WS_KCMP) + (size_t)(b * 2 + g) * 128 * 128;
        for (int tl = 0; tl < ntile; ++tl) { const v4u k0 = *(const GAS v4u*)(KC + (size_t)(tl * 64 + sr) * 128 + sc), k1 = *(const GAS v4u*)(KC + (size_t)(tl * 64 + 32 + sr) * 128 + sc);
            *(LAS v4u*)(Kl + tl * 16384 + KSWZ(sr, sc * 2)) = k0; *(LAS v4u*)(Kl + tl * 16384 + KSWZ(32 + sr, sc * 2)) = k1; } }
    __syncthreads();
    const int hg = g * 8 + F.wave;
    const float slope = exp2f(-0.5f * (float)(hg + 1));
    for (int qh = 0; qh < 2; ++qh) {
        const int t = q0 + 32 * qh + r32; const size_t row = (size_t)b * SEQ + t;
        bf16x8 qr[8];
#pragma unroll
        for (int d0 = 0; d0 < 8; ++d0) qr[d0] = *(const GAS bf16x8*)(P + row * NPAD + PC_Q + hg * 128 + 16 * d0 + 8 * hi);
        f32x16 p0, p1, p2, p3;
        qkt(p0, p1, Kl, qr, r32, hi);
        if (ntile == 2) qkt(p2, p3, Kl + 16384, qr, r32, hi); else { p2 = f32x16{}; p3 = f32x16{}; }
        const int base0 = t - 31 - 64 * hi; float mx = -1e30f;
#define LG(Pv, SH) _Pragma("unroll") for (int r = 0; r < 16; ++r) { const int d = base0 - (SH) - 16 * koff(r); const float lg = (d >= 0) ? (Pv[r] * SM_SCALE - slope * (float)d) : -1e30f; Pv[r] = lg; mx = fmaxf(mx, lg); }
        LG(p0, 0) LG(p1, 512) LG(p2, 1024) LG(p3, 1536)
#undef LG
        mx = half_swap_max(mx);
        const float mref = (mx < -1e29f) ? 0.f : mx; float sum = 0.f;
#define EX(Pv) _Pragma("unroll") for (int r = 0; r < 16; ++r) { Pv[r] = __expf(Pv[r] - mref); sum += Pv[r]; }
        EX(p0) EX(p1) EX(p2) EX(p3)
#undef EX
        sum = half_swap_sum(sum);
        const float inv = sum > 0.f ? 1.0f / sum : 0.f;
#define SC(Pv, S) _Pragma("unroll") for (int r = 0; r < 16; ++r) Pv[r] *= (S);
        SC(p0, inv) SC(p1, inv) SC(p2, inv) SC(p3, inv)
        {   float cg[16], sp[16];
#define GRP(Pv, GB) _Pragma("unroll") for (int i = 0; i < 4; ++i) { sp[(GB) + i] = 0.5f * Pv[4 * i + 3]; cg[(GB) + i] = (Pv[4 * i] + Pv[4 * i + 1]) + (Pv[4 * i + 2] + sp[(GB) + i]); }
            GRP(p0, 0) GRP(p1, 4) GRP(p2, 8) GRP(p3, 12)
#undef GRP
            float oth[16];
#pragma unroll
            for (int G = 0; G < 16; ++G) oth[G] = __shfl_xor(sp[G], 32);
#pragma unroll
            for (int G = 0; G < 16; ++G) { float v = cg[G]; if (hi) v += oth[G]; else if (G > 0) v += oth[G - 1];
                impP[(F.wave * 64 + 32 * qh + r32) * 32 + 2 * G + hi] = v; }
        }
#undef SC
    }
    __syncthreads();
    LAS float* impS = (LAS float*)F.lds;
    const int q = F.tid >> 3, sub = F.tid & 7;
#pragma unroll
    for (int e = 0; e < 4; ++e) { const int n = 4 * sub + e; float s = 0.f;
#pragma unroll
        for (int w = 0; w < 8; ++w) s += impP[(w * 64 + q) * 32 + n];
        if (n > qb) s = -1e30f; else if (n == 0 || n == qb || n == qb - 1) s = 1e9f;
        impS[q * 33 + n] = s; }
    __syncthreads();
    {   float mine[4]; int rank[4];
#pragma unroll
        for (int e = 0; e < 4; ++e) { mine[e] = impS[q * 33 + 4 * sub + e]; rank[e] = 0; }
        for (int mI = 0; mI < 32; ++mI) { const float sm = impS[q * 33 + mI];
#pragma unroll
            for (int e = 0; e < 4; ++e) rank[e] += (sm > mine[e] || (sm == mine[e] && mI < 4 * sub + e)) ? 1 : 0; }
        unsigned bits = 0u;
#pragma unroll
        for (int e = 0; e < 4; ++e) if (rank[e] < TOPN && (4 * sub + e) <= qb) bits |= 1u << (4 * sub + e);
        bits |= __shfl_xor(bits, 1); bits |= __shfl_xor(bits, 2); bits |= __shfl_xor(bits, 4);
        if (sub == 0) ((unsigned*)(F.ws + WS_SEL))[(size_t)(b * 2 + g) * SEQ + q0 + q] = bits;
    }
    __syncthreads();
}

__device__ __forceinline__ void kv_src_offsets(int tid, size_t ld, unsigned (&ko)[2], unsigned (&vo)[2]) {
#pragma unroll
    for (int p = 0; p < 2; ++p) { const int L = p * 8192 + tid * 16;
        const int row = L >> 8, cB = (L & 255) ^ ((row & 7) << 4); ko[p] = (unsigned)(row * ld + (cB >> 1));
        const int sub = L >> 9, within = (L & 511) >> 1, kk = (sub >> 2) * 8 + (within >> 5), c = (sub & 3) * 32 + (within & 31);
        const int k = (kk & ~0xC) | ((kk & 4) << 1) | ((kk & 8) >> 1); vo[p] = (unsigned)(k * ld + c); }
}
__device__ __forceinline__ void kv_stage(const bf16* Kt, const bf16* Vt, const unsigned (&ko)[2], const unsigned (&vo)[2], LAS char* slot, int wave) {
#pragma unroll
    for (int p = 0; p < 2; ++p) __builtin_amdgcn_global_load_lds((const unsigned*)(Kt + ko[p]), (LAS unsigned*)(slot + p * 8192 + wave * 1024), 16, 0, 0);
#pragma unroll
    for (int p = 0; p < 2; ++p) __builtin_amdgcn_global_load_lds((const unsigned*)(Vt + vo[p]), (LAS unsigned*)(slot + 16384 + p * 8192 + wave * 1024), 16, 0, 0);
}
__device__ __forceinline__ void attn_branch(const int MODE, Frame& F, f32x16* o, float& lsum, const bf16x8* qr, const bf16* Kg, const bf16* Vg, unsigned tiles, unsigned mymask,
                                            int t, int qb, float C1, float C2, LAS char* KV, LAS float* wsf, size_t ld) {
    const int r32 = F.lane & 31, hi = F.lane >> 5;
    float m = -1e30f; lsum = 0.f;
    unsigned rem = tiles; int cur = 0;
    unsigned ko[2], vo[2]; kv_src_offsets(F.tid, ld, ko, vo);
    { const int n = 31 - __builtin_clz(rem); kv_stage(Kg + (size_t)(64 * n) * ld, Vg + (size_t)(64 * n) * ld, ko, vo, KV, F.wave); }
    VM_WAIT(); __syncthreads();
    while (rem) {
        const int n = 31 - __builtin_clz(rem); rem &= ~(1u << n);
        LAS char* Kl = KV + cur * 32768; LAS char* Vl = Kl + 16384;
        if (rem) { const int n2 = 31 - __builtin_clz(rem); kv_stage(Kg + (size_t)(64 * n2) * ld, Vg + (size_t)(64 * n2) * ld, ko, vo, KV + (cur ^ 1) * 32768, F.wave); }
        f32x16 p0, p1; qkt(p0, p1, Kl, qr, r32, hi);
        float alpha;
        if (MODE == 2) { int dist0 = t - 31 - 1024 * n - 64 * hi; asm volatile("" : "+v"(dist0)); sm_tile_cmp(p0, p1, dist0, C1, C2, m, lsum, alpha); }
        else {
            int dist0 = t - 64 * n - 4 * hi; asm volatile("" : "+v"(dist0));
            const bool rowsel = ((mymask >> n) & 1u) != 0u;
            const bool masked = (n == qb) || (MODE == 1 && n == qb - 8);
            if (masked) { if (MODE == 1) sm_tile<1>(p0, p1, dist0, rowsel, C1, C2, m, lsum, alpha); else sm_tile<0>(p0, p1, dist0, rowsel, C1, C2, m, lsum, alpha); }
            else sm_tile_fast(p0, p1, rowsel ? -C2 * (float)dist0 : -1e30f, C1, C2, m, lsum, alpha);
        }
        o_rescale(o, alpha, wsf, r32, hi);
        bf16x8 pa0, pa1, pa2, pa3; p_to_frag(p0, p1, pa0, pa1, pa2, pa3);
        pv_d0(o, (int)(uintptr_t)Vl + v_rd_base(F.lane), pa0, pa1, pa2, pa3);
        VM_WAIT(); __syncthreads();
        cur ^= 1;
    }
}
__device__ __forceinline__ void nsa_attn_item(Frame& F, int l, int item) {
    const int qb = 31 - (item >> 4), rest = item & 15, b = rest >> 2, g = (rest >> 1) & 1, hh = rest & 1, q0 = 64 * qb;
    const int r32 = F.lane & 31, hi = F.lane >> 5;
    const int hg = 8 * g + 4 * hh + (F.wave >> 1), qh = F.wave & 1, t = q0 + 32 * qh + r32;
    const size_t row = (size_t)b * SEQ + t;
    const float slope = exp2f(-0.5f * (float)(hg + 1)), C1 = SM_SCALE * LOG2E, C2 = slope * LOG2E;
    LAS char* KV = (LAS char*)F.lds; LAS float* wsf = (LAS float*)(F.lds + 69632) + F.wave * 64;
    const bf16* P = ws_bf(F, WS_P);
    bf16x8 qr[8];
#pragma unroll
    for (int d0 = 0; d0 < 8; ++d0) qr[d0] = *(const GAS bf16x8*)(P + row * NPAD + PC_Q + hg * 128 + 16 * d0 + 8 * hi);
    const unsigned* SEL = (const unsigned*)(F.ws + WS_SEL) + (size_t)(b * 2 + g) * SEQ;
    const unsigned mymask = SEL[t];
    unsigned uni = SEL[q0 + F.lane];
#pragma unroll
    for (int o_ = 1; o_ < 64; o_ <<= 1) uni |= __shfl_xor(uni, o_);
    uni = __builtin_amdgcn_readfirstlane(uni);
    const unsigned upto = (qb == 31) ? 0xffffffffu : ((2u << qb) - 1u);
    LAS unsigned* stash = (LAS unsigned*)(F.lds + 71680) + F.tid;
    const int nlo = qb > 8 ? qb - 8 : 0;
#pragma unroll
    for (int br = 0; br < 3; ++br) {
        const int mode = (br == 0) ? 2 : (br == 1 ? 0 : 1);
        const bf16* Kg = (br == 0) ? ws_bf(F, WS_KCMP) + (size_t)(b * 2 + g) * 128 * 128 : P + (size_t)b * SEQ * NPAD + (br == 1 ? PC_KVS : PC_KVW) + g * 128;
        const bf16* Vg = (br == 0) ? ws_bf(F, WS_VCMP) + (size_t)(b * 2 + g) * 128 * 128 : Kg + 256;
        const size_t ld = (br == 0) ? 128 : NPAD;
        const unsigned tiles = (br == 0) ? ((4 * qb + 3) > 64 ? 3u : 1u) : (br == 1 ? (uni & upto) : (upto & ~((1u << nlo) - 1u)));
        f32x16 o[4] = {};
        float lsum, rs[16];
        attn_branch(mode, F, o, lsum, qr, Kg, Vg, tiles, (br == 1) ? mymask : 0xffffffffu, t, qb, C1, C2, KV, wsf, ld);
        const float gt = sigm(bf2f(P[row * NPAD + PC_GL + hg * 3 + br]));
        row_bcast16(lsum > 0.f ? gt / lsum : 0.f, rs, wsf + 32, r32, hi);
        if (br == 0) {
#pragma unroll
            for (int d0 = 0; d0 < 4; ++d0)
#pragma unroll
                for (int r = 0; r < 16; r += 2) stash[(d0 * 8 + (r >> 1)) * 512] = cvtpk(o[d0][r] * rs[r], o[d0][r + 1] * rs[r + 1]);
        } else if (br == 1) {
#pragma unroll
            for (int d0 = 0; d0 < 4; ++d0)
#pragma unroll
                for (int r = 0; r < 16; r += 2) { const unsigned sw = stash[(d0 * 8 + (r >> 1)) * 512];
                    stash[(d0 * 8 + (r >> 1)) * 512] = cvtpk(bflo(sw) + o[d0][r] * rs[r], bfhi(sw) + o[d0][r + 1] * rs[r + 1]); }
        } else {
            LAS bf16* Yl = (LAS bf16*)(F.lds + F.wave * 8704);
#pragma unroll
            for (int d0 = 0; d0 < 4; ++d0)
#pragma unroll
                for (int r = 0; r < 16; ++r) { const unsigned sw = stash[(d0 * 8 + (r >> 1)) * 512];
                    const float v = ((r & 1) ? bfhi(sw) : bflo(sw)) + o[d0][r] * rs[r];
                    Yl[(koff(r) + 4 * hi) * 136 + 32 * d0 + r32] = (bf16)f2bf(v); }
            LDS_WAIT(); asm volatile("" ::: "memory");
            const int yr = F.lane >> 1, yh = (F.lane & 1) * 64;
            const size_t orow = (size_t)b * SEQ + q0 + 32 * qh + yr;
            const bf16* gp = P + orow * NPAD + PC_NSAG + hg * 128 + yh;
            bf16* yp = ws_bf(F, WS_YCAT) + orow * DM + 1024 + hg * 128 + yh;
#pragma unroll
            for (int i2 = 0; i2 < 8; ++i2) { const v4u w = *(const LAS v4u*)(Yl + yr * 136 + yh + 8 * i2); const v4u gq = *(const GAS v4u*)(gp + 8 * i2);
                v4u y; y.x = pk2(bflo(w.x) * silu(bflo(gq.x)), bfhi(w.x) * silu(bfhi(gq.x))); y.y = pk2(bflo(w.y) * silu(bflo(gq.y)), bfhi(w.y) * silu(bfhi(gq.y)));
                y.z = pk2(bflo(w.z) * silu(bflo(gq.z)), bfhi(w.z) * silu(bfhi(gq.z))); y.w = pk2(bflo(w.w) * silu(bflo(gq.w)), bfhi(w.w) * silu(bfhi(gq.w)));
                *(GAS v4u*)(yp + 8 * i2) = y; }
        }
    }
    __syncthreads();
}

#ifndef PROBE_DUP
#define PROBE_DUP -1
#endif
#ifndef MK_SPLIT
#define MK_SPLIT 0
#endif
constexpr int N_PHASES = 2 + 6 * DEPTH;
struct Args { const float* in[23]; float* out; unsigned char* ws; int ph_lo, ph_hi; };
__global__ void __launch_bounds__(NWAVES * 64, 2) hymba_fwd(Args args) {
    extern __shared__ __attribute__((aligned(16))) unsigned char lds[];
    Frame F;
    F.lds = (LAS unsigned char*)lds;
    F.MISC = (volatile LAS unsigned*)(F.lds + MISC_OFF);
    F.tid = threadIdx.x; F.lane = F.tid & 63; F.wave = __builtin_amdgcn_readfirstlane(F.tid >> 6);
    F.G = gridDim.x; { const int bx = blockIdx.x; F.vcu = (F.G % 8 == 0) ? (bx % 8) * (F.G / 8) + bx / 8 : bx; }
    F.ws = args.ws; F.out = args.out; F.ctl = (gu32*)(args.ws + WS_CTL);
    F.in = args.in;
    for (int u = F.tid; u < (LDS_BYTES - LDSCTL_OFF) / 4; u += NWAVES * 64) ((LAS unsigned*)(F.lds + LDSCTL_OFF))[u] = 0u;
    __syncthreads();
#if MK_SPLIT
#define GRID_BAR() do { } while (0)
#else
    XcdBarrier bar = xcd_barrier_post((unsigned*)(F.ctl + CW_BAR), F.MISC + 8);
#define GRID_BAR() xcd_barrier(bar)
#endif
#if MK_SPLIT
    const int lo = args.ph_lo, hi_ = args.ph_hi;
#define IN(k) (lo <= (k) && (k) < hi_)
#define BOTH(k) (IN(k) && IN((k) + 1))
#else
#define IN(k) true
#define BOTH(k) ((k) + 1 < N_PHASES)
#endif

    if (IN(0)) { launder(F); p0_prologue(F);
#if PROBE_DUP == 0
            launder(F); __syncthreads(); p0_prologue(F);
#endif
        if (BOTH(0)) GRID_BAR(); }
    if (IN(1)) { launder(F); p1_u0(F); if (BOTH(1)) GRID_BAR(); }
    for (int l = 0; l < DEPTH; ++l) {
        const int pb = 2 + 6 * l;
        if (IN(pb + 0)) { launder(F);
            pg8::Gemm g{ws_bf(F, WS_U), ws_bf(F, WS_WIN) + (size_t)l * NPAD * DM, MROWS, NPAD, DM}; pg8::StaticOrder S; S.init(MROWS, NPAD, F.G, (int)blockIdx.x);
            pg8::EpiBf16 E{ws_bf(F, WS_P), NPAD};
            pg8::gemm_phase<pg8::EpiBf16, pg8::StaticOrder, true, true>(F.lds, g, S, E);
#if PROBE_DUP == 1
            launder(F); __syncthreads(); pg8::gemm_phase<pg8::EpiBf16, pg8::StaticOrder, true, true>(F.lds, g, S, E);
#endif
            if (BOTH(pb + 0)) GRID_BAR();
        }
        if (IN(pb + 1)) { launder(F);
            for (int it = F.vcu; it < 128; it += F.G) cmp_item(F, l, it);
            launder(F);
            for (int it = F.vcu; it < 1024; it += F.G) hg1_item(F, l, it);
            launder(F);
            for (int it = F.vcu; it < 1024; it += F.G) rg_item<1>(F, l, it);
#if PROBE_DUP == 2
            launder(F); for (int it = F.vcu; it < 128; it += F.G) cmp_item(F, l, it); launder(F); for (int it = F.vcu; it < 1024; it += F.G) hg1_item(F, l, it); launder(F); for (int it = F.vcu; it < 1024; it += F.G) rg_item<1>(F, l, it);
#endif
            if (BOTH(pb + 1)) GRID_BAR();
        }
        if (IN(pb + 2)) { launder(F);
            for (int it = F.vcu; it < 256; it += F.G) nsa_cmp_item(F, l, it);
#if PROBE_DUP == 3
            launder(F); for (int it = F.vcu; it < 256; it += F.G) nsa_cmp_item(F, l, it);
#endif
            launder(F);
            hg_pass2(F);
            launder(F);
            rg_pass2(F);
            if (BOTH(pb + 2)) GRID_BAR();
        }
        if (IN(pb + 3)) { launder(F);
            for (;;) { const int it = q_next(F, l * 4 + 0); if (it >= 512) break; nsa_attn_item(F, l, it); }
#if PROBE_DUP == 4
            launder(F); for (;;) { const int it = q_next(F, 8 + l * 4 + 0); if (it >= 512) break; nsa_attn_item(F, l, it); }
#endif
            launder(F);
            for (;;) { const int it = q_next(F, l * 4 + 1); if (it >= 1024) break; hg3_item(F, l, it); }
            launder(F);
            for (;;) { const int it = q_next(F, l * 4 + 2); if (it >= 1024) break; rg_item<3>(F, l, it); }
#if PROBE_DUP == 5
            launder(F); for (;;) { const int it = q_next(F, 8 + l * 4 + 1); if (it >= 1024) break; hg3_item(F, l, it); } launder(F); for (;;) { const int it = q_next(F, 8 + l * 4 + 2); if (it >= 1024) break; rg_item<3>(F, l, it); }
#endif
            if (BOTH(pb + 3)) GRID_BAR();
        }
        if (IN(pb + 4)) { launder(F);
            pg8::Gemm g{ws_bf(F, WS_YCAT), ws_bf(F, WS_WOUT) + (size_t)l * DM * DM, MROWS, DM, DM}; pg8::StaticOrder S; S.init(MROWS, DM, F.G, (int)blockIdx.x);
            pg8::EpiResid E{l == 0 ? F.in[0] : ws_f(F, WS_XRES), ws_f(F, WS_V), ws_f(F, WS_MOD) + (size_t)l * 4 * 12288 + 2 * DM, 12288, SEQ, DM, ALPHA};
            pg8::gemm_phase<pg8::EpiResid, pg8::StaticOrder, true, true>(F.lds, g, S, E);
#if PROBE_DUP == 6
            launder(F); __syncthreads(); pg8::gemm_phase<pg8::EpiResid, pg8::StaticOrder, true, true>(F.lds, g, S, E);
#endif
            if (BOTH(pb + 4)) GRID_BAR();
        }
        if (IN(pb + 5)) { launder(F);
            ln_phase(F, l, (l == DEPTH - 1) ? F.out : ws_f(F, WS_XRES), l != DEPTH - 1);
#if PROBE_DUP == 7
            launder(F); ln_phase(F, l, (l == DEPTH - 1) ? F.out : ws_f(F, WS_XRES), l != DEPTH - 1);
#endif
            if (BOTH(pb + 5)) GRID_BAR();
        }
    }
#undef IN
#undef BOTH
}

extern "C" void kernel_launch(void* const* d_in, const int* in_sizes, int n_in, void* d_out, int out_size, void* d_ws, size_t ws_size, hipStream_t stream) {
    static int grid = 0;
    if (grid == 0) {
        if (n_in != 23 || in_sizes[0] != MROWS * DM || out_size != MROWS * DM || ws_size < WS_END) {
            fprintf(stderr, "kernel_launch: shape/workspace mismatch: n_in %d in0 %d out %d ws %zu (need %zu)\n", n_in, n_in > 0 ? in_sizes[0] : -1, out_size, ws_size, (size_t)WS_END); grid = -1; return; }
        int dev = 0, cus = 0, per_cu = 0;
        if (hipGetDevice(&dev) != hipSuccess || hipDeviceGetAttribute(&cus, hipDeviceAttributeMultiprocessorCount, dev) != hipSuccess) { fprintf(stderr, "kernel_launch: device query failed\n"); grid = -1; return; }
        if (hipFuncSetAttribute((const void*)hymba_fwd, hipFuncAttributeMaxDynamicSharedMemorySize, LDS_BYTES) != hipSuccess) { fprintf(stderr, "kernel_launch: hipFuncSetAttribute failed\n"); grid = -1; return; }
        if (hipOccupancyMaxActiveBlocksPerMultiprocessor(&per_cu, (const void*)hymba_fwd, NWAVES * 64, LDS_BYTES) != hipSuccess || per_cu < 1)
            fprintf(stderr, "kernel_launch: note: occupancy query reports %d workgroups per CU\n", per_cu);
        (void)hipGetLastError();
        grid = cus;
    }
    if (grid < 0) return;
    if (hipMemsetAsync((char*)d_ws + WS_CTL, 0, CTL_ZERO_BYTES, stream) != hipSuccess) { fprintf(stderr, "kernel_launch: memset failed\n"); return; }
    Args a{};
    for (int i = 0; i < 23; ++i) a.in[i] = (const float*)d_in[i];
    a.out = (float*)d_out; a.ws = (unsigned char*)d_ws;
#if MK_SPLIT
    for (int ph = 0; ph < N_PHASES; ++ph) { a.ph_lo = ph; a.ph_hi = ph + 1;
        hipLaunchKernelGGL(hymba_fwd, dim3(grid), dim3(NWAVES * 64), LDS_BYTES, stream, a); }
#else
    a.ph_lo = 0; a.ph_hi = N_PHASES;
    hipLaunchKernelGGL(hymba_fwd, dim3(grid), dim3(NWAVES * 64), LDS_BYTES, stream, a);
#endif
    const hipError_t le = hipPeekAtLastError();
    if (le != hipSuccess) fprintf(stderr, "kernel_launch: launch failed: %s\n", hipGetErrorName(le));
}
```

```cpp
#include <hip/hip_runtime.h>
#include <cstdio>
#include <cstdint>
#define MK_SPLIT 0
#define PROBE_DUP -1
namespace pg8 {
#define PG8_LAS __attribute__((address_space(3)))
typedef unsigned short bf16_t;
typedef short bf16x8 __attribute__((ext_vector_type(8)));
typedef float f32x4 __attribute__((ext_vector_type(4)));
typedef unsigned u32x4 __attribute__((ext_vector_type(4)));
constexpr int BM = 256, BK = 64, HALF = 128, HTB = HALF * BK * 2  , STAGE_BYTES = 8 * HTB, NXCD = 8, WGM = 8;

__host__ __device__ __forceinline__ int lds_byte(int r, int c) { const int st = (r >> 4) * 2 + (c >> 5), rr = r & 15, cc = c & 31, ob = rr * 64 + cc * 2; return st * 1024 + (ob ^ (((ob >> 9) & 1) << 5)); }
__host__ __device__ __forceinline__ void stage_rc(int b, int& R, int& C) { const int st = b / 1024, sb = b % 1024, swz = sb ^ (((sb >> 9) & 1) << 5); R = (st >> 1) * 16 + swz / 64; C = (st & 1) * 32 + (swz % 64) / 2; }
__host__ __device__ __forceinline__ int perm32(int rho) { const int n = rho >> 4, i = rho & 15; return 8 * (i >> 2) + 4 * n + (i & 3); }

struct Unit { int pm, pn; };
struct Gemm { const bf16_t* A; const bf16_t* Bt; int M, N, K; };

struct StaticOrder {
    int nM, nN, nwg, G, c;
    __host__ __device__ void init(int M, int N, int G_, int c_) { nM = M / BM; nN = N / BM; nwg = nM * nN; G = G_; c = c_; }
    __host__ __device__ bool next(int i, Unit& u) const {
        const long L = (long)i * G + c; if (L >= nwg) return false;
        int wgid = (int)L; { const int q = nwg / NXCD, r = nwg % NXCD, xcd = wgid % NXCD, off = wgid / NXCD; wgid = (xcd < r ? xcd * (q + 1) : r * (q + 1) + (xcd - r) * q) + off; }
        const int nig = WGM * nN, gid = wgid / nig, fm = gid * WGM, gsz = (nM - fm) < WGM ? (nM - fm) : WGM;
        u.pm = fm + ((wgid % nig) % gsz); u.pn = (wgid % nig) / gsz; return true;
    }
    __device__ __forceinline__ void a_ready(const Unit&) const {}
    __device__ __forceinline__ void done(const Unit&) const {}
};

__device__ __forceinline__ unsigned cvt_pk_bf16(float lo, float hi) { unsigned r; asm volatile("v_cvt_pk_bf16_f32 %0, %1, %2" : "=v"(r) : "v"(lo), "v"(hi)); return r; }
typedef float f32x2 __attribute__((ext_vector_type(2)));

struct EpiBf16 {
    static constexpr bool PERM = true, AFTER_DRAIN = false;
    bf16_t* O; int ldc;
    __device__ __forceinline__ void operator()(const f32x4 (&acc)[2][2][4][2], const Unit& u, int wr, int wc, int fr, int fq) const {
        const int row0 = u.pm * BM + wr * 64 + fr; const int col0 = u.pn * BM + wc * 32 + 8 * fq;
#pragma unroll
        for (int ai = 0; ai < 2; ++ai)
#pragma unroll
            for (int m = 0; m < 4; ++m) { bf16_t* rowp = O + (size_t)(row0 + ai * HALF + m * 16) * ldc + col0;
#pragma unroll
                for (int bj = 0; bj < 2; ++bj) { const f32x4 v0 = acc[ai][bj][m][0], v1 = acc[ai][bj][m][1];
                    u32x4 w; w.x = cvt_pk_bf16(v0[0], v0[1]); w.y = cvt_pk_bf16(v0[2], v0[3]); w.z = cvt_pk_bf16(v1[0], v1[1]); w.w = cvt_pk_bf16(v1[2], v1[3]);
                    *(u32x4*)(rowp + bj * HALF) = w; } }
    }
};
struct EpiResid {
    static constexpr bool PERM = false, AFTER_DRAIN = false;
    const float* xres; float* V; const float* gate; int gate_stride; int rows_per_batch; int ldc; float alpha;
    __device__ __forceinline__ void operator()(const f32x4 (&acc)[2][2][4][2], const Unit& u, int wr, int wc, int fr, int fq) const {
        const int bidx = (u.pm * BM) / rows_per_batch; const int col0 = u.pn * BM + wc * 32 + 4 * fq;
        f32x4 gv[2][2];
#pragma unroll
        for (int bj = 0; bj < 2; ++bj)
#pragma unroll
            for (int n = 0; n < 2; ++n) gv[bj][n] = *(const f32x4*)(gate + (size_t)bidx * gate_stride + col0 + bj * HALF + n * 16) + 1.0f;
#pragma unroll
        for (int ai = 0; ai < 2; ++ai)
#pragma unroll
            for (int m = 0; m < 4; ++m) { const size_t off = (size_t)(u.pm * BM + ai * HALF + wr * 64 + m * 16 + fr) * ldc + col0;
#pragma unroll
                for (int bj = 0; bj < 2; ++bj)
#pragma unroll
                    for (int n = 0; n < 2; ++n) { const f32x4 xr = *(const f32x4*)(xres + off + bj * HALF + n * 16);
                        *(f32x4*)(V + off + bj * HALF + n * 16) = xr * alpha + gv[bj][n] * acc[ai][bj][m][n]; } }
    }
};
template <class Epi, class Sched, bool ALIGN_EPI = false, bool SP2 = false>
__device__ __forceinline__ void gemm_phase(PG8_LAS unsigned char* lds, const Gemm g, const Sched& S, const Epi& E) {
    int tid_ = threadIdx.x; asm volatile("" : "+v"(tid_));
    const int tid = tid_, wid = __builtin_amdgcn_readfirstlane(tid >> 6), lane = tid & 63, wr = wid >> 2, wc = wid & 3, fr = lane & 15, fq = lane >> 4;
    const int K = g.K, nt = K / BK;
    unsigned voffA[2], voffB[2];
#pragma unroll
    for (int i = 0; i < 2; ++i) { int R, C; stage_rc(tid * 16 + i * 8192, R, C); const int Rb = Epi::PERM ? ((R & ~31) + perm32(R & 31)) : R;
        voffA[i] = (unsigned)(R * K + C) * 2u; voffB[i] = (unsigned)(Rb * K + C) * 2u; }
    const size_t kstep = (size_t)(BK * 2);
    const size_t hstep = (size_t)HALF * K * 2;
    const size_t tstep = 2 * hstep;
    const unsigned ldsw = (unsigned)wid * 1024u;
    const int aoff = lds_byte(wr * 64 + fr, fq * 8), boff = lds_byte(wc * 32 + fr, fq * 8);
#define PG8_SA(b, h) (((b) * 2 + (h)) * HTB)
#define PG8_SB(b, h) ((4 + (b) * 2 + (h)) * HTB)
#define PG8_STAGE(bufoff, gbase, voff) do { _Pragma("unroll") for (int _i = 0; _i < 2; ++_i) \
        __builtin_amdgcn_global_load_lds((const unsigned*)((const char*)(gbase) + (voff)[_i]), (PG8_LAS unsigned*)(lds + (bufoff) + ldsw + _i * 8192), 16, 0, 0); } while (0)
#define PG8_LDA(dst, b, h) do { _Pragma("unroll") for (int m = 0; m < 4; ++m) _Pragma("unroll") for (int k = 0; k < 2; ++k) dst[m][k] = *(const PG8_LAS bf16x8*)(lds + PG8_SA(b, h) + aoff + m * 2048 + k * 1024); } while (0)
#define PG8_LDB(dst, b, h) do { _Pragma("unroll") for (int n = 0; n < 2; ++n) _Pragma("unroll") for (int k = 0; k < 2; ++k) dst[n][k] = *(const PG8_LAS bf16x8*)(lds + PG8_SB(b, h) + boff + n * 2048 + k * 1024); } while (0)
#define PG8_MMA(ai, bj, At, Bt) do { __builtin_amdgcn_s_setprio(1); _Pragma("unroll") for (int m = 0; m < 4; ++m) _Pragma("unroll") for (int n = 0; n < 2; ++n) _Pragma("unroll") for (int k = 0; k < 2; ++k) \
        acc[ai][bj][m][n] = __builtin_amdgcn_mfma_f32_16x16x32_bf16(Bt[n][k], At[m][k], acc[ai][bj][m][n], 0, 0, 0); __builtin_amdgcn_s_setprio(0); } while (0)
#define PG8_WAIT_V(n) asm volatile("s_waitcnt vmcnt(" #n ")" ::: "memory")
#define PG8_WAIT_L(n) asm volatile("s_waitcnt lgkmcnt(" #n ")" ::: "memory")
#define PG8_BAR __builtin_amdgcn_s_barrier()
#define PG8_SCHED __builtin_amdgcn_sched_barrier(0)
    Unit cur, nxt; int ui = 0;
    if (!S.next(0, cur)) return;
    f32x4 acc[2][2][4][2];
#pragma unroll
    for (int a = 0; a < 2; ++a)
#pragma unroll
        for (int b = 0; b < 2; ++b)
#pragma unroll
            for (int m = 0; m < 4; ++m)
#pragma unroll
                for (int n = 0; n < 2; ++n) acc[a][b][m][n] = (f32x4){0.f, 0.f, 0.f, 0.f};
    bf16x8 At[4][2], B0[2][2], B1[2][2];
    const char* cA = (const char*)g.A + (size_t)cur.pm * tstep; const char* cB = (const char*)g.Bt + (size_t)cur.pn * tstep;
    S.a_ready(cur);
    if constexpr (SP2) {
        PG8_STAGE(PG8_SB(0, 0), cB, voffB); PG8_STAGE(PG8_SB(0, 1), cB + hstep, voffB); PG8_STAGE(PG8_SA(0, 0), cA, voffA); PG8_STAGE(PG8_SA(0, 1), cA + hstep, voffA);
        if (wr == 1) PG8_BAR;
        PG8_WAIT_V(2); PG8_BAR;
        PG8_STAGE(PG8_SB(1, 0), cB + kstep, voffB); PG8_STAGE(PG8_SA(1, 0), cA + kstep, voffA); PG8_STAGE(PG8_SB(1, 1), cB + hstep + kstep, voffB);
        PG8_WAIT_V(6); PG8_BAR;
    } else {
        PG8_STAGE(PG8_SB(0, 0), cB, voffB); PG8_STAGE(PG8_SA(0, 0), cA, voffA); PG8_STAGE(PG8_SB(0, 1), cB + hstep, voffB); PG8_STAGE(PG8_SA(0, 1), cA + hstep, voffA);
        if (wr == 1) PG8_BAR;
        PG8_WAIT_V(4); PG8_BAR;
        PG8_STAGE(PG8_SB(1, 0), cB + kstep, voffB); PG8_STAGE(PG8_SA(1, 0), cA + kstep, voffA); PG8_STAGE(PG8_SB(1, 1), cB + hstep + kstep, voffB);
        PG8_WAIT_V(6); PG8_BAR;
    }
    for (;;) {
        const bool has_next = S.next(ui + 1, nxt);
        const char* nA = has_next ? (const char*)g.A + (size_t)nxt.pm * tstep : cA; const char* nB = has_next ? (const char*)g.Bt + (size_t)nxt.pn * tstep : cB;
        for (int t = 0; t < nt; t += 2) {
            const bool last = (t == nt - 2);
            const char* a1 = cA + (size_t)(t + 1) * kstep;
            const char* a2 = last ? nA : cA + (size_t)(t + 2) * kstep; const char* b2 = last ? nB : cB + (size_t)(t + 2) * kstep;
            const char* a3 = a2 + kstep; const char* b3 = b2 + kstep;
            if (last && has_next) S.a_ready(nxt);
            if constexpr (SP2) {
            PG8_LDB(B0, 0, 0); PG8_LDB(B1, 0, 1); PG8_SCHED; PG8_LDA(At, 0, 0); PG8_STAGE(PG8_SA(1, 1), a1 + hstep, voffA);
            PG8_WAIT_V(8); PG8_WAIT_L(0); PG8_BAR; PG8_MMA(0, 0, At, B0); PG8_MMA(0, 1, At, B1); PG8_BAR; PG8_SCHED;
            PG8_LDA(At, 0, 1); PG8_STAGE(PG8_SB(0, 0), b2, voffB); PG8_STAGE(PG8_SB(0, 1), b2 + hstep, voffB); PG8_STAGE(PG8_SA(0, 0), a2, voffA);
            PG8_WAIT_V(8); PG8_WAIT_L(0); PG8_BAR; PG8_MMA(1, 0, At, B0); PG8_MMA(1, 1, At, B1); PG8_BAR; PG8_SCHED;
            PG8_LDB(B0, 1, 0); PG8_LDB(B1, 1, 1); PG8_SCHED; PG8_LDA(At, 1, 0); PG8_STAGE(PG8_SA(0, 1), a2 + hstep, voffA);
            PG8_WAIT_V(8); PG8_WAIT_L(0); PG8_BAR; PG8_MMA(0, 0, At, B0); PG8_MMA(0, 1, At, B1); PG8_BAR; PG8_SCHED;
            PG8_LDA(At, 1, 1); PG8_STAGE(PG8_SB(1, 0), b3, voffB); PG8_STAGE(PG8_SB(1, 1), b3 + hstep, voffB); PG8_STAGE(PG8_SA(1, 0), a3, voffA);
            PG8_WAIT_V(8); PG8_WAIT_L(0); PG8_BAR; PG8_MMA(1, 0, At, B0); PG8_MMA(1, 1, At, B1); PG8_BAR; PG8_SCHED;
            } else {
            PG8_LDB(B0, 0, 0); PG8_SCHED; PG8_LDA(At, 0, 0); PG8_STAGE(PG8_SA(1, 1), a1 + hstep, voffA);
            PG8_WAIT_L(8); PG8_BAR; PG8_WAIT_L(0); PG8_MMA(0, 0, At, B0); PG8_BAR; PG8_SCHED;
            PG8_LDB(B1, 0, 1); PG8_STAGE(PG8_SB(0, 0), b2, voffB);
            PG8_BAR; PG8_WAIT_L(0); PG8_MMA(0, 1, At, B1); PG8_BAR;
            PG8_LDA(At, 0, 1); PG8_STAGE(PG8_SA(0, 0), a2, voffA);
            PG8_BAR; PG8_WAIT_L(0); PG8_MMA(1, 0, At, B0); PG8_BAR; PG8_SCHED;
            PG8_STAGE(PG8_SB(0, 1), b2 + hstep, voffB);
            PG8_WAIT_V(6); PG8_BAR; PG8_MMA(1, 1, At, B1); PG8_BAR;
            PG8_LDB(B0, 1, 0); PG8_SCHED; PG8_LDA(At, 1, 0); PG8_STAGE(PG8_SA(0, 1), a2 + hstep, voffA);
            PG8_WAIT_L(8); PG8_BAR; PG8_WAIT_L(0); PG8_MMA(0, 0, At, B0); PG8_BAR; PG8_SCHED;
            PG8_LDB(B1, 1, 1); PG8_STAGE(PG8_SB(1, 0), b3, voffB);
            PG8_BAR; PG8_WAIT_L(0); PG8_MMA(0, 1, At, B1); PG8_BAR;
            PG8_LDA(At, 1, 1); PG8_STAGE(PG8_SA(1, 0), a3, voffA);
            PG8_BAR; PG8_WAIT_L(0); PG8_MMA(1, 0, At, B0); PG8_BAR; PG8_SCHED;
            PG8_STAGE(PG8_SB(1, 1), b3 + hstep, voffB);
            PG8_WAIT_V(6); PG8_BAR; PG8_MMA(1, 1, At, B1); PG8_BAR;
            }
        }
        if constexpr (ALIGN_EPI) { if (wr == 0) PG8_BAR; }
        if constexpr (!Epi::AFTER_DRAIN) { E(acc, cur, wr, wc, fr, fq); S.done(cur); }
        if (!has_next) break;
#pragma unroll
        for (int a = 0; a < 2; ++a)
#pragma unroll
            for (int b = 0; b < 2; ++b)
#pragma unroll
                for (int m = 0; m < 4; ++m)
#pragma unroll
                    for (int n = 0; n < 2; ++n) acc[a][b][m][n] = (f32x4){0.f, 0.f, 0.f, 0.f};
        cur = nxt; cA = nA; cB = nB; ++ui;
        if constexpr (ALIGN_EPI) { if (wr == 1) PG8_BAR; }
    }
    PG8_WAIT_V(0);
    if constexpr (!ALIGN_EPI) { if (wr == 0) PG8_BAR; }
    PG8_BAR;
    if constexpr (Epi::AFTER_DRAIN) { E.fused(acc, cur, wr, wc, fr, fq, lds, wid, lane); S.done(cur); }
#undef PG8_SA
#undef PG8_SB
#undef PG8_STAGE
#undef PG8_LDA
#undef PG8_LDB
#undef PG8_MMA
#undef PG8_WAIT_V
#undef PG8_WAIT_L
#undef PG8_BAR
#undef PG8_SCHED
}
}

constexpr int DM = 4096, BATCH = 4, SEQ = 2048, DEPTH = 2, MROWS = BATCH * SEQ;
constexpr int HD = 128, D_RG = 1024, D_NSA = 2048, D_HG = 1024;
constexpr int NIN = 11824, NPAD = 12032;
constexpr int NHEADS = 16, NKV = 2, NGRP = 8;
constexpr int NCMP = 127, NSEL = 32, TOPN = 16, WINDOW = 512;
constexpr int PC_RGX = 0, PC_RGG = 1024, PC_Q = 2048, PC_KVC = 4096, PC_KVS = 4608, PC_KVW = 5120, PC_NSAG = 5632,
              PC_HGQ = 7680, PC_HGF = 8704, PC_HGI = 9728, PC_HGG = 10752, PC_GL = 11776;
constexpr float LN_EPS = 1e-5f, RMS_EPS = 1e-6f, ALPHA = 1.41421356237309515f;
constexpr float SM_SCALE = 0.088388347648318440f;
constexpr float LOG2E = 1.4426950408889634f;

constexpr size_t MiB = 1u << 20;
constexpr size_t WS_CTL = 0, CTL_ZERO_BYTES = 1 * MiB;
constexpr size_t WS_WIN  = 2 * MiB;
constexpr size_t WS_WOUT = 190 * MiB;
constexpr size_t WS_W1T  = 254 * MiB;
constexpr size_t WS_W2T  = 262 * MiB;
constexpr size_t WS_RGW  = 263 * MiB;
constexpr size_t WS_MOD  = 264 * MiB;
constexpr size_t WS_U    = 266 * MiB;
constexpr size_t WS_P    = 330 * MiB;
constexpr size_t WS_XRES = 518 * MiB;
constexpr size_t WS_V    = 646 * MiB;
constexpr size_t WS_YCAT = 774 * MiB;
constexpr size_t WS_OACC = 838 * MiB;
constexpr size_t WS_HS   = 902 * MiB;
constexpr size_t WS_HDEC = 966 * MiB;
constexpr size_t WS_RGSA = 967 * MiB;
constexpr size_t WS_RGSH = 967 * MiB + 512 * 1024;
constexpr size_t WS_RGC  = 968 * MiB;
constexpr size_t WS_KCMP = 969 * MiB;
constexpr size_t WS_VCMP = 969 * MiB + 256 * 1024;
constexpr size_t WS_SEL  = 970 * MiB;
constexpr size_t WS_END  = 972 * MiB;

constexpr int CW_TMO = 0;
constexpr int CW_BAR = 4096;
constexpr int CW_Q = 8192;

constexpr int RING_BYTES = 131072;
constexpr int LDSCTL_OFF = 143360, MISC_OFF = LDSCTL_OFF + 320;
constexpr int LDS_BYTES = 147456;
constexpr int NWAVES = 8;

#define GAS __attribute__((address_space(1)))
#define LAS __attribute__((address_space(3)))
typedef unsigned short bf16;
typedef unsigned v4u __attribute__((ext_vector_type(4)));
typedef unsigned v2u __attribute__((ext_vector_type(2)));
typedef float f32x4 __attribute__((ext_vector_type(4)));
typedef float f32x16 __attribute__((ext_vector_type(16)));
typedef short bf16x8 __attribute__((ext_vector_type(8)));
typedef short s16x4 __attribute__((ext_vector_type(4)));
typedef GAS unsigned gu32;
#define RLX_AGENT __ATOMIC_RELAXED, __HIP_MEMORY_SCOPE_AGENT
#define LDS_WAIT() asm volatile("s_waitcnt lgkmcnt(0)" ::: "memory")
#define VM_WAIT() asm volatile("s_waitcnt vmcnt(0)" ::: "memory")
#define SBAR() __builtin_amdgcn_sched_barrier(0)
__device__ __forceinline__ unsigned f2bf(float f) { unsigned u = __builtin_bit_cast(unsigned, f); return (u + 0x7fffu + ((u >> 16) & 1u)) >> 16; }
__device__ __forceinline__ unsigned pk2(float lo, float hi) { return f2bf(lo) | (f2bf(hi) << 16); }
__device__ __forceinline__ float bf2f(unsigned h) { return __builtin_bit_cast(float, h << 16); }
__device__ __forceinline__ float bflo(unsigned w) { return __builtin_bit_cast(float, w << 16); }
__device__ __forceinline__ float bfhi(unsigned w) { return __builtin_bit_cast(float, w & 0xffff0000u); }
__device__ __forceinline__ float sigm(float x) { return 1.0f / (1.0f + __expf(-x)); }
__device__ __forceinline__ float silu(float x) { return x / (1.0f + __expf(-x)); }
__device__ __forceinline__ int crow(int r, int hi) { return (r & 3) + 8 * (r >> 2) + 4 * hi; }
__device__ __forceinline__ unsigned cvtpk(float lo, float hi) { unsigned r; asm volatile("v_cvt_pk_bf16_f32 %0, %1, %2" : "=v"(r) : "v"(lo), "v"(hi)); return r; }
__device__ __forceinline__ float wave_sum(float v) {
#pragma unroll
    for (int o = 1; o < 64; o <<= 1) v += __shfl_xor(v, o);
    return v;
}
#define XB_TMO      128
#define XB_XCNT(j)  (256  + 64 * (j))
#define XB_XSUB(j)  (1280 + 64 * (j))
#define XB_XGEN(j)  (2304 + 64 * (j))
#define XB_TOP      3328
#define XB_TOPGEN   3392
#define XCD_BAR_WORDS 3456
#define XB_SPIN_CAP (1u << 18)

__device__ __forceinline__ unsigned xb_ld(unsigned* p)              { return __hip_atomic_load(p, __ATOMIC_RELAXED, __HIP_MEMORY_SCOPE_AGENT); }
__device__ __forceinline__ unsigned xb_add(unsigned* p, unsigned v) { return __hip_atomic_fetch_add(p, v, __ATOMIC_RELAXED, __HIP_MEMORY_SCOPE_AGENT); }
__device__ __forceinline__ unsigned xb_xcc_id() { return (unsigned)__builtin_amdgcn_s_getreg((3 << 11) | 20) & 0xFu; }
#define XB_SPIN(cond, bar) do { unsigned _sp = 0; while (cond) { __builtin_amdgcn_s_sleep(1); \
    if ((++_sp & 255u) == 0u) { if (xb_ld(&(bar)[XB_TMO])) break; if (_sp > XB_SPIN_CAP) { atomicAdd(&(bar)[XB_TMO], 1u); break; } } } } while (0)

struct XcdBarrier {
    unsigned* bar; unsigned x;
    volatile LAS unsigned* st;
};

__device__ __forceinline__ XcdBarrier xcd_barrier_post(unsigned* bar, volatile LAS unsigned* st) {
    XcdBarrier b; b.bar = bar; b.x = xb_xcc_id(); b.st = st;
    if (threadIdx.x == 0) (void)xb_add(&bar[XB_XCNT(b.x)], 1u);
    return b;
}
__device__ __forceinline__ void xcd_barrier_complete(unsigned* bar, unsigned x, unsigned& nloc, unsigned& nx) {
    const unsigned G = gridDim.x * gridDim.y * gridDim.z;
    unsigned sum, cnt, mine, sp = 0u;
    for (;;) {
        sum = 0u; cnt = 0u; mine = 0u;
#pragma unroll 1
        for (unsigned j = 0; j < 16; ++j) { const unsigned c = xb_ld(&bar[XB_XCNT(j)]); sum += c; cnt += (c > 0u) ? 1u : 0u; mine = (j == x) ? c : mine; }
        if (sum == G) break;
        __builtin_amdgcn_s_sleep(1);
        if ((++sp & 255u) == 0u) { if (xb_ld(&bar[XB_TMO])) break; if (sp > XB_SPIN_CAP) { atomicAdd(&bar[XB_TMO], 1u); break; } }
    }
    nloc = mine > 0u ? mine : 1u; nx = cnt > 0u ? cnt : 1u;
}

__device__ __forceinline__ void xcd_barrier(const XcdBarrier& b) {
    asm volatile("s_waitcnt vmcnt(0)" ::: "memory");
    __syncthreads();
    if (threadIdx.x == 0) {
        unsigned* bar = b.bar;
        __builtin_amdgcn_s_waitcnt(0);
        unsigned nloc = b.st[0], nx = b.st[1];
        if (nloc == 0u) { xcd_barrier_complete(bar, b.x, nloc, nx); b.st[0] = nloc; b.st[1] = nx; }
        const unsigned old = xb_add(&bar[XB_XSUB(b.x)], 1u);
        const unsigned gen = old / nloc;
        if (old + 1u == (gen + 1u) * nloc) {
            __builtin_amdgcn_fence(__ATOMIC_RELEASE, "agent");
            asm volatile("s_waitcnt vmcnt(0)" ::: "memory");
            const unsigned og = xb_add(&bar[XB_TOP], 1u);
            const unsigned tg = og / nx;
            if (og + 1u == (tg + 1u) * nx) xb_add(&bar[XB_TOPGEN], 1u);
            else XB_SPIN(xb_ld(&bar[XB_TOPGEN]) == tg, bar);
            __builtin_amdgcn_fence(__ATOMIC_ACQUIRE, "agent");
            xb_add(&bar[XB_XGEN(b.x)], 1u);
            asm volatile("s_waitcnt vmcnt(0)" ::: "memory");
        } else {
            XB_SPIN(xb_ld(&bar[XB_XGEN(b.x)]) == gen, bar);
            __builtin_amdgcn_fence(__ATOMIC_ACQUIRE, "agent");
            asm volatile("s_waitcnt vmcnt(0)" ::: "memory");
        }
    }
    __syncthreads();
}

struct Frame {
    LAS unsigned char* lds;
    volatile LAS unsigned* MISC;
    gu32* ctl;
    int tid, lane, wave, vcu, G;
    unsigned char* ws; float* out;
    const float* const* in;
};
__device__ __forceinline__ bf16* ws_bf(const Frame& F, size_t off) { return (bf16*)(F.ws + off); }
__device__ __forceinline__ float* ws_f(const Frame& F, size_t off) { return (float*)(F.ws + off); }

__device__ __forceinline__ int launder_u(int v) { asm volatile("" : "+v"(v)); return __builtin_amdgcn_readfirstlane(v); }
template <class T> __device__ __forceinline__ T* launder_p(T* p) { const unsigned long long a = (unsigned long long)p;
    const unsigned lo = (unsigned)launder_u((int)(unsigned)a), hi = (unsigned)launder_u((int)(unsigned)(a >> 32)); return (T*)(((unsigned long long)hi << 32) | lo); }
struct Roots { unsigned char* ws; float* out; LAS unsigned char* lds; };
__device__ __forceinline__ void launder_from(Frame& F, const Roots& R) {
    F.ws = launder_p(R.ws); F.out = launder_p(R.out); F.ctl = (gu32*)(F.ws + WS_CTL);
    F.G = launder_u((int)gridDim.x); { const int bx = launder_u((int)blockIdx.x); F.vcu = (F.G % 8 == 0) ? (bx % 8) * (F.G / 8) + bx / 8 : bx; }
    { const unsigned lb = (unsigned)launder_u((int)(unsigned)(uintptr_t)R.lds); F.lds = (LAS unsigned char*)(uintptr_t)lb; F.MISC = (volatile LAS unsigned*)(F.lds + MISC_OFF); }
    { int t = threadIdx.x; asm volatile("" : "+v"(t)); F.tid = t; F.lane = t & 63; F.wave = __builtin_amdgcn_readfirstlane(t >> 6); }
}

__device__ __forceinline__ int q_next(Frame& F, int qid) {
    __syncthreads();
    if (F.tid == 0) F.MISC[0] = __hip_atomic_fetch_add(F.ctl + CW_Q + 64 * qid, 1u, RLX_AGENT);
    __syncthreads();
    return (int)F.MISC[0];
}

__device__ __forceinline__ int win_src_col(int np) { return np < 5632 ? np : (np < 11776 ? np + 48 : (np < 11824 ? np - 11776 + 5632 : -1)); }
template <int MODE>
__device__ __forceinline__ void transpose_item(const float* W, int K, int N, bf16* WT, LAS float* scr, int kb, int nb, int lane) {
    const int k0 = 64 * kb, n0 = 64 * nb, rr = lane >> 4, cq = lane & 15;
    int nsrc = n0 + 4 * cq; if (MODE == 1) nsrc = win_src_col(nsrc);
    const float* src = W + (size_t)(k0 + rr) * N + (nsrc >= 0 ? nsrc : 0);
    f32x4 v[16];
#pragma unroll
    for (int i = 0; i < 16; ++i) v[i] = (nsrc >= 0) ? *(const GAS f32x4*)(src + (size_t)(4 * i) * N) : (f32x4){0.f, 0.f, 0.f, 0.f};
#pragma unroll
    for (int i = 0; i < 16; ++i) { LAS float* d = scr + (4 * i + rr) * 65 + 4 * cq; d[0] = v[i][0]; d[1] = v[i][1]; d[2] = v[i][2]; d[3] = v[i][3]; }
    LDS_WAIT(); asm volatile("" ::: "memory");
    const int c = lane & 7;
#pragma unroll
    for (int j = 0; j < 8; ++j) { const int n = (lane >> 3) + 8 * j; const LAS float* s = scr + (8 * c) * 65 + n;
        v4u o; o.x = pk2(s[0 * 65], s[1 * 65]); o.y = pk2(s[2 * 65], s[3 * 65]); o.z = pk2(s[4 * 65], s[5 * 65]); o.w = pk2(s[6 * 65], s[7 * 65]);
        *(GAS v4u*)(WT + (size_t)(n0 + n) * K + k0 + 8 * c) = o; }
    LDS_WAIT(); asm volatile("" ::: "memory");
}

__device__ __forceinline__ void ada_item(Frame& F, int item) {
    const int l = item / 384, n0 = (item % 384) * 32;
    const float* W = F.in[2] + (size_t)l * DM * 12288;
    const LAS float* cl = (const LAS float*)F.lds;
    LAS float* red = (LAS float*)(F.lds + 65536);
    const int kq = F.lane >> 3, nq = F.lane & 7;
    f32x4 acc[4];
#pragma unroll
    for (int b = 0; b < 4; ++b) acc[b] = (f32x4){0.f, 0.f, 0.f, 0.f};
#pragma unroll 8
    for (int i = 0; i < 64; ++i) {
        const int k = 64 * i + 8 * F.wave + kq;
        const f32x4 w = *(const GAS f32x4*)(W + (size_t)k * 12288 + n0 + 4 * nq);
#pragma unroll
        for (int b = 0; b < 4; ++b) acc[b] += w * cl[b * DM + k];
    }
#pragma unroll
    for (int b = 0; b < 4; ++b)
#pragma unroll
        for (int e = 0; e < 4; ++e) { float v = acc[b][e]; v += __shfl_xor(v, 8); v += __shfl_xor(v, 16); v += __shfl_xor(v, 32);
            if (kq == 0) red[(F.wave * 4 + b) * 32 + 4 * nq + e] = v; }
    __syncthreads();
    if (F.tid < 128) { const int b = F.tid >> 5, n = F.tid & 31; float s = 0.f;
#pragma unroll
        for (int w = 0; w < 8; ++w) s += red[(w * 4 + b) * 32 + n];
        ws_f(F, WS_MOD)[(size_t)(l * 4 + b) * 12288 + n0 + n] = s + F.in[3][l * 12288 + n0 + n]; }
    __syncthreads();
}

__device__ __forceinline__ void p0_prologue(Frame& F) {
    { LAS float* cl = (LAS float*)F.lds;
      for (int i = F.tid; i < 4 * DM / 4; i += NWAVES * 64) ((LAS f32x4*)cl)[i] = ((const GAS f32x4*)F.in[1])[i];
      __syncthreads();
      for (int it = F.vcu; it < 768; it += F.G) ada_item(F, it);
      __syncthreads(); }
    LAS float* scr = (LAS float*)(F.lds + F.wave * 16640);
    const int gw = F.vcu * NWAVES + F.wave, NGW = F.G * NWAVES;
    constexpr int I_WIN = 64 * (NPAD / 64), I_WOUT = 64 * (DM / 64), I_W1 = 64 * 4, I_W2 = 4 * 2, I_RG = 2 * 2;
    constexpr int NIT = 2 * I_WIN + 2 * I_WOUT + 4 * I_W1 + 4 * I_W2 + 32 * I_RG;
    for (int it = gw; it < NIT; it += NGW) {
        int r = it;
        if (r < 2 * I_WIN) { const int l = r / I_WIN; r -= l * I_WIN; const int nblk = NPAD / 64;
            transpose_item<1>(F.in[4] + (size_t)l * DM * NIN, DM, NIN, ws_bf(F, WS_WIN) + (size_t)l * NPAD * DM, scr, r / nblk, r % nblk, F.lane); continue; }
        r -= 2 * I_WIN;
        if (r < 2 * I_WOUT) { const int l = r / I_WOUT; r -= l * I_WOUT; const int nblk = DM / 64;
            transpose_item<0>(F.in[20] + (size_t)l * DM * DM, DM, DM, ws_bf(F, WS_WOUT) + (size_t)l * DM * DM, scr, r / nblk, r % nblk, F.lane); continue; }
        r -= 2 * I_WOUT;
        if (r < 4 * I_W1) { const int lk = r / I_W1; r -= lk * I_W1; const int l = lk >> 1, kv = lk & 1;
            transpose_item<0>((kv ? F.in[16] : F.in[14]) + (size_t)l * 4096 * 256, 4096, 256, ws_bf(F, WS_W1T) + (size_t)lk * 256 * 4096, scr, r / 4, r % 4, F.lane); continue; }
        r -= 4 * I_W1;
        if (r < 4 * I_W2) { const int lk = r / I_W2; r -= lk * I_W2; const int l = lk >> 1, kv = lk & 1;
            transpose_item<0>((kv ? F.in[17] : F.in[15]) + (size_t)l * 256 * 128, 256, 128, ws_bf(F, WS_W2T) + (size_t)lk * 128 * 256, scr, r / 2, r % 2, F.lane); continue; }
        r -= 4 * I_W2;
        { const int mi = r / I_RG; r -= mi * I_RG; const int l = mi >> 4, gate = (mi >> 3) & 1, n = mi & 7;
            transpose_item<0>((gate ? F.in[9] : F.in[7]) + (size_t)(l * 8 + n) * 128 * 128, 128, 128, ws_bf(F, WS_RGW) + (size_t)mi * 128 * 128, scr, r / 2, r % 2, F.lane); }
    }
    { const int g = F.vcu * NWAVES * 64 + F.tid;
      if (g < 2 * 8 * 128 / 2) { const int kv = g >> 9, rest = g & 511, bg = rest >> 6, e = rest & 63;
          ((unsigned*)(F.ws + (kv ? WS_VCMP : WS_KCMP)))[(size_t)(bg * 128 + 127) * 64 + e] = 0u; } }
}

__device__ __forceinline__ void p1_u0(Frame& F) {
    const int gw = F.vcu * NWAVES + F.wave, NGW = F.G * NWAVES;
    const float* mod = ws_f(F, WS_MOD);
    bf16* U = ws_bf(F, WS_U);
    for (int m = gw; m < MROWS; m += NGW) {
        const int b = m / SEQ;
        const GAS f32x4* xr = (const GAS f32x4*)(F.in[0] + (size_t)m * DM);
        const GAS f32x4* sh = (const GAS f32x4*)(mod + (size_t)b * 12288);
        const GAS f32x4* sc = (const GAS f32x4*)(mod + (size_t)b * 12288 + DM);
        GAS v2u* o = (GAS v2u*)(U + (size_t)m * DM);
#pragma unroll 4
        for (int j = 0; j < 16; ++j) { const int idx = 64 * j + F.lane; const f32x4 v = xr[idx] * (sc[idx] + 1.0f) + sh[idx];
            v2u w; w.x = pk2(v[0], v[1]); w.y = pk2(v[2], v[3]); o[idx] = w; }
    }
}

__device__ __forceinline__ void ln_phase(Frame& F, int l, float* xout, bool unext) {
    const int gw = F.vcu * NWAVES + F.wave, NGW = F.G * NWAVES;
    const float* Vb = ws_f(F, WS_V);
    const float* mod = ws_f(F, WS_MOD) + (size_t)(l + 1) * 4 * 12288;
    bf16* U = ws_bf(F, WS_U);
    const GAS f32x4* g4 = (const GAS f32x4*)(F.in[21] + (size_t)l * DM);
    const GAS f32x4* b4 = (const GAS f32x4*)(F.in[22] + (size_t)l * DM);
    for (int m = gw; m < MROWS; m += NGW) {
        const int b = m / SEQ;
        const GAS f32x4* vr = (const GAS f32x4*)(Vb + (size_t)m * DM);
        f32x4 v[16]; float s = 0.f;
#pragma unroll
        for (int j = 0; j < 16; ++j) { v[j] = vr[64 * j + F.lane]; s += (v[j][0] + v[j][1]) + (v[j][2] + v[j][3]); }
        const float mean = wave_sum(s) * (1.0f / DM); float s2 = 0.f;
#pragma unroll
        for (int j = 0; j < 16; ++j) { v[j] = v[j] - mean; s2 += (v[j][0] * v[j][0] + v[j][1] * v[j][1]) + (v[j][2] * v[j][2] + v[j][3] * v[j][3]); }
        const float rstd = 1.0f / sqrtf(wave_sum(s2) * (1.0f / DM) + LN_EPS);
        GAS f32x4* xo = (GAS f32x4*)(xout + (size_t)m * DM);
        if (unext) {
            const GAS f32x4* sh = (const GAS f32x4*)(mod + (size_t)b * 12288);
            const GAS f32x4* sc = (const GAS f32x4*)(mod + (size_t)b * 12288 + DM);
            GAS v2u* o = (GAS v2u*)(U + (size_t)m * DM);
#pragma unroll
            for (int j = 0; j < 16; ++j) { const int idx = 64 * j + F.lane; const f32x4 y = v[j] * rstd * g4[idx] + b4[idx]; xo[idx] = y;
                const f32x4 u = y * (sc[idx] + 1.0f) + sh[idx]; v2u w; w.x = pk2(u[0], u[1]); w.y = pk2(u[2], u[3]); o[idx] = w; }
        } else {
#pragma unroll
            for (int j = 0; j < 16; ++j) { const int idx = 64 * j + F.lane; xo[idx] = v[j] * rstd * g4[idx] + b4[idx]; }
        }
    }
}

__device__ __forceinline__ f32x16 mfma32(bf16x8 a, bf16x8 b, f32x16 c) { return __builtin_amdgcn_mfma_f32_32x32x16_bf16(a, b, c, 0, 0, 0); }
__device__ __forceinline__ f32x4 mfma16(bf16x8 a, bf16x8 b, f32x4 c) { return __builtin_amdgcn_mfma_f32_16x16x32_bf16(a, b, c, 0, 0, 0); }
__device__ __forceinline__ bf16x8 as_bf16x8(v4u w) { return __builtin_bit_cast(bf16x8, w); }

typedef float f32x2v __attribute__((ext_vector_type(2)));
__device__ __forceinline__ void load16(const bf16* p, float (&x)[16]) {
    const v4u a = *(const GAS v4u*)p, b = *(const GAS v4u*)(p + 8);
    x[0] = bflo(a.x); x[1] = bfhi(a.x); x[2] = bflo(a.y); x[3] = bfhi(a.y); x[4] = bflo(a.z); x[5] = bfhi(a.z); x[6] = bflo(a.w); x[7] = bfhi(a.w);
    x[8] = bflo(b.x); x[9] = bfhi(b.x); x[10] = bflo(b.y); x[11] = bfhi(b.y); x[12] = bflo(b.z); x[13] = bfhi(b.z); x[14] = bflo(b.w); x[15] = bfhi(b.w);
}
__device__ __forceinline__ void store16_lds(LAS bf16* p, const float (&x)[16]) {
    *(LAS v4u*)p = (v4u){pk2(x[0], x[1]), pk2(x[2], x[3]), pk2(x[4], x[5]), pk2(x[6], x[7])};
    *(LAS v4u*)(p + 8) = (v4u){pk2(x[8], x[9]), pk2(x[10], x[11]), pk2(x[12], x[13]), pk2(x[14], x[15])};
}
__device__ __forceinline__ void lane_scan16(float (&x)[16], int lane) {
#pragma unroll
    for (int d = 1; d < 64; d <<= 1) {
#pragma unroll
        for (int e = 0; e < 16; ++e) { const float y = __shfl_up(x[e], d); if (lane >= d) x[e] += y; } }
}

__device__ __forceinline__ void rg1_item(Frame& F, int l, int item) {
    const int n = item & 7, c = (item >> 3) & 31, b = item >> 8;
    LAS bf16*  xcb = (LAS bf16*)(F.lds);
    LAS float* aL  = (LAS float*)(F.lds + 17408);
    LAS float* bxL = (LAS float*)(F.lds + 51200);
    LAS float* qs  = (LAS float*)(F.lds + 84992);
    const bf16* P = ws_bf(F, WS_P);
    const size_t rowbase = (size_t)b * SEQ + 64 * c;
    {
        const int t = F.lane, ch0 = n * 128 + 16 * F.wave;
        float acc[16];
        const float* cw = F.in[5] + (size_t)l * 4 * 1024 + ch0; const float* cbp = F.in[6] + (size_t)l * 1024 + ch0;
#pragma unroll
        for (int e = 0; e < 16; ++e) acc[e] = cbp[e];
#pragma unroll
        for (int j = 0; j < 4; ++j) { const int tl = 64 * c + t - 3 + j;
            float xv[16];
            if (tl >= 0) load16(P + ((size_t)b * SEQ + tl) * NPAD + PC_RGX + ch0, xv);
            else {
#pragma unroll
                for (int e = 0; e < 16; ++e) xv[e] = 0.f; }
#pragma unroll
            for (int e = 0; e < 16; ++e) acc[e] = fmaf(cw[j * 1024 + e], xv[e], acc[e]); }
        store16_lds(xcb + t * 136 + 16 * F.wave, acc);
    }
    __syncthreads();
    {
        const int rt = F.wave & 1, ct = F.wave >> 1, r32 = F.lane & 31, hi = F.lane >> 5;
        const bf16* WA = ws_bf(F, WS_RGW) + (size_t)((l * 2 + 0) * 8 + n) * 16384;
        const bf16* WX = ws_bf(F, WS_RGW) + (size_t)((l * 2 + 1) * 8 + n) * 16384;
        f32x16 ga = {}, gx = {};
#pragma unroll
        for (int s = 0; s < 8; ++s) {
            const bf16x8 a = *(const LAS bf16x8*)(xcb + (32 * rt + r32) * 136 + 16 * s + 8 * hi);
            const bf16x8 wa = *(const GAS bf16x8*)(WA + (32 * ct + r32) * 128 + 16 * s + 8 * hi);
            const bf16x8 wx = *(const GAS bf16x8*)(WX + (32 * ct + r32) * 128 + 16 * s + 8 * hi);
            ga = mfma32(a, wa, ga); gx = mfma32(a, wx, gx);
        }
        const int e = 32 * ct + r32, che = n * 128 + e;
        const float ba_ = F.in[8][l * 1024 + che], bx_ = F.in[10][l * 1024 + che], lam = F.in[11][l * 1024 + che];
        const float sp8 = 8.0f * log1pf(__expf(-lam));
#pragma unroll
        for (int r = 0; r < 16; ++r) { const int t = 32 * rt + crow(r, hi);
            const float rg = sigm(ga[r] + ba_), ig = sigm(gx[r] + bx_);
            const float la = -sp8 * rg; const float a = __expf(la); float mult = sqrtf(-expm1f(2.0f * la)); if (c == 0 && t == 0) mult = 1.0f;
            aL[t * 132 + e] = a; bxL[t * 132 + e] = mult * ig * bf2f(xcb[t * 136 + e]); }
    }
    __syncthreads();
    {
        const int d = F.tid & 127, tq = F.tid >> 7, ch = n * 128 + d;
        float Ap = 1.0f, H = 0.f;
#pragma unroll
        for (int i = 0; i < 16; ++i) { const float av = aL[(16 * tq + i) * 132 + d], bv = bxL[(16 * tq + i) * 132 + d]; H = av * H + bv; Ap *= av; }
        qs[(tq * 128 + d) * 2 + 0] = Ap; qs[(tq * 128 + d) * 2 + 1] = H;
        { const int tr = F.tid >> 3, cc = (F.tid & 7) * 16;
          float* Ag = ws_f(F, WS_OACC) + (rowbase + tr) * D_RG + n * 128 + cc; float* Bg = ws_f(F, WS_OACC) + (size_t)MROWS * D_RG + (rowbase + tr) * D_RG + n * 128 + cc;
#pragma unroll
          for (int q4 = 0; q4 < 4; ++q4) { *(GAS f32x4*)(Ag + 4 * q4) = *(const LAS f32x4*)(aL + tr * 132 + cc + 4 * q4); *(GAS f32x4*)(Bg + 4 * q4) = *(const LAS f32x4*)(bxL + tr * 132 + cc + 4 * q4); } }
        __syncthreads();
        if (tq == 3) { float hin = 0.f, atot = 1.0f;
#pragma unroll
            for (int q = 0; q < 3; ++q) { const float aq = qs[(q * 128 + d) * 2], hq = qs[(q * 128 + d) * 2 + 1]; hin = aq * hin + hq; atot *= aq; }
            ws_f(F, WS_RGSA)[(size_t)(b * 32 + c) * 1024 + ch] = atot * Ap; ws_f(F, WS_RGSH)[(size_t)(b * 32 + c) * 1024 + ch] = Ap * hin + H; }
    }
    __syncthreads();
}
__device__ __forceinline__ void rg_pass2(Frame& F) {
    const int g = F.vcu * NWAVES * 64 + F.tid;
    if (g < BATCH * D_RG) { const int b = g >> 10, ch = g & 1023; float h = 0.f;
        const float* A = ws_f(F, WS_RGSA); const float* Hh = ws_f(F, WS_RGSH); float* C = ws_f(F, WS_RGC);
#pragma unroll 8
        for (int c = 0; c < 32; ++c) { const size_t idx = (size_t)(b * 32 + c) * 1024 + ch; C[idx] = h; h = A[idx] * h + Hh[idx]; } }
}
__device__ __forceinline__ void rg_pass3(Frame& F) {
    const bf16* P = ws_bf(F, WS_P); bf16* Y = ws_bf(F, WS_YCAT);
    const float* Ag = ws_f(F, WS_OACC); const float* Bg = Ag + (size_t)MROWS * D_RG; const float* C = ws_f(F, WS_RGC);
    for (int g = F.vcu * NWAVES * 64 + F.tid; g < BATCH * 32 * (D_RG / 2); g += F.G * NWAVES * 64) {
        const int cp = g & 511, bc = g >> 9, b = bc >> 5, c = bc & 31, ch = 2 * cp;
        const size_t row0 = (size_t)b * SEQ + 64 * c;
        float h0 = C[(size_t)bc * 1024 + ch], h1 = C[(size_t)bc * 1024 + ch + 1];
#pragma unroll 8
        for (int t = 0; t < 64; ++t) { const size_t row = row0 + t;
            const f32x2v a2 = *(const GAS f32x2v*)(Ag + row * D_RG + ch), b2 = *(const GAS f32x2v*)(Bg + row * D_RG + ch);
            const unsigned gw_ = *(const GAS unsigned*)(P + row * NPAD + PC_RGG + ch);
            h0 = a2.x * h0 + b2.x; h1 = a2.y * h1 + b2.y;
            *(GAS unsigned*)(Y + row * DM + ch) = pk2(h0 * silu(bflo(gw_)), h1 * silu(bfhi(gw_))); }
    }
}

__device__ __forceinline__ float hg_lower_bound(const Frame& F, int l, int ch) {
    if (l == 0) return 0.f;
    return 1.0f / (1.0f + __expf(F.in[18][ch] - F.in[18][1024 + ch]));
}
__device__ __forceinline__ void hg_lower_bound16(const Frame& F, int l, int ch0, float (&lb)[16]) {
    if (l == 0) {
#pragma unroll
        for (int e = 0; e < 16; ++e) lb[e] = 0.f;
    } else {
#pragma unroll
        for (int q = 0; q < 4; ++q) { const f32x4 h0 = *(const GAS f32x4*)(F.in[18] + ch0 + 4 * q), h1 = *(const GAS f32x4*)(F.in[18] + 1024 + ch0 + 4 * q);
#pragma unroll
            for (int e = 0; e < 4; ++e) lb[4 * q + e] = 1.0f / (1.0f + __expf(h0[e] - h1[e])); }
    }
}
__device__ __forceinline__ void hg_fk(float z, float lb, int l, float& lf, float& kk) {
    if (l == 0) { lf = fminf(z, 0.f) - log1pf(__expf(-fabsf(z))); kk = sigm(-z); }
    else { const float sg = sigm(z); lf = __logf(lb + (1.0f - lb) * sg); kk = (1.0f - lb) * sigm(-z); }
}
__device__ __forceinline__ void hg1_item(Frame& F, int l, int item) {
    const int c = item & 31, bh = item >> 5, b = bh >> 3, h = bh & 7;
    LAS bf16* kdT = (LAS bf16*)(F.lds);
    LAS bf16* vT  = (LAS bf16*)(F.lds + 18432);
    const bf16* P = ws_bf(F, WS_P);
    const int t = F.lane, k0 = 16 * F.wave, ch0 = h * 128 + k0;
    const size_t row = (size_t)b * SEQ + 64 * c + t;
    float bcum[16], kk[16];
    {   float z[16], lb[16]; load16(P + row * NPAD + PC_HGF + ch0, z); hg_lower_bound16(F, l, ch0, lb);
#pragma unroll
        for (int e = 0; e < 16; ++e) hg_fk(z[e], lb[e], l, bcum[e], kk[e]); }
    {   const v4u va = *(const GAS v4u*)(P + row * NPAD + PC_HGI + ch0), vb = *(const GAS v4u*)(P + row * NPAD + PC_HGI + ch0 + 8);
        const unsigned vw[8] = {va.x, va.y, va.z, va.w, vb.x, vb.y, vb.z, vb.w};
#pragma unroll
        for (int e = 0; e < 16; ++e) vT[(k0 + e) * 72 + t] = (bf16)((e & 1) ? (vw[e >> 1] >> 16) : (vw[e >> 1] & 0xffffu)); }
    lane_scan16(bcum, t);
#pragma unroll
    for (int e = 0; e < 16; ++e) { const float tot = __shfl(bcum[e], 63);
        kdT[(k0 + e) * 72 + t] = (bf16)f2bf(kk[e] * __expf(tot - bcum[e]));
        if (t == 63) ws_f(F, WS_HDEC)[(size_t)item * 128 + k0 + e] = __expf(tot); }
    __syncthreads();
    {
        const int vt = F.wave >> 1, kt0 = 2 * (F.wave & 1), r32 = F.lane & 31, hi = F.lane >> 5;
        f32x16 a0 = {}, a1 = {};
#pragma unroll
        for (int s = 0; s < 4; ++s) {
            const bf16x8 a = *(const LAS bf16x8*)(vT + (32 * vt + r32) * 72 + 16 * s + 8 * hi);
            const bf16x8 b0 = *(const LAS bf16x8*)(kdT + (32 * kt0 + r32) * 72 + 16 * s + 8 * hi);
            const bf16x8 b1 = *(const LAS bf16x8*)(kdT + (32 * (kt0 + 1) + r32) * 72 + 16 * s + 8 * hi);
            a0 = mfma32(a, b0, a0); a1 = mfma32(a, b1, a1);
        }
        float* HS = ws_f(F, WS_HS) + (size_t)item * 16384;
#pragma unroll
        for (int r = 0; r < 16; ++r) { const int v = 32 * vt + crow(r, hi); HS[v * 128 + 32 * kt0 + r32] = a0[r]; HS[v * 128 + 32 * kt0 + 32 + r32] = a1[r]; }
    }
    __syncthreads();
}
__device__ __forceinline__ void hg_pass2(Frame& F) {
    float* HS = ws_f(F, WS_HS); const float* DEC = ws_f(F, WS_HDEC);
    for (int g = F.vcu * NWAVES * 64 + F.tid; g < 32 * 4096; g += F.G * NWAVES * 64) {
        const int bh = g >> 12, e4 = g & 4095, k4 = (e4 & 31) * 4;
        f32x4 S = {0.f, 0.f, 0.f, 0.f};
#pragma unroll 8
        for (int c = 0; c < 32; ++c) { GAS f32x4* p = (GAS f32x4*)(HS + ((size_t)(bh * 32 + c) * 16384) + e4 * 4);
            const f32x4 tmp = *p; const f32x4 d4 = *(const GAS f32x4*)(DEC + (size_t)(bh * 32 + c) * 128 + k4); *p = S; S = S * d4 + tmp; }
    }
}
__device__ __forceinline__ void hg3_item(Frame& F, int l, int item) {
    const int c = item & 31, bh = item >> 5, b = bh >> 3, h = bh & 7;
    LAS bf16* qi   = (LAS bf16*)(F.lds);
    LAS bf16* qd1  = (LAS bf16*)(F.lds + 17408);
    LAS bf16* kd00 = (LAS bf16*)(F.lds + 26112);
    LAS bf16* kd10 = (LAS bf16*)(F.lds + 34816);
    LAS bf16* kd11 = (LAS bf16*)(F.lds + 43520);
    LAS bf16* sT   = (LAS bf16*)(F.lds + 52224);
    LAS bf16* vT   = (LAS bf16*)(F.lds + 87040);
    LAS bf16* Abf  = (LAS bf16*)(F.lds + 105472);
    LAS float* ssq = (LAS float*)(F.lds + 114688);
    LAS bf16* Yt   = (LAS bf16*)(F.lds);
    const bf16* P = ws_bf(F, WS_P);
    const size_t rowbase = (size_t)b * SEQ + 64 * c;
    {
        const int t = F.lane, k0 = 16 * F.wave, ch0 = h * 128 + k0;
        const size_t row = rowbase + t;
        float bcum[16], kk[16], qv[16];
        {   float z[16], lb[16]; load16(P + row * NPAD + PC_HGF + ch0, z); hg_lower_bound16(F, l, ch0, lb);
#pragma unroll
            for (int e = 0; e < 16; ++e) hg_fk(z[e], lb[e], l, bcum[e], kk[e]); }
        {   load16(P + row * NPAD + PC_HGQ + ch0, qv);
#pragma unroll
            for (int e = 0; e < 16; ++e) qv[e] = silu(qv[e]); }
        {   const v4u va = *(const GAS v4u*)(P + row * NPAD + PC_HGI + ch0), vb = *(const GAS v4u*)(P + row * NPAD + PC_HGI + ch0 + 8);
            const unsigned vw[8] = {va.x, va.y, va.z, va.w, vb.x, vb.y, vb.z, vb.w};
#pragma unroll
            for (int e = 0; e < 16; ++e) vT[(k0 + e) * 72 + t] = (bf16)((e & 1) ? (vw[e >> 1] >> 16) : (vw[e >> 1] & 0xffffu)); }
        lane_scan16(bcum, t);
        float x0[16], x1[16], x2[16];
        const bool lo = t < 32;
#pragma unroll
        for (int e = 0; e < 16; ++e) { const float bref1 = __shfl(bcum[e], 31), run = bcum[e];
            x0[e] = qv[e] * __expf(run);
            x1[e] = lo ? kk[e] * __expf(-run) : qv[e] * __expf(run - bref1);
            x2[e] = kk[e] * __expf(bref1 - run); }
        store16_lds(qi + t * 136 + k0, x0);
        store16_lds((lo ? kd00 + t * 136 : qd1 + (t - 32) * 136) + k0, x1);
        store16_lds((lo ? kd10 + t * 136 : kd11 + (t - 32) * 136) + k0, x2);
    }
    {
        const int v = F.tid >> 2, k0 = (F.tid & 3) * 32;
        const GAS f32x4* src = (const GAS f32x4*)(ws_f(F, WS_HS) + (size_t)item * 16384 + v * 128 + k0);
#pragma unroll
        for (int j = 0; j < 4; ++j) { const f32x4 x0 = src[2 * j], x1 = src[2 * j + 1];
            *(LAS v4u*)(sT + v * 136 + k0 + 8 * j) = (v4u){pk2(x0[0], x0[1]), pk2(x0[2], x0[3]), pk2(x1[0], x1[1]), pk2(x1[2], x1[3])}; }
    }
    __syncthreads();
    const int r32 = F.lane & 31, hi = F.lane >> 5;
    if (F.wave < 4) {
        const int I = (F.wave == 0 || F.wave == 3) ? 0 : 1, J = (F.wave == 2 || F.wave == 3) ? 1 : 0;
        f32x16 a = {};
        if (F.wave != 3) {
            const LAS bf16* Aop = (F.wave == 0) ? qi : qd1;
            const LAS bf16* Bop = (F.wave == 0) ? kd00 : (F.wave == 1 ? kd10 : kd11);
#pragma unroll
            for (int s = 0; s < 8; ++s) a = mfma32(*(const LAS bf16x8*)(Aop + r32 * 136 + 16 * s + 8 * hi), *(const LAS bf16x8*)(Bop + r32 * 136 + 16 * s + 8 * hi), a);
        }
#pragma unroll
        for (int r = 0; r < 16; ++r) { const int tt = crow(r, hi); float x = a[r]; if (I == J && r32 > tt) x = 0.f;
            Abf[(32 * I + tt) * 72 + 32 * J + r32] = (bf16)f2bf(x); }
    }
    __syncthreads();
    {
        const int I = F.wave & 1, vt = F.wave >> 1;
        f32x16 o = {};
#pragma unroll
        for (int s = 0; s < 8; ++s) o = mfma32(*(const LAS bf16x8*)(qi + (32 * I + r32) * 136 + 16 * s + 8 * hi), *(const LAS bf16x8*)(sT + (32 * vt + r32) * 136 + 16 * s + 8 * hi), o);
#pragma unroll
        for (int s = 0; s < 4; ++s) if (s < 2 * (I + 1)) o = mfma32(*(const LAS bf16x8*)(Abf + (32 * I + r32) * 72 + 16 * s + 8 * hi), *(const LAS bf16x8*)(vT + (32 * vt + r32) * 72 + 16 * s + 8 * hi), o);
#pragma unroll
        for (int r = 0; r < 16; ++r) { float ss = o[r] * o[r];
            ss += __shfl_xor(ss, 1); ss += __shfl_xor(ss, 2); ss += __shfl_xor(ss, 4); ss += __shfl_xor(ss, 8); ss += __shfl_xor(ss, 16);
            if (r32 == 0) ssq[(32 * I + crow(r, hi)) * 4 + vt] = ss; }
        __syncthreads();
        const int v = 32 * vt + r32; const float ng = F.in[19][l * 128 + v];
#pragma unroll
        for (int r = 0; r < 16; ++r) { const int t = 32 * I + crow(r, hi);
            const float tot = (ssq[t * 4] + ssq[t * 4 + 1]) + (ssq[t * 4 + 2] + ssq[t * 4 + 3]);
            const float rs = 1.0f / sqrtf(tot * (1.0f / 128.0f) + RMS_EPS);
            Yt[t * 136 + v] = (bf16)f2bf(o[r] * rs * ng); }
    }
    __syncthreads();
    {
        const int t = F.tid >> 3, cc = (F.tid & 7) * 16; const size_t row = rowbase + t;
        const bf16* gp = P + row * NPAD + PC_HGG + h * 128 + cc; bf16* yp = ws_bf(F, WS_YCAT) + row * DM + 3072 + h * 128 + cc;
#pragma unroll
        for (int q2 = 0; q2 < 2; ++q2) { const v4u w = *(const LAS v4u*)(Yt + t * 136 + cc + 8 * q2); const v4u gq = *(const GAS v4u*)(gp + 8 * q2);
            v4u y; y.x = pk2(bflo(w.x) * silu(bflo(gq.x)), bfhi(w.x) * silu(bfhi(gq.x))); y.y = pk2(bflo(w.y) * silu(bflo(gq.y)), bfhi(w.y) * silu(bfhi(gq.y)));
            y.z = pk2(bflo(w.z) * silu(bflo(gq.z)), bfhi(w.z) * silu(bfhi(gq.z))); y.w = pk2(bflo(w.w) * silu(bflo(gq.w)), bfhi(w.w) * silu(bfhi(gq.w)));
            *(GAS v4u*)(yp + 8 * q2) = y; }
    }
    __syncthreads();
}

__device__ __forceinline__ void cmp_item(Frame& F, int l, int item) {
    const int kv = item >> 6, rt = item & 63;
    const int arow = F.lane & 15, kq = F.lane >> 4;
    LAS float* slots = (LAS float*)F.lds;
    LAS bf16* hbf = (LAS bf16*)(F.lds + 65536);
    const bf16* P = ws_bf(F, WS_P);
    int rho = rt * 16 + arow; if (rho > 1015) rho = 1015;
    const int b = rho / 254, rem = rho - b * 254, j = rem >> 1, g = rem & 1;
    const bf16* xrow = P + ((size_t)b * SEQ + 16 * j) * NPAD + PC_KVC + kv * 256 + g * 128;
    const bf16* W1T = ws_bf(F, WS_W1T) + (size_t)(l * 2 + kv) * 256 * 4096;
    const float* pe = (kv ? F.in[13] : F.in[12]) + l * 32 * 128;
    f32x4 acc[16];
#pragma unroll
    for (int n = 0; n < 16; ++n) acc[n] = (f32x4){0.f, 0.f, 0.f, 0.f};
    for (int li = 0; li < 4; ++li) { const int lidx = 4 * F.wave + li;
#pragma unroll
        for (int ds = 0; ds < 4; ++ds) { const int d = 32 * ds + 8 * kq;
            const v4u xa = *(const GAS v4u*)(xrow + (size_t)lidx * NPAD + d);
            const f32x4 p0 = *(const GAS f32x4*)(pe + lidx * 128 + d), p1 = *(const GAS f32x4*)(pe + lidx * 128 + d + 4);
            v4u aw; aw.x = pk2(bflo(xa.x) + p0[0], bfhi(xa.x) + p0[1]); aw.y = pk2(bflo(xa.y) + p0[2], bfhi(xa.y) + p0[3]);
            aw.z = pk2(bflo(xa.z) + p1[0], bfhi(xa.z) + p1[1]); aw.w = pk2(bflo(xa.w) + p1[2], bfhi(xa.w) + p1[3]);
            const bf16x8 a = as_bf16x8(aw); const int kbase = lidx * 128 + d;
#pragma unroll
            for (int n = 0; n < 16; ++n) { const bf16x8 bb = *(const GAS bf16x8*)(W1T + (size_t)(16 * n + arow) * 4096 + kbase); acc[n] = mfma16(a, bb, acc[n]); }
        } }
    if (F.wave >= 4) {
#pragma unroll
        for (int n = 0; n < 16; ++n)
#pragma unroll
            for (int rg = 0; rg < 4; ++rg) slots[((F.wave - 4) * 16 + 4 * kq + rg) * 256 + 16 * n + arow] = acc[n][rg]; }
    __syncthreads();
    if (F.wave < 4) {
#pragma unroll
        for (int n = 0; n < 16; ++n)
#pragma unroll
            for (int rg = 0; rg < 4; ++rg) slots[(F.wave * 16 + 4 * kq + rg) * 256 + 16 * n + arow] += acc[n][rg]; }
    __syncthreads();
#pragma unroll
    for (int e = 0; e < 8; ++e) { const int idx = F.tid * 8 + e; const float s = (slots[idx] + slots[4096 + idx]) + (slots[8192 + idx] + slots[12288 + idx]);
        hbf[(idx >> 8) * 264 + (idx & 255)] = (bf16)f2bf(silu(s)); }
    __syncthreads();
    {
        const bf16* W2T = ws_bf(F, WS_W2T) + (size_t)(l * 2 + kv) * 128 * 256;
        f32x4 a2 = {0.f, 0.f, 0.f, 0.f};
#pragma unroll
        for (int ks = 0; ks < 8; ++ks) { const bf16x8 a = *(const LAS bf16x8*)(hbf + arow * 264 + 32 * ks + 8 * kq);
            const bf16x8 bb = *(const GAS bf16x8*)(W2T + (size_t)(16 * F.wave + arow) * 256 + 32 * ks + 8 * kq); a2 = mfma16(a, bb, a2); }
        bf16* CMP = ws_bf(F, kv ? WS_VCMP : WS_KCMP);
#pragma unroll
        for (int rg = 0; rg < 4; ++rg) { const int rho2 = rt * 16 + 4 * kq + rg;
            if (rho2 < 1016) { const int b2 = rho2 / 254, rem2 = rho2 - b2 * 254, j2 = rem2 >> 1, g2 = rem2 & 1;
                CMP[((size_t)(b2 * 2 + g2) * 128 + j2) * 128 + 16 * F.wave + arow] = (bf16)f2bf(a2[rg]); } }
    }
    __syncthreads();
}

#define KSWZ(row, colB) ((row) * 256 + ((colB) ^ (((row) & 7) << 4)))
__device__ __forceinline__ int v_st(int k, int c) { const int kk = (k & ~0xC) | ((k & 4) << 1) | ((k & 8) >> 1); return ((kk >> 3) * 4 + (c >> 5)) * 512 + ((kk & 7) * 32 + (c & 31)) * 2; }
__device__ __forceinline__ int v_rd_base(int lane) { return ((lane & 3) << 3) | (((lane >> 2) & 3) << 6) | (((lane >> 4) & 1) << 5) | (((lane >> 5) & 1) << 8); }
constexpr int v_rd_off(int d0, int ks, int half) { return d0 * 512 + ks * 4096 + half * 2048; }
template <int OFF> __device__ __forceinline__ s16x4 tr_read(int vb) {
    s16x4 r; asm volatile("ds_read_b64_tr_b16 %0, %1 offset:%2" : "=&v"(r) : "v"(vb), "i"(OFF) : "memory"); return r;
}
template <int D0> __device__ __forceinline__ void pv_one(f32x16& od, int vb, bf16x8 pa0, bf16x8 pa1, bf16x8 pa2, bf16x8 pa3) {
    const s16x4 l0 = tr_read<v_rd_off(D0, 0, 0)>(vb), h0 = tr_read<v_rd_off(D0, 0, 1)>(vb), l1 = tr_read<v_rd_off(D0, 1, 0)>(vb), h1 = tr_read<v_rd_off(D0, 1, 1)>(vb);
    const s16x4 l2 = tr_read<v_rd_off(D0, 2, 0)>(vb), h2 = tr_read<v_rd_off(D0, 2, 1)>(vb), l3 = tr_read<v_rd_off(D0, 3, 0)>(vb), h3 = tr_read<v_rd_off(D0, 3, 1)>(vb);
    asm volatile("s_waitcnt lgkmcnt(0)" ::: "memory"); SBAR();
#define PK(L, H) (bf16x8){L[0], L[1], L[2], L[3], H[0], H[1], H[2], H[3]}
    od = mfma32(pa0, PK(l0, h0), od);
    od = mfma32(pa1, PK(l1, h1), od);
    od = mfma32(pa2, PK(l2, h2), od);
    od = mfma32(pa3, PK(l3, h3), od);
#undef PK
}
__device__ __forceinline__ void pv_d0(f32x16* o, int vb, bf16x8 pa0, bf16x8 pa1, bf16x8 pa2, bf16x8 pa3) {
    pv_one<0>(o[0], vb, pa0, pa1, pa2, pa3); pv_one<1>(o[1], vb, pa0, pa1, pa2, pa3); pv_one<2>(o[2], vb, pa0, pa1, pa2, pa3); pv_one<3>(o[3], vb, pa0, pa1, pa2, pa3);
}
__device__ __forceinline__ void qkt(f32x16& p0, f32x16& p1, const LAS char* Ks, const bf16x8* qr, int r32, int hi) {
    p0 = f32x16{}; p1 = f32x16{};
#pragma unroll
    for (int d0 = 0; d0 < 8; ++d0) { const int cb = (d0 * 16 + hi * 8) * 2;
        const bf16x8 b0 = *(const LAS bf16x8*)(Ks + KSWZ(r32, cb));
        const bf16x8 b1 = *(const LAS bf16x8*)(Ks + KSWZ(32 + r32, cb));
        p0 = mfma32(b0, qr[d0], p0);
        p1 = mfma32(b1, qr[d0], p1); }
}
__device__ __forceinline__ void p_to_frag(const f32x16& p0, const f32x16& p1, bf16x8& pa0, bf16x8& pa1, bf16x8& pa2, bf16x8& pa3) {
#define PK4(P, BASE, OUT) do { unsigned a0 = cvtpk(P[BASE + 0], P[BASE + 1]), a1 = cvtpk(P[BASE + 2], P[BASE + 3]);   \
    unsigned b0 = cvtpk(P[BASE + 4], P[BASE + 5]), b1 = cvtpk(P[BASE + 6], P[BASE + 7]);                              \
    auto r0 = __builtin_amdgcn_permlane32_swap(a0, b0, false, false); auto r1 = __builtin_amdgcn_permlane32_swap(a1, b1, false, false); \
    v4u w = {r0[0], r1[0], r0[1], r1[1]}; OUT = as_bf16x8(w); } while (0)
    PK4(p0, 0, pa0); PK4(p0, 8, pa1); PK4(p1, 0, pa2); PK4(p1, 8, pa3);
#undef PK4
}
__device__ __forceinline__ float half_swap_max(float v) { auto rr = __builtin_amdgcn_permlane32_swap(__float_as_uint(v), __float_as_uint(v), false, false); return fmaxf(__uint_as_float(rr[0]), __uint_as_float(rr[1])); }
__device__ __forceinline__ float half_swap_sum(float v) { auto rr = __builtin_amdgcn_permlane32_swap(__float_as_uint(v), __float_as_uint(v), false, false); return __uint_as_float(rr[0]) + __uint_as_float(rr[1]); }

struct KVRegs { v4u k0, k1, v0, v1; };
__device__ __forceinline__ void kv_load(KVRegs& R, const bf16* Kg, const bf16* Vg, size_t ld, int sr, int sc) {
    R.k0 = *(const GAS v4u*)(Kg + (size_t)sr * ld + sc); R.k1 = *(const GAS v4u*)(Kg + (size_t)(32 + sr) * ld + sc);
    R.v0 = *(const GAS v4u*)(Vg + (size_t)sr * ld + sc); R.v1 = *(const GAS v4u*)(Vg + (size_t)(32 + sr) * ld + sc);
}
__device__ __forceinline__ void kv_write(const KVRegs& R, LAS char* Kl, LAS char* Vl, int sr, int sc) {
    *(LAS v4u*)(Kl + KSWZ(sr, sc * 2)) = R.k0; *(LAS v4u*)(Kl + KSWZ(32 + sr, sc * 2)) = R.k1;
    *(LAS v4u*)(Vl + v_st(sr, sc)) = R.v0; *(LAS v4u*)(Vl + v_st(32 + sr, sc)) = R.v1;
}
constexpr int koff(int r) { return (r & 3) + 8 * (r >> 2); }
template <int MODE>
__device__ __forceinline__ void sm_tile(f32x16& p0, f32x16& p1, int dist0, bool rowsel, float C1, float C2, float& m, float& l, float& alpha) {
    float pmax = -1e30f;
#pragma unroll
    for (int r = 0; r < 16; ++r) { const int d = dist0 - koff(r); const bool ok = (MODE == 0) ? (rowsel && d >= 0) : (d >= 0 && d < WINDOW);
        const float lg = ok ? fmaf(p0[r], C1, -C2 * (float)d) : -1e30f; p0[r] = lg; pmax = fmaxf(pmax, lg); }
#pragma unroll
    for (int r = 0; r < 16; ++r) { const int d = dist0 - 32 - koff(r); const bool ok = (MODE == 0) ? (rowsel && d >= 0) : (d >= 0 && d < WINDOW);
        const float lg = ok ? fmaf(p1[r], C1, -C2 * (float)d) : -1e30f; p1[r] = lg; pmax = fmaxf(pmax, lg); }
    pmax = half_swap_max(pmax);
    const float mn = fmaxf(m, pmax);
    alpha = __builtin_amdgcn_exp2f(m - mn);
    const float mref = (mn < -1e29f) ? 0.f : mn;
    float ps = 0.f;
#pragma unroll
    for (int r = 0; r < 16; ++r) { p0[r] = __builtin_amdgcn_exp2f(p0[r] - mref); ps += p0[r]; }
#pragma unroll
    for (int r = 0; r < 16; ++r) { p1[r] = __builtin_amdgcn_exp2f(p1[r] - mref); ps += p1[r]; }
    ps = half_swap_sum(ps);
    l = l * alpha + ps; m = mn;
}
__device__ __forceinline__ void sm_tile_cmp(f32x16& p0, f32x16& p1, int dist0, float C1, float C2, float& m, float& l, float& alpha) {
    float pmax = -1e30f;
#pragma unroll
    for (int r = 0; r < 16; ++r) { const int d = dist0 - 16 * koff(r); const float lg = (d >= 0) ? fmaf(p0[r], C1, -C2 * (float)d) : -1e30f; p0[r] = lg; pmax = fmaxf(pmax, lg); }
#pragma unroll
    for (int r = 0; r < 16; ++r) { const int d = dist0 - 512 - 16 * koff(r); const float lg = (d >= 0) ? fmaf(p1[r], C1, -C2 * (float)d) : -1e30f; p1[r] = lg; pmax = fmaxf(pmax, lg); }
    pmax = half_swap_max(pmax);
    const float mn = fmaxf(m, pmax);
    alpha = __builtin_amdgcn_exp2f(m - mn);
    const float mref = (mn < -1e29f) ? 0.f : mn;
    float ps = 0.f;
#pragma unroll
    for (int r = 0; r < 16; ++r) { p0[r] = __builtin_amdgcn_exp2f(p0[r] - mref); ps += p0[r]; }
#pragma unroll
    for (int r = 0; r < 16; ++r) { p1[r] = __builtin_amdgcn_exp2f(p1[r] - mref); ps += p1[r]; }
    ps = half_swap_sum(ps);
    l = l * alpha + ps; m = mn;
}
__device__ __forceinline__ void sm_tile_fast(f32x16& p0, f32x16& p1, float base, float C1, float C2, float& m, float& l, float& alpha) {
    float pmax = -1e30f;
#pragma unroll
    for (int r = 0; r < 16; ++r) { const float lg = fmaf(p0[r], C1, fmaf((float)koff(r), C2, base)); p0[r] = lg; pmax = fmaxf(pmax, lg); }
#pragma unroll
    for (int r = 0; r < 16; ++r) { const float lg = fmaf(p1[r], C1, fmaf((float)(koff(r) + 32), C2, base)); p1[r] = lg; pmax = fmaxf(pmax, lg); }
    pmax = half_swap_max(pmax);
    const float mn = fmaxf(m, pmax);
    alpha = __builtin_amdgcn_exp2f(m - mn);
    const float mref = (mn < -1e29f) ? 0.f : mn;
    float ps = 0.f;
#pragma unroll
    for (int r = 0; r < 16; ++r) { p0[r] = __builtin_amdgcn_exp2f(p0[r] - mref); ps += p0[r]; }
#pragma unroll
    for (int r = 0; r < 16; ++r) { p1[r] = __builtin_amdgcn_exp2f(p1[r] - mref); ps += p1[r]; }
    ps = half_swap_sum(ps);
    l = l * alpha + ps; m = mn;
}
__device__ __forceinline__ void o_rescale(f32x16* o, float a, LAS float* al_l, int r32, int hi) {
    if (__any(a < 1.0f)) { if (hi == 0) al_l[r32] = a; LDS_WAIT();
#pragma unroll
        for (int r = 0; r < 16; ++r) { const float s = al_l[crow(r, hi)];
#pragma unroll
            for (int d = 0; d < 4; ++d) o[d][r] *= s; }
        LDS_WAIT(); }
}
__device__ __forceinline__ void row_bcast16(float v, float* out16, LAS float* li_l, int r32, int hi) {
    if (hi == 0) li_l[r32] = v; LDS_WAIT();
#pragma unroll
    for (int r = 0; r < 16; ++r) out16[r] = li_l[crow(r, hi)];
    LDS_WAIT();
}

__device__ __forceinline__ void nsa_cmp_item(Frame& F, int l, int item) {
    const int qb = item & 31, g = (item >> 5) & 1, b = item >> 6, q0 = 64 * qb;
    const int ntile = (4 * qb + 3) > 64 ? 2 : 1;
    LAS char* Kl = (LAS char*)F.lds;
    LAS float* impP = (LAS float*)(F.lds + 67584);
    const bf16* P = ws_bf(F, WS_P);
    const int r32 = F.lane & 31, hi = F.lane >> 5;
    {   const int sr = F.tid >> 4, sc = (F.tid & 15) * 8;
        const bf16* KC = ws_bf(F, WS_KCMP) + (size_t)(b * 2 + g) * 128 * 128;
        for (int tl = 0; tl < ntile; ++tl) { const v4u k0 = *(const GAS v4u*)(KC + (size_t)(tl * 64 + sr) * 128 + sc), k1 = *(const GAS v4u*)(KC + (size_t)(tl * 64 + 32 + sr) * 128 + sc);
            *(LAS v4u*)(Kl + tl * 16384 + KSWZ(sr, sc * 2)) = k0; *(LAS v4u*)(Kl + tl * 16384 + KSWZ(32 + sr, sc * 2)) = k1; } }
    __syncthreads();
    const int hg = g * 8 + F.wave;
    const float slope = exp2f(-0.5f * (float)(hg + 1));
    for (int qh = 0; qh < 2; ++qh) {
        const int t = q0 + 32 * qh + r32; const size_t row = (size_t)b * SEQ + t;
        bf16x8 qr[8];
#pragma unroll
        for (int d0 = 0; d0 < 8; ++d0) qr[d0] = *(const GAS bf16x8*)(P + row * NPAD + PC_Q + hg * 128 + 16 * d0 + 8 * hi);
        f32x16 p0, p1, p2, p3;
        qkt(p0, p1, Kl, qr, r32, hi);
        if (ntile == 2) qkt(p2, p3, Kl + 16384, qr, r32, hi); else { p2 = f32x16{}; p3 = f32x16{}; }
        const int base0 = t - 31 - 64 * hi; float mx = -1e30f;
#define LG(Pv, SH) _Pragma("unroll") for (int r = 0; r < 16; ++r) { const int d = base0 - (SH) - 16 * koff(r); const float lg = (d >= 0) ? (Pv[r] * SM_SCALE - slope * (float)d) : -1e30f; Pv[r] = lg; mx = fmaxf(mx, lg); }
        LG(p0, 0) LG(p1, 512) LG(p2, 1024) LG(p3, 1536)
#undef LG
        mx = half_swap_max(mx);
        const float mref = (mx < -1e29f) ? 0.f : mx; float sum = 0.f;
#define EX(Pv) _Pragma("unroll") for (int r = 0; r < 16; ++r) { Pv[r] = __expf(Pv[r] - mref); sum += Pv[r]; }
        EX(p0) EX(p1) EX(p2) EX(p3)
#undef EX
        sum = half_swap_sum(sum);
        const float inv = sum > 0.f ? 1.0f / sum : 0.f;
#define SC(Pv, S) _Pragma("unroll") for (int r = 0; r < 16; ++r) Pv[r] *= (S);
        SC(p0, inv) SC(p1, inv) SC(p2, inv) SC(p3, inv)
        {   float cg[16], sp[16];
#define GRP(Pv, GB) _Pragma("unroll") for (int i = 0; i < 4; ++i) { sp[(GB) + i] = 0.5f * Pv[4 * i + 3]; cg[(GB) + i] = (Pv[4 * i] + Pv[4 * i + 1]) + (Pv[4 * i + 2] + sp[(GB) + i]); }
            GRP(p0, 0) GRP(p1, 4) GRP(p2, 8) GRP(p3, 12)
#undef GRP
            float oth[16];
#pragma unroll
            for (int G = 0; G < 16; ++G) oth[G] = __shfl_xor(sp[G], 32);
#pragma unroll
            for (int G = 0; G < 16; ++G) { float v = cg[G]; if (hi) v += oth[G]; else if (G > 0) v += oth[G - 1];
                impP[(F.wave * 64 + 32 * qh + r32) * 32 + 2 * G + hi] = v; }
        }
#undef SC
    }
    __syncthreads();
    LAS float* impS = (LAS float*)F.lds;
    const int q = F.tid >> 3, sub = F.tid & 7;
#pragma unroll
    for (int e = 0; e < 4; ++e) { const int n = 4 * sub + e; float s = 0.f;
#pragma unroll
        for (int w = 0; w < 8; ++w) s += impP[(w * 64 + q) * 32 + n];
        if (n > qb) s = -1e30f; else if (n == 0 || n == qb || n == qb - 1) s = 1e9f;
        impS[q * 33 + n] = s; }
    __syncthreads();
    {   float mine[4]; int rank[4];
#pragma unroll
        for (int e = 0; e < 4; ++e) { mine[e] = impS[q * 33 + 4 * sub + e]; rank[e] = 0; }
        for (int mI = 0; mI < 32; ++mI) { const float sm = impS[q * 33 + mI];
#pragma unroll
            for (int e = 0; e < 4; ++e) rank[e] += (sm > mine[e] || (sm == mine[e] && mI < 4 * sub + e)) ? 1 : 0; }
        unsigned bits = 0u;
#pragma unroll
        for (int e = 0; e < 4; ++e) if (rank[e] < TOPN && (4 * sub + e) <= qb) bits |= 1u << (4 * sub + e);
        bits |= __shfl_xor(bits, 1); bits |= __shfl_xor(bits, 2); bits |= __shfl_xor(bits, 4);
        if (sub == 0) ((unsigned*)(F.ws + WS_SEL))[(size_t)(b * 2 + g) * SEQ + q0 + q] = bits;
    }
    __syncthreads();
}

__device__ __forceinline__ void kv_src_offsets(int tid, size_t ld, unsigned (&ko)[2], unsigned (&vo)[2]) {
#pragma unroll
    for (int p = 0; p < 2; ++p) { const int L = p * 8192 + tid * 16;
        const int row = L >> 8, cB = (L & 255) ^ ((row & 7) << 4); ko[p] = (unsigned)(row * ld + (cB >> 1));
        const int sub = L >> 9, within = (L & 511) >> 1, kk = (sub >> 2) * 8 + (within >> 5), c = (sub & 3) * 32 + (within & 31);
        const int k = (kk & ~0xC) | ((kk & 4) << 1) | ((kk & 8) >> 1); vo[p] = (unsigned)(k * ld + c); }
}
__device__ __forceinline__ void kv_stage(const bf16* Kt, const bf16* Vt, const unsigned (&ko)[2], const unsigned (&vo)[2], LAS char* slot, int wave) {
#pragma unroll
    for (int p = 0; p < 2; ++p) __builtin_amdgcn_global_load_lds((const unsigned*)(Kt + ko[p]), (LAS unsigned*)(slot + p * 8192 + wave * 1024), 16, 0, 0);
#pragma unroll
    for (int p = 0; p < 2; ++p) __builtin_amdgcn_global_load_lds((const unsigned*)(Vt + vo[p]), (LAS unsigned*)(slot + 16384 + p * 8192 + wave * 1024), 16, 0, 0);
}
__device__ __forceinline__ void attn_branch(const int MODE, Frame& F, f32x16* o, float& lsum, const bf16x8* qr, const bf16* Kg, const bf16* Vg, unsigned tiles, unsigned mymask,
                                            int t, int qb, float C1, float C2, LAS char* KV, LAS float* wsf, size_t ld) {
    const int r32 = F.lane & 31, hi = F.lane >> 5;
    float m = -1e30f; lsum = 0.f;
    unsigned rem = tiles; int cur = 0;
    unsigned ko[2], vo[2]; kv_src_offsets(F.tid, ld, ko, vo);
    { const int n = 31 - __builtin_clz(rem); kv_stage(Kg + (size_t)(64 * n) * ld, Vg + (size_t)(64 * n) * ld, ko, vo, KV, F.wave); }
    VM_WAIT(); __syncthreads();
    while (rem) {
        const int n = 31 - __builtin_clz(rem); rem &= ~(1u << n);
        LAS char* Kl = KV + cur * 32768; LAS char* Vl = Kl + 16384;
        if (rem) { const int n2 = 31 - __builtin_clz(rem); kv_stage(Kg + (size_t)(64 * n2) * ld, Vg + (size_t)(64 * n2) * ld, ko, vo, KV + (cur ^ 1) * 32768, F.wave); }
        f32x16 p0, p1; qkt(p0, p1, Kl, qr, r32, hi);
        float alpha;
        if (MODE == 2) { int dist0 = t - 31 - 1024 * n - 64 * hi; asm volatile("" : "+v"(dist0)); sm_tile_cmp(p0, p1, dist0, C1, C2, m, lsum, alpha); }
        else {
            int dist0 = t - 64 * n - 4 * hi; asm volatile("" : "+v"(dist0));
            const bool rowsel = ((mymask >> n) & 1u) != 0u;
            const bool masked = (n == qb) || (MODE == 1 && n == qb - 8);
            if (masked) { if (MODE == 1) sm_tile<1>(p0, p1, dist0, rowsel, C1, C2, m, lsum, alpha); else sm_tile<0>(p0, p1, dist0, rowsel, C1, C2, m, lsum, alpha); }
            else sm_tile_fast(p0, p1, rowsel ? -C2 * (float)dist0 : -1e30f, C1, C2, m, lsum, alpha);
        }
        o_rescale(o, alpha, wsf, r32, hi);
        bf16x8 pa0, pa1, pa2, pa3; p_to_frag(p0, p1, pa0, pa1, pa2, pa3);
        pv_d0(o, (int)(uintptr_t)Vl + v_rd_base(F.lane), pa0, pa1, pa2, pa3);
        VM_WAIT(); __syncthreads();
        cur ^= 1;
    }
}
__device__ __forceinline__ void nsa_attn_item(Frame& F, int l, int item) {
    const int qb = 31 - (item >> 4), rest = item & 15, b = rest >> 2, g = (rest >> 1) & 1, hh = rest & 1, q0 = 64 * qb;
    const int r32 = F.lane & 31, hi = F.lane >> 5;
    const int hg = 8 * g + 4 * hh + (F.wave >> 1), qh = F.wave & 1, t = q0 + 32 * qh + r32;
    const size_t row = (size_t)b * SEQ + t;
    const float slope = exp2f(-0.5f * (float)(hg + 1)), C1 = SM_SCALE * LOG2E, C2 = slope * LOG2E;
    LAS char* KV = (LAS char*)F.lds; LAS float* wsf = (LAS float*)(F.lds + 69632) + F.wave * 64;
    const bf16* P = ws_bf(F, WS_P);
    bf16x8 qr[8];
#pragma unroll
    for (int d0 = 0; d0 < 8; ++d0) qr[d0] = *(const GAS bf16x8*)(P + row * NPAD + PC_Q + hg * 128 + 16 * d0 + 8 * hi);
    const unsigned* SEL = (const unsigned*)(F.ws + WS_SEL) + (size_t)(b * 2 + g) * SEQ;
    const unsigned mymask = SEL[t];
    unsigned uni = SEL[q0 + F.lane];
#pragma unroll
    for (int o_ = 1; o_ < 64; o_ <<= 1) uni |= __shfl_xor(uni, o_);
    uni = __builtin_amdgcn_readfirstlane(uni);
    const unsigned upto = (qb == 31) ? 0xffffffffu : ((2u << qb) - 1u);
    LAS unsigned* stash = (LAS unsigned*)(F.lds + 71680) + F.tid;
    const int nlo = qb > 8 ? qb - 8 : 0;
#pragma unroll
    for (int br = 0; br < 3; ++br) {
        const int mode = (br == 0) ? 2 : (br == 1 ? 0 : 1);
        const bf16* Kg = (br == 0) ? ws_bf(F, WS_KCMP) + (size_t)(b * 2 + g) * 128 * 128 : P + (size_t)b * SEQ * NPAD + (br == 1 ? PC_KVS : PC_KVW) + g * 128;
        const bf16* Vg = (br == 0) ? ws_bf(F, WS_VCMP) + (size_t)(b * 2 + g) * 128 * 128 : Kg + 256;
        const size_t ld = (br == 0) ? 128 : NPAD;
        const unsigned tiles = (br == 0) ? ((4 * qb + 3) > 64 ? 3u : 1u) : (br == 1 ? (uni & upto) : (upto & ~((1u << nlo) - 1u)));
        f32x16 o[4] = {};
        float lsum, rs[16];
        attn_branch(mode, F, o, lsum, qr, Kg, Vg, tiles, (br == 1) ? mymask : 0xffffffffu, t, qb, C1, C2, KV, wsf, ld);
        const float gt = sigm(bf2f(P[row * NPAD + PC_GL + hg * 3 + br]));
        row_bcast16(lsum > 0.f ? gt / lsum : 0.f, rs, wsf + 32, r32, hi);
        if (br == 0) {
#pragma unroll
            for (int d0 = 0; d0 < 4; ++d0)
#pragma unroll
                for (int r = 0; r < 16; r += 2) stash[(d0 * 8 + (r >> 1)) * 512] = cvtpk(o[d0][r] * rs[r], o[d0][r + 1] * rs[r + 1]);
        } else if (br == 1) {
#pragma unroll
            for (int d0 = 0; d0 < 4; ++d0)
#pragma unroll
                for (int r = 0; r < 16; r += 2) { const unsigned sw = stash[(d0 * 8 + (r >> 1)) * 512];
                    stash[(d0 * 8 + (r >> 1)) * 512] = cvtpk(bflo(sw) + o[d0][r] * rs[r], bfhi(sw) + o[d0][r + 1] * rs[r + 1]); }
        } else {
            LAS bf16* Yl = (LAS bf16*)(F.lds + F.wave * 8704);
#pragma unroll
            for (int d0 = 0; d0 < 4; ++d0)
#pragma unroll
                for (int r = 0; r < 16; ++r) { const unsigned sw = stash[(d0 * 8 + (r >> 1)) * 512];
                    const float v = ((r & 1) ? bfhi(sw) : bflo(sw)) + o[d0][r] * rs[r];
                    Yl[(koff(r) + 4 * hi) * 136 + 32 * d0 + r32] = (bf16)f2bf(v); }
            LDS_WAIT(); asm volatile("" ::: "memory");
            const int yr = F.lane >> 1, yh = (F.lane & 1) * 64;
            const size_t orow = (size_t)b * SEQ + q0 + 32 * qh + yr;
            const bf16* gp = P + orow * NPAD + PC_NSAG + hg * 128 + yh;
            bf16* yp = ws_bf(F, WS_YCAT) + orow * DM + 1024 + hg * 128 + yh;
#pragma unroll
            for (int i2 = 0; i2 < 8; ++i2) { const v4u w = *(const LAS v4u*)(Yl + yr * 136 + yh + 8 * i2); const v4u gq = *(const GAS v4u*)(gp + 8 * i2);
                v4u y; y.x = pk2(bflo(w.x) * silu(bflo(gq.x)), bfhi(w.x) * silu(bfhi(gq.x))); y.y = pk2(bflo(w.y) * silu(bflo(gq.y)), bfhi(w.y) * silu(bfhi(gq.y)));
                y.z = pk2(bflo(w.z) * silu(bflo(gq.z)), bfhi(w.z) * silu(bfhi(gq.z))); y.w = pk2(bflo(w.w) * silu(bflo(gq.w)), bfhi(w.w) * silu(bfhi(gq.w)));
                *(GAS v4u*)(yp + 8 * i2) = y; }
        }
    }
    __syncthreads();
}

#ifndef PROBE_DUP
#define PROBE_DUP -1
#endif
#ifndef MK_SPLIT
#define MK_SPLIT 0
#endif
constexpr int N_PHASES = 2 + 6 * DEPTH;
struct Args { const float* in[23]; float* out; unsigned char* ws; int ph_lo, ph_hi; };
__global__ void __launch_bounds__(NWAVES * 64, 2) hymba_fwd(Args args) {
    extern __shared__ __attribute__((aligned(16))) unsigned char lds[];
    Frame F;
    F.lds = (LAS unsigned char*)lds;
    F.MISC = (volatile LAS unsigned*)(F.lds + MISC_OFF);
    F.tid = threadIdx.x; F.lane = F.tid & 63; F.wave = __builtin_amdgcn_readfirstlane(F.tid >> 6);
    F.G = gridDim.x; { const int bx = blockIdx.x; F.vcu = (F.G % 8 == 0) ? (bx % 8) * (F.G / 8) + bx / 8 : bx; }
    F.ws = args.ws; F.out = args.out; F.ctl = (gu32*)(args.ws + WS_CTL);
    F.in = args.in;
    const Roots RT{args.ws, args.out, (LAS unsigned char*)lds};
    for (int u = F.tid; u < (LDS_BYTES - LDSCTL_OFF) / 4; u += NWAVES * 64) ((LAS unsigned*)(F.lds + LDSCTL_OFF))[u] = 0u;
    __syncthreads();
#if MK_SPLIT
#define GRID_BAR() do { } while (0)
#else
    XcdBarrier bar = xcd_barrier_post((unsigned*)(F.ctl + CW_BAR), F.MISC + 8);
#define GRID_BAR() do { XcdBarrier bl_ = bar; bl_.bar = launder_p(bl_.bar); bl_.x = (unsigned)launder_u((int)bl_.x); xcd_barrier(bl_); } while (0)
#endif
#if MK_SPLIT
    const int lo = args.ph_lo, hi_ = args.ph_hi;
#define IN(k) (lo <= (k) && (k) < hi_)
#define BOTH(k) (IN(k) && IN((k) + 1))
#else
#define IN(k) true
#define BOTH(k) ((k) + 1 < N_PHASES)
#endif

    if (IN(0)) { launder_from(F, RT); p0_prologue(F);
        if (BOTH(0)) GRID_BAR(); }
    if (IN(1)) { launder_from(F, RT); p1_u0(F); if (BOTH(1)) GRID_BAR(); }
    for (int l = 0; l < DEPTH; ++l) {
        const int pb = 2 + 6 * l;
        if (IN(pb + 0)) { launder_from(F, RT);
            pg8::Gemm g{ws_bf(F, WS_U), ws_bf(F, WS_WIN) + (size_t)l * NPAD * DM, MROWS, NPAD, DM}; pg8::StaticOrder S; S.init(MROWS, NPAD, F.G, (int)blockIdx.x);
            pg8::EpiBf16 E{ws_bf(F, WS_P), NPAD};
            pg8::gemm_phase<pg8::EpiBf16, pg8::StaticOrder, true, true>(F.lds, g, S, E);
            if (BOTH(pb + 0)) GRID_BAR();
        }
        if (IN(pb + 1)) { launder_from(F, RT);
            for (;;) { const int it = q_next(F, l * 8 + 3); if (it >= 128) break; cmp_item(F, l, it); }
            launder_from(F, RT);
            for (;;) { const int it = q_next(F, l * 8 + 4); if (it >= 1024) break; hg1_item(F, l, it); }
            launder_from(F, RT);
            for (;;) { const int it = q_next(F, l * 8 + 5); if (it >= 1024) break; rg1_item(F, l, it); }
            if (BOTH(pb + 1)) GRID_BAR();
        }
        if (IN(pb + 2)) { launder_from(F, RT);
            for (int it = F.vcu; it < 256; it += F.G) nsa_cmp_item(F, l, it);
            launder_from(F, RT);
            hg_pass2(F);
            launder_from(F, RT);
            rg_pass2(F);
            if (BOTH(pb + 2)) GRID_BAR();
        }
        if (IN(pb + 3)) { launder_from(F, RT);
            for (;;) { const int it = q_next(F, l * 8 + 0); if (it >= 512) break; nsa_attn_item(F, l, it); }
            launder_from(F, RT);
            for (;;) { const int it = q_next(F, l * 8 + 1); if (it >= 1024) break; hg3_item(F, l, it); }
            launder_from(F, RT);
            rg_pass3(F);
            if (BOTH(pb + 3)) GRID_BAR();
        }
        if (IN(pb + 4)) { launder_from(F, RT);
            pg8::Gemm g{ws_bf(F, WS_YCAT), ws_bf(F, WS_WOUT) + (size_t)l * DM * DM, MROWS, DM, DM}; pg8::StaticOrder S; S.init(MROWS, DM, F.G, (int)blockIdx.x);
            pg8::EpiResid E{l == 0 ? F.in[0] : ws_f(F, WS_XRES), ws_f(F, WS_V), ws_f(F, WS_MOD) + (size_t)l * 4 * 12288 + 2 * DM, 12288, SEQ, DM, ALPHA};
            pg8::gemm_phase<pg8::EpiResid, pg8::StaticOrder, true, true>(F.lds, g, S, E);
            if (BOTH(pb + 4)) GRID_BAR();
        }
        if (IN(pb + 5)) { launder_from(F, RT);
            ln_phase(F, l, (l == DEPTH - 1) ? F.out : ws_f(F, WS_XRES), l != DEPTH - 1);
            if (BOTH(pb + 5)) GRID_BAR();
        }
    }
#undef IN
#undef BOTH
}

extern "C" void kernel_launch(void* const* d_in, const int* in_sizes, int n_in, void* d_out, int out_size, void* d_ws, size_t ws_size, hipStream_t stream) {
    static int grid = 0;
    if (grid == 0) {
        if (n_in != 23 || in_sizes[0] != MROWS * DM || out_size != MROWS * DM || ws_size < WS_END) {
            fprintf(stderr, "kernel_launch: shape/workspace mismatch: n_in %d in0 %d out %d ws %zu (need %zu)\n", n_in, n_in > 0 ? in_sizes[0] : -1, out_size, ws_size, (size_t)WS_END); grid = -1; return; }
        int dev = 0, cus = 0, per_cu = 0;
        if (hipGetDevice(&dev) != hipSuccess || hipDeviceGetAttribute(&cus, hipDeviceAttributeMultiprocessorCount, dev) != hipSuccess) { fprintf(stderr, "kernel_launch: device query failed\n"); grid = -1; return; }
        if (hipFuncSetAttribute((const void*)hymba_fwd, hipFuncAttributeMaxDynamicSharedMemorySize, LDS_BYTES) != hipSuccess) { fprintf(stderr, "kernel_launch: hipFuncSetAttribute failed\n"); grid = -1; return; }
        if (hipOccupancyMaxActiveBlocksPerMultiprocessor(&per_cu, (const void*)hymba_fwd, NWAVES * 64, LDS_BYTES) != hipSuccess || per_cu < 1)
            fprintf(stderr, "kernel_launch: note: occupancy query reports %d workgroups per CU\n", per_cu);
        (void)hipGetLastError();
        grid = cus;
    }
    if (grid < 0) return;
    if (hipMemsetAsync((char*)d_ws + WS_CTL, 0, CTL_ZERO_BYTES, stream) != hipSuccess) { fprintf(stderr, "kernel_launch: memset failed\n"); return; }
    Args a{};
    for (int i = 0; i < 23; ++i) a.in[i] = (const float*)d_in[i];
    a.out = (float*)d_out; a.ws = (unsigned char*)d_ws;
#if MK_SPLIT
    for (int ph = 0; ph < N_PHASES; ++ph) { a.ph_lo = ph; a.ph_hi = ph + 1;
        hipLaunchKernelGGL(hymba_fwd, dim3(grid), dim3(NWAVES * 64), LDS_BYTES, stream, a); }
#else
    a.ph_lo = 0; a.ph_hi = N_PHASES;
    hipLaunchKernelGGL(hymba_fwd, dim3(grid), dim3(NWAVES * 64), LDS_BYTES, stream, a);
#endif
    const hipError_t le = hipPeekAtLastError();
    if (le != hipSuccess) fprintf(stderr, "kernel_launch: launch failed: %s\n", hipGetErrorName(le));
}
```
